# Optimizing an MI355X kernel written in HIP

```python
import math
import jax, jax.numpy as jnp
from jax import lax
import numpy as np

D_MODEL = 1024
BATCH = 1
SEQ = 16384
DEPTH = 4

HEAD_DIM = 64
N_HEADS_SB = 4
N_HEADS_DIL = 12
W_SB = N_HEADS_SB * HEAD_DIM
W_DIL = N_HEADS_DIL * HEAD_DIM
MIX_WIDTH = W_SB + W_DIL
IN_COLS = 4 * W_SB + 4 * W_DIL
DIL_PATTERNS = ((128, 1), (512, 4), (2048, 16))
ROPE_THETA = 500000.0
ROPE_DIM = HEAD_DIM // 4
BLOCK = 128
EPS = 1e-6

kernel_name = "hybrid_stickbreak_dilated_gated"


def _rmsnorm(x, g):
    xf = x.astype(jnp.float32)
    y = xf * lax.rsqrt(jnp.mean(xf * xf, axis=-1, keepdims=True) + EPS)
    return (y * g.astype(jnp.float32)).astype(x.dtype)


def _partial_rope(x, pos):
    half = ROPE_DIM // 2
    inv_freq = 1.0 / (ROPE_THETA ** (jnp.arange(half, dtype=jnp.float32) * 2.0 / ROPE_DIM))
    ang = pos.astype(jnp.float32)[:, None] * inv_freq[None, :]
    cos = jnp.cos(ang)[None, :, None, :]
    sin = jnp.sin(ang)[None, :, None, :]
    xf = x.astype(jnp.float32)
    x1 = xf[..., :half]
    x2 = xf[..., half:ROPE_DIM]
    rot = jnp.concatenate([x1 * cos - x2 * sin, x2 * cos + x1 * sin], axis=-1)
    return jnp.concatenate([rot, xf[..., ROPE_DIM:]], axis=-1).astype(x.dtype)


def _stick_breaking(q, k, v):
    B, S, H, Dh = q.shape
    nblk = S // BLOCK
    scale = 1.0 / math.sqrt(Dh)
    qt = q.transpose(0, 2, 1, 3)
    kt = k.transpose(0, 2, 1, 3)
    vt = v.transpose(0, 2, 1, 3)
    idx = jnp.arange(BLOCK)
    tri_in = (idx[:, None] > idx[None, :]).astype(jnp.float32)
    blk_idx = jnp.arange(nblk)
    tri_blk = (blk_idx[:, None] > blk_idx[None, :]).astype(jnp.float32)
    outs = []
    for i in range(nblk):
        nk = i + 1
        lk = nk * BLOCK
        qblk = qt[:, :, i * BLOCK:(i + 1) * BLOCK]
        z = jnp.einsum('bhqd,bhkd->bhqk', qblk, kt[:, :, :lk],
                       preferred_element_type=jnp.float32) * scale
        qpos = i * BLOCK + idx
        mask = jnp.arange(lk)[None, :] < qpos[:, None]
        ls_z = jax.nn.log_sigmoid(z)
        log_surv = jnp.where(mask, ls_z - z, 0.0)
        lsb = log_surv.reshape(B, H, BLOCK, nk, BLOCK)
        within = jnp.einsum('bhqnj,js->bhqns', lsb, tri_in,
                            precision=lax.Precision.HIGHEST)
        totals = jnp.sum(lsb, axis=-1)
        later = jnp.einsum('bhqm,mn->bhqn', totals, tri_blk[:nk, :nk],
                           precision=lax.Precision.HIGHEST)
        acc = (within + later[..., None]).reshape(B, H, BLOCK, lk)
        a = jnp.where(mask, jnp.exp(ls_z + acc), 0.0)
        o = jnp.einsum('bhqk,bhkd->bhqd', a, vt[:, :, :lk],
                       preferred_element_type=jnp.float32)
        outs.append(o.astype(q.dtype))
    o = jnp.concatenate(outs, axis=2)
    return o.transpose(0, 2, 1, 3)


def _dilated_window(q, k, v, window, dilation):
    B, S, H, Dh = q.shape
    r = dilation
    span = window // r
    L = S // r
    nb = -(-L // BLOCK)
    Lp = nb * BLOCK
    scale = 1.0 / math.sqrt(Dh)

    def to_blocks(t):
        t = t.reshape(B, L, r, H, Dh).transpose(0, 2, 1, 3, 4)
        t = jnp.pad(t, ((0, 0), (0, 0), (0, Lp - L), (0, 0), (0, 0)))
        return t.reshape(B, r, nb, BLOCK, H, Dh)

    def with_prev(t):
        prev = jnp.concatenate([jnp.zeros_like(t[:, :, :1]), t[:, :, :-1]], axis=2)
        return jnp.concatenate([prev, t], axis=3)

    qb = to_blocks(q)
    kk = with_prev(to_blocks(k))
    vv = with_prev(to_blocks(v))

    i = jnp.arange(BLOCK)[:, None]
    j = jnp.arange(2 * BLOCK)[None, :]
    n = jnp.arange(nb)[:, None, None]
    dist = BLOCK + i - j
    mask = (dist >= 0) & (dist <= span) & ((n > 0) | (j >= BLOCK))
    mask = mask[None, None, :, None]

    s = jnp.einsum('brnqhd,brnkhd->brnhqk', qb, kk,
                   preferred_element_type=jnp.float32) * scale
    s = jnp.where(mask, s, -jnp.inf)
    m = jnp.max(s, axis=-1, keepdims=True)
    p = jnp.exp(s - m)
    l = jnp.sum(p, axis=-1, keepdims=True)
    o = jnp.einsum('brnhqk,brnkhd->brnqhd', p, vv,
                   preferred_element_type=jnp.float32)
    o = o / jnp.transpose(l, (0, 1, 2, 4, 3, 5))
    log_den = (m + jnp.log(l))[..., 0].transpose(0, 1, 2, 4, 3)

    o = o.reshape(B, r, Lp, H, Dh)[:, :, :L].transpose(0, 2, 1, 3, 4).reshape(B, S, H, Dh)
    log_den = log_den.reshape(B, r, Lp, H)[:, :, :L].transpose(0, 2, 1, 3).reshape(B, S, H)
    return o, log_den


def _dilated_mixture(q, k, v):
    outs, dens = [], []
    for window, dilation in DIL_PATTERNS:
        o, ld = _dilated_window(q, k, v, window, dilation)
        outs.append(o)
        dens.append(ld)
    outs = jnp.stack(outs, axis=0)
    alpha = jax.nn.softmax(jnp.stack(dens, axis=0), axis=0)
    return jnp.sum(alpha[..., None] * outs, axis=0).astype(q.dtype)


def setup_inputs(seed: int = 0) -> dict:
    key = jax.random.key(seed)
    ks = jax.random.split(key, 6)
    x = jax.random.normal(ks[0], (BATCH, SEQ, D_MODEL), jnp.float32)
    norm_g = 1.0 + 0.02 * jax.random.normal(ks[1], (DEPTH, D_MODEL), jnp.float32)
    w_in = jax.random.normal(ks[2], (DEPTH, D_MODEL, IN_COLS), jnp.float32) * D_MODEL ** -0.5
    q_norm_g = 1.0 + 0.02 * jax.random.normal(ks[3], (DEPTH, HEAD_DIM), jnp.float32)
    k_norm_g = 1.0 + 0.02 * jax.random.normal(ks[4], (DEPTH, HEAD_DIM), jnp.float32)
    w_out = jax.random.normal(ks[5], (DEPTH, MIX_WIDTH, D_MODEL), jnp.float32) * (
        MIX_WIDTH ** -0.5 * (2 * DEPTH) ** -0.5)
    return {"x": x, "norm_g": norm_g, "w_in": w_in, "q_norm_g": q_norm_g,
            "k_norm_g": k_norm_g, "w_out": w_out}


def reference(x, norm_g, w_in, q_norm_g, k_norm_g, w_out):
    B, S, _ = x.shape
    pos = jnp.arange(S)
    cuts = np.cumsum([W_SB] * 4 + [W_DIL] * 3).tolist()
    for layer in range(DEPTH):
        h = _rmsnorm(x, norm_g[layer])
        proj = jnp.einsum('bsd,dc->bsc', h, w_in[layer])
        qa, ka, va, ga, qd, kd, vd, gd = jnp.split(proj, cuts, axis=-1)
        heads = lambda t, n: t.reshape(B, S, n, HEAD_DIM)

        oa = _stick_breaking(heads(qa, N_HEADS_SB), heads(ka, N_HEADS_SB), heads(va, N_HEADS_SB))
        oa = oa.reshape(B, S, W_SB) * jax.nn.silu(ga)

        qd = _partial_rope(_rmsnorm(heads(qd, N_HEADS_DIL), q_norm_g[layer]), pos)
        kd = _partial_rope(_rmsnorm(heads(kd, N_HEADS_DIL), k_norm_g[layer]), pos)
        od = _dilated_mixture(qd, kd, heads(vd, N_HEADS_DIL))
        od = od.reshape(B, S, W_DIL) * jax.nn.silu(gd)

        y = jnp.einsum('bsc,cd->bsd', jnp.concatenate([oa, od], axis=-1), w_out[layer])
        x = x + y.astype(x.dtype)
    return x
```

```cpp
#include <hip/hip_runtime.h>
#include <cstdio>
#include <cstdint>
#ifndef MK_N_LAUNCHES
#define MK_N_LAUNCHES 17
#endif
#ifndef SB_EARLY_EXIT
#define SB_EARLY_EXIT 0
#endif
namespace pg8 {
#define PG8_LAS __attribute__((address_space(3)))
typedef unsigned short bf16_t;
typedef short bf16x8 __attribute__((ext_vector_type(8)));
typedef float f32x4 __attribute__((ext_vector_type(4)));
typedef unsigned u32x4 __attribute__((ext_vector_type(4)));
constexpr int BM = 256, BK = 64, HALF = 128, HTB = HALF * BK * 2  , STAGE_BYTES = 8 * HTB, NXCD = 8, WGM = 8;

__host__ __device__ __forceinline__ int lds_byte(int r, int c) { const int st = (r >> 4) * 2 + (c >> 5), rr = r & 15, cc = c & 31, ob = rr * 64 + cc * 2; return st * 1024 + (ob ^ (((ob >> 9) & 1) << 5)); }
__host__ __device__ __forceinline__ void stage_rc(int b, int& R, int& C) { const int st = b / 1024, sb = b % 1024, swz = sb ^ (((sb >> 9) & 1) << 5); R = (st >> 1) * 16 + swz / 64; C = (st & 1) * 32 + (swz % 64) / 2; }
__host__ __device__ __forceinline__ int perm32(int rho) { const int n = rho >> 4, i = rho & 15; return 8 * (i >> 2) + 4 * n + (i & 3); }

struct Unit { int pm, pn; };
struct Gemm { const bf16_t* A; const bf16_t* Bt; int M, N, K; };

struct StaticOrder {
    int nM, nN, nwg, G, c;
    __host__ __device__ void init(int M, int N, int G_, int c_) { nM = M / BM; nN = N / BM; nwg = nM * nN; G = G_; c = c_; }
    __host__ __device__ bool next(int i, Unit& u) const {
        const long L = (long)i * G + c; if (L >= nwg) return false;
        int wgid = (int)L; { const int q = nwg / NXCD, r = nwg % NXCD, xcd = wgid % NXCD, off = wgid / NXCD; wgid = (xcd < r ? xcd * (q + 1) : r * (q + 1) + (xcd - r) * q) + off; }
        const int nig = WGM * nN, gid = wgid / nig, fm = gid * WGM, gsz = (nM - fm) < WGM ? (nM - fm) : WGM;
        u.pm = fm + ((wgid % nig) % gsz); u.pn = (wgid % nig) / gsz; return true;
    }
    __device__ __forceinline__ void a_ready(const Unit&) const {}
    __device__ __forceinline__ void done(const Unit&) const {}
};

typedef float f32x2 __attribute__((ext_vector_type(2)));
typedef __bf16 bf16x2_t __attribute__((ext_vector_type(2)));
__device__ __forceinline__ unsigned cvtpk(float lo, float hi) { f32x2 v = {lo, hi}; bf16x2_t b = __builtin_convertvector(v, bf16x2_t); return __builtin_bit_cast(unsigned, b); }
constexpr int SEQ = 16384, PROJ_PITCH = 4096;
constexpr float EPSV = 1e-6f;
constexpr float QSCALE = 0.125f * 1.4426950408889634f;

struct EpiInProj {
    static constexpr bool PERM = true, AFTER_DRAIN = false;
    bf16_t* P; const float* ssq; const float* qg; const float* kg; const float* rope;
    __device__ __forceinline__ void operator()(const f32x4 (&acc)[2][2][4][2], const Unit& u, int wr, int wc, int fr, int fq) const {
        const int pn = u.pn;
        const int kind = (pn == 0) ? 0 : ((pn == 3 || pn >= 13) ? 1 : ((pn >= 4 && pn <= 6) ? 2 : ((pn >= 7 && pn <= 9) ? 3 : 4)));
        const int colbase = pn * 256 + wc * 64 + 8 * fq;
        f32x4 g[2][2];
#pragma unroll
        for (int bj = 0; bj < 2; ++bj)
#pragma unroll
            for (int n = 0; n < 2; ++n) g[bj][n] = (f32x4){1.f, 1.f, 1.f, 1.f};
        if (kind == 2 || kind == 3) { const float* gp = (kind == 2) ? qg : kg;
#pragma unroll
            for (int bj = 0; bj < 2; ++bj)
#pragma unroll
                for (int n = 0; n < 2; ++n) g[bj][n] = *(const f32x4*)(gp + 32 * bj + 8 * fq + 4 * n); }
#pragma unroll
        for (int ai = 0; ai < 2; ++ai)
#pragma unroll
            for (int m = 0; m < 4; ++m) {
                const int row = u.pm * BM + ai * HALF + wr * 64 + m * 16 + fr;
                const float ss = (ssq[row] + ssq[SEQ + row]) + (ssq[2 * SEQ + row] + ssq[3 * SEQ + row]);
                const float rs = __builtin_amdgcn_rsqf(ss * (1.0f / 1024.0f) + EPSV);
                f32x4 v[2][2];
#pragma unroll
                for (int bj = 0; bj < 2; ++bj)
#pragma unroll
                    for (int n = 0; n < 2; ++n) v[bj][n] = acc[ai][bj][m][n] * rs;
                if (kind == 0) {
#pragma unroll
                    for (int bj = 0; bj < 2; ++bj)
#pragma unroll
                        for (int n = 0; n < 2; ++n) v[bj][n] = v[bj][n] * QSCALE;
                } else if (kind == 1) {
#pragma unroll
                    for (int bj = 0; bj < 2; ++bj)
#pragma unroll
                        for (int n = 0; n < 2; ++n)
#pragma unroll
                            for (int e = 0; e < 4; ++e) { const float x = v[bj][n][e]; v[bj][n][e] = x * __builtin_amdgcn_rcpf(1.0f + __builtin_amdgcn_exp2f(-1.4426950408889634f * x)); }
                } else if (kind == 2 || kind == 3) {
                    float hs = 0.f;
#pragma unroll
                    for (int bj = 0; bj < 2; ++bj)
#pragma unroll
                        for (int n = 0; n < 2; ++n) { const f32x4 x = v[bj][n]; hs += (x[0] * x[0] + x[1] * x[1]) + (x[2] * x[2] + x[3] * x[3]); }
                    hs += __shfl_xor(hs, 16); hs += __shfl_xor(hs, 32);
                    const float hr = __builtin_amdgcn_rsqf(hs * (1.0f / 64.0f) + EPSV);
#pragma unroll
                    for (int bj = 0; bj < 2; ++bj)
#pragma unroll
                        for (int n = 0; n < 2; ++n) v[bj][n] = v[bj][n] * hr * g[bj][n];
                    f32x4 cs[2], sn[2];
#pragma unroll
                    for (int n = 0; n < 2; ++n) { cs[n] = *(const f32x4*)(rope + (size_t)row * 16 + 4 * n); sn[n] = *(const f32x4*)(rope + (size_t)row * 16 + 8 + 4 * n); }
#pragma unroll
                    for (int n = 0; n < 2; ++n)
#pragma unroll
                        for (int e = 0; e < 4; ++e) { const float own = v[0][n][e]; const float oth = __shfl_xor(own, 16);
                            const float r0 = own * cs[n][e] - oth * sn[n][e], r1 = own * cs[n][e] + oth * sn[n][e];
                            v[0][n][e] = (fq == 0) ? r0 : ((fq == 1) ? r1 : own); }
                    if (kind == 2) {
#pragma unroll
                        for (int bj = 0; bj < 2; ++bj)
#pragma unroll
                            for (int n = 0; n < 2; ++n) v[bj][n] = v[bj][n] * QSCALE;
                    }
                }
                bf16_t* rowp = P + (size_t)row * PROJ_PITCH + colbase;
#pragma unroll
                for (int bj = 0; bj < 2; ++bj) { u32x4 w; w.x = cvtpk(v[bj][0][0], v[bj][0][1]); w.y = cvtpk(v[bj][0][2], v[bj][0][3]); w.z = cvtpk(v[bj][1][0], v[bj][1][1]); w.w = cvtpk(v[bj][1][2], v[bj][1][3]);
                    *(u32x4*)(rowp + 32 * bj) = w; }
            }
    }
};

struct EpiOutProj {
    static constexpr bool PERM = true, AFTER_DRAIN = true;
    const float* xin; float* xout; bf16_t* xb; float* ssq;
    __device__ __forceinline__ void fused(f32x4 (&acc)[2][2][4][2], const Unit& u, int wr, int wc, int fr, int fq, PG8_LAS unsigned char* lds, int wid, int lane) const {
        PG8_LAS float* Pw = (PG8_LAS float*)lds;
#pragma unroll
        for (int ai = 0; ai < 2; ++ai)
#pragma unroll
            for (int m = 0; m < 4; ++m) {
                const int rt = ai * HALF + wr * 64 + m * 16 + fr; const size_t off = (size_t)(u.pm * BM + rt) * 1024 + u.pn * BM + wc * 32 + 8 * fq;
                float s = 0.f;
#pragma unroll
                for (int bj = 0; bj < 2; ++bj) {
                    const f32x4 a0 = *(const f32x4*)(xin + off + bj * HALF) + acc[ai][bj][m][0], a1 = *(const f32x4*)(xin + off + bj * HALF + 4) + acc[ai][bj][m][1];
                    *(f32x4*)(xout + off + bj * HALF) = a0; *(f32x4*)(xout + off + bj * HALF + 4) = a1;
                    u32x4 w; w.x = cvtpk(a0[0], a0[1]); w.y = cvtpk(a0[2], a0[3]); w.z = cvtpk(a1[0], a1[1]); w.w = cvtpk(a1[2], a1[3]);
                    *(u32x4*)(xb + off + bj * HALF) = w;
                    s += ((a0[0] * a0[0] + a0[1] * a0[1]) + (a0[2] * a0[2] + a0[3] * a0[3])) + ((a1[0] * a1[0] + a1[1] * a1[1]) + (a1[2] * a1[2] + a1[3] * a1[3]));
                }
                s += __shfl_xor(s, 16); s += __shfl_xor(s, 32);
                if (fq == 0) Pw[rt * 4 + wc] = s;
                if (m & 1) asm volatile("" ::: "memory");
            }
        asm volatile("s_waitcnt lgkmcnt(0)" ::: "memory"); __builtin_amdgcn_s_barrier(); asm volatile("" ::: "memory");
        const int t = wid * 64 + lane;
        if (t < 256) { const float s = (Pw[t * 4 + 0] + Pw[t * 4 + 1]) + (Pw[t * 4 + 2] + Pw[t * 4 + 3]); ssq[(size_t)u.pn * SEQ + u.pm * BM + t] = s; }
        asm volatile("s_waitcnt lgkmcnt(0)" ::: "memory"); __builtin_amdgcn_s_barrier(); asm volatile("" ::: "memory");
    }
};

template <class Epi, class Sched, bool ALIGN_EPI = false, bool SP2 = false>
__device__ __forceinline__ void gemm_phase(PG8_LAS unsigned char* lds, const Gemm g, const Sched& S, const Epi& E) {
    int tid = threadIdx.x; asm volatile("" : "+v"(tid));
    const int wid = __builtin_amdgcn_readfirstlane(tid >> 6), lane = tid & 63, wr = wid >> 2, wc = wid & 3, fr = lane & 15, fq = lane >> 4;
    const int K = g.K, nt = K / BK;
    unsigned voffA[2], voffB[2];
#pragma unroll
    for (int i = 0; i < 2; ++i) { int R, C; stage_rc(tid * 16 + i * 8192, R, C); const int Rb = Epi::PERM ? ((R & ~31) + perm32(R & 31)) : R;
        voffA[i] = (unsigned)(R * K + C) * 2u; voffB[i] = (unsigned)(Rb * K + C) * 2u; }
    const size_t kstep = (size_t)(BK * 2);
    const size_t hstep = (size_t)HALF * K * 2;
    const size_t tstep = 2 * hstep;
    const unsigned ldsw = (unsigned)wid * 1024u;
    const int aoff = lds_byte(wr * 64 + fr, fq * 8), boff = lds_byte(wc * 32 + fr, fq * 8);
#define PG8_SA(b, h) (((b) * 2 + (h)) * HTB)
#define PG8_SB(b, h) ((4 + (b) * 2 + (h)) * HTB)
#define PG8_STAGE(bufoff, gbase, voff) do { _Pragma("unroll") for (int _i = 0; _i < 2; ++_i) \
        __builtin_amdgcn_global_load_lds((const unsigned*)((const char*)(gbase) + (voff)[_i]), (PG8_LAS unsigned*)(lds + (bufoff) + ldsw + _i * 8192), 16, 0, 0); } while (0)
#define PG8_LDA(dst, b, h) do { _Pragma("unroll") for (int m = 0; m < 4; ++m) _Pragma("unroll") for (int k = 0; k < 2; ++k) dst[m][k] = *(const PG8_LAS bf16x8*)(lds + PG8_SA(b, h) + aoff + m * 2048 + k * 1024); } while (0)
#define PG8_LDB(dst, b, h) do { _Pragma("unroll") for (int n = 0; n < 2; ++n) _Pragma("unroll") for (int k = 0; k < 2; ++k) dst[n][k] = *(const PG8_LAS bf16x8*)(lds + PG8_SB(b, h) + boff + n * 2048 + k * 1024); } while (0)
#define PG8_MMA(ai, bj, At, Bt) do { __builtin_amdgcn_s_setprio(1); _Pragma("unroll") for (int m = 0; m < 4; ++m) _Pragma("unroll") for (int n = 0; n < 2; ++n) _Pragma("unroll") for (int k = 0; k < 2; ++k) \
        acc[ai][bj][m][n] = __builtin_amdgcn_mfma_f32_16x16x32_bf16(Bt[n][k], At[m][k], acc[ai][bj][m][n], 0, 0, 0); __builtin_amdgcn_s_setprio(0); } while (0)
#define PG8_WAIT_V(n) asm volatile("s_waitcnt vmcnt(" #n ")" ::: "memory")
#define PG8_WAIT_L(n) asm volatile("s_waitcnt lgkmcnt(" #n ")" ::: "memory")
#define PG8_BAR __builtin_amdgcn_s_barrier()
#define PG8_SCHED __builtin_amdgcn_sched_barrier(0)
    Unit cur, nxt; int ui = 0;
    if (!S.next(0, cur)) return;
    f32x4 acc[2][2][4][2];
#pragma unroll
    for (int a = 0; a < 2; ++a)
#pragma unroll
        for (int b = 0; b < 2; ++b)
#pragma unroll
            for (int m = 0; m < 4; ++m)
#pragma unroll
                for (int n = 0; n < 2; ++n) acc[a][b][m][n] = (f32x4){0.f, 0.f, 0.f, 0.f};
    bf16x8 At[4][2], B0[2][2], B1[2][2];
    const char* cA = (const char*)g.A + (size_t)cur.pm * tstep; const char* cB = (const char*)g.Bt + (size_t)cur.pn * tstep;
    S.a_ready(cur);
    if constexpr (SP2) {
        PG8_STAGE(PG8_SB(0, 0), cB, voffB); PG8_STAGE(PG8_SB(0, 1), cB + hstep, voffB); PG8_STAGE(PG8_SA(0, 0), cA, voffA); PG8_STAGE(PG8_SA(0, 1), cA + hstep, voffA);
        if (wr == 1) PG8_BAR;
        PG8_WAIT_V(2); PG8_BAR;
        PG8_STAGE(PG8_SB(1, 0), cB + kstep, voffB); PG8_STAGE(PG8_SA(1, 0), cA + kstep, voffA); PG8_STAGE(PG8_SB(1, 1), cB + hstep + kstep, voffB);
        PG8_WAIT_V(6); PG8_BAR;
    } else {
        PG8_STAGE(PG8_SB(0, 0), cB, voffB); PG8_STAGE(PG8_SA(0, 0), cA, voffA); PG8_STAGE(PG8_SB(0, 1), cB + hstep, voffB); PG8_STAGE(PG8_SA(0, 1), cA + hstep, voffA);
        if (wr == 1) PG8_BAR;
        PG8_WAIT_V(4); PG8_BAR;
        PG8_STAGE(PG8_SB(1, 0), cB + kstep, voffB); PG8_STAGE(PG8_SA(1, 0), cA + kstep, voffA); PG8_STAGE(PG8_SB(1, 1), cB + hstep + kstep, voffB);
        PG8_WAIT_V(6); PG8_BAR;
    }
    for (;;) {
        const bool has_next = S.next(ui + 1, nxt);
        const char* nA = has_next ? (const char*)g.A + (size_t)nxt.pm * tstep : cA; const char* nB = has_next ? (const char*)g.Bt + (size_t)nxt.pn * tstep : cB;
        for (int t = 0; t < nt; t += 2) {
            const bool last = (t == nt - 2);
            const char* a1 = cA + (size_t)(t + 1) * kstep;
            const char* a2 = last ? nA : cA + (size_t)(t + 2) * kstep; const char* b2 = last ? nB : cB + (size_t)(t + 2) * kstep;
            const char* a3 = a2 + kstep; const char* b3 = b2 + kstep;
            if (last && has_next) S.a_ready(nxt);
            if constexpr (SP2) {
            PG8_LDB(B0, 0, 0); PG8_LDB(B1, 0, 1); PG8_SCHED; PG8_LDA(At, 0, 0); PG8_STAGE(PG8_SA(1, 1), a1 + hstep, voffA);
            PG8_WAIT_V(8); PG8_WAIT_L(0); PG8_BAR; PG8_MMA(0, 0, At, B0); PG8_MMA(0, 1, At, B1); PG8_BAR; PG8_SCHED;
            PG8_LDA(At, 0, 1); PG8_STAGE(PG8_SB(0, 0), b2, voffB); PG8_STAGE(PG8_SB(0, 1), b2 + hstep, voffB); PG8_STAGE(PG8_SA(0, 0), a2, voffA);
            PG8_WAIT_V(8); PG8_WAIT_L(0); PG8_BAR; PG8_MMA(1, 0, At, B0); PG8_MMA(1, 1, At, B1); PG8_BAR; PG8_SCHED;
            PG8_LDB(B0, 1, 0); PG8_LDB(B1, 1, 1); PG8_SCHED; PG8_LDA(At, 1, 0); PG8_STAGE(PG8_SA(0, 1), a2 + hstep, voffA);
            PG8_WAIT_V(8); PG8_WAIT_L(0); PG8_BAR; PG8_MMA(0, 0, At, B0); PG8_MMA(0, 1, At, B1); PG8_BAR; PG8_SCHED;
            PG8_LDA(At, 1, 1); PG8_STAGE(PG8_SB(1, 0), b3, voffB); PG8_STAGE(PG8_SB(1, 1), b3 + hstep, voffB); PG8_STAGE(PG8_SA(1, 0), a3, voffA);
            PG8_WAIT_V(8); PG8_WAIT_L(0); PG8_BAR; PG8_MMA(1, 0, At, B0); PG8_MMA(1, 1, At, B1); PG8_BAR; PG8_SCHED;
            } else {
            PG8_LDB(B0, 0, 0); PG8_SCHED; PG8_LDA(At, 0, 0); PG8_STAGE(PG8_SA(1, 1), a1 + hstep, voffA);
            PG8_WAIT_L(8); PG8_BAR; PG8_WAIT_L(0); PG8_MMA(0, 0, At, B0); PG8_BAR; PG8_SCHED;
            PG8_LDB(B1, 0, 1); PG8_STAGE(PG8_SB(0, 0), b2, voffB);
            PG8_BAR; PG8_WAIT_L(0); PG8_MMA(0, 1, At, B1); PG8_BAR;
            PG8_LDA(At, 0, 1); PG8_STAGE(PG8_SA(0, 0), a2, voffA);
            PG8_BAR; PG8_WAIT_L(0); PG8_MMA(1, 0, At, B0); PG8_BAR; PG8_SCHED;
            PG8_STAGE(PG8_SB(0, 1), b2 + hstep, voffB);
            PG8_WAIT_V(6); PG8_BAR; PG8_MMA(1, 1, At, B1); PG8_BAR;
            PG8_LDB(B0, 1, 0); PG8_SCHED; PG8_LDA(At, 1, 0); PG8_STAGE(PG8_SA(0, 1), a2 + hstep, voffA);
            PG8_WAIT_L(8); PG8_BAR; PG8_WAIT_L(0); PG8_MMA(0, 0, At, B0); PG8_BAR; PG8_SCHED;
            PG8_LDB(B1, 1, 1); PG8_STAGE(PG8_SB(1, 0), b3, voffB);
            PG8_BAR; PG8_WAIT_L(0); PG8_MMA(0, 1, At, B1); PG8_BAR;
            PG8_LDA(At, 1, 1); PG8_STAGE(PG8_SA(1, 0), a3, voffA);
            PG8_BAR; PG8_WAIT_L(0); PG8_MMA(1, 0, At, B0); PG8_BAR; PG8_SCHED;
            PG8_STAGE(PG8_SB(1, 1), b3 + hstep, voffB);
            PG8_WAIT_V(6); PG8_BAR; PG8_MMA(1, 1, At, B1); PG8_BAR;
            }
        }
        if constexpr (ALIGN_EPI) { if (wr == 0) PG8_BAR; }
        if constexpr (!Epi::AFTER_DRAIN) { E(acc, cur, wr, wc, fr, fq); S.done(cur); }
        if (!has_next) break;
#pragma unroll
        for (int a = 0; a < 2; ++a)
#pragma unroll
            for (int b = 0; b < 2; ++b)
#pragma unroll
                for (int m = 0; m < 4; ++m)
#pragma unroll
                    for (int n = 0; n < 2; ++n) acc[a][b][m][n] = (f32x4){0.f, 0.f, 0.f, 0.f};
        cur = nxt; cA = nA; cB = nB; ++ui;
        if constexpr (ALIGN_EPI) { if (wr == 1) PG8_BAR; }
    }
    PG8_WAIT_V(0);
    if constexpr (!ALIGN_EPI) { if (wr == 0) PG8_BAR; }
    PG8_BAR;
    if constexpr (Epi::AFTER_DRAIN) { E.fused(acc, cur, wr, wc, fr, fq, lds, wid, lane); S.done(cur); }
#undef PG8_SA
#undef PG8_SB
#undef PG8_STAGE
#undef PG8_LDA
#undef PG8_LDB
#undef PG8_MMA
#undef PG8_WAIT_V
#undef PG8_WAIT_L
#undef PG8_BAR
#undef PG8_SCHED
}
}
namespace att {
#define ATT_LAS __attribute__((address_space(3)))
using bf16x8 = __attribute__((ext_vector_type(8))) short;
using s16x4 = __attribute__((ext_vector_type(4))) short;
using f32x16 = __attribute__((ext_vector_type(16))) float;
using u32x4 = __attribute__((ext_vector_type(4))) unsigned;
typedef unsigned short bf16_t;
typedef ATT_LAS const char* lds_cptr;
typedef ATT_LAS char* lds_ptr;
typedef short v4i16_t __attribute__((ext_vector_type(4)));
typedef float f32x2_t __attribute__((ext_vector_type(2))); typedef __bf16 bf16x2_t __attribute__((ext_vector_type(2)));
constexpr int SEQ = 16384, PITCH = 4096;
constexpr int COL_QA = 0, COL_KA = 256, COL_VA = 512, COL_GA = 768, COL_QD = 1024, COL_KD = 1792, COL_VD = 2560, COL_GD = 3328;
constexpr int SLOTB = 8192;
constexpr int LDS_K = 0, LDS_V = 2 * SLOTB, LDS_WS = 4 * SLOTB, LDS_OST = LDS_WS + 8 * 64 * 4, LDS_FLAG = LDS_OST + 8 * 4096, LDS_Q = LDS_FLAG + 128, LDS_END = LDS_Q + 64;
constexpr float SB_DEAD = 152.0f;
__device__ __forceinline__ int crow(int r, int hi) { return (r & 3) + 8 * (r >> 2) + 4 * hi; }
__device__ __forceinline__ unsigned cvtpk_s(float lo, float hi) { f32x2_t v = {lo, hi}; bf16x2_t b = __builtin_convertvector(v, bf16x2_t); return __builtin_bit_cast(unsigned, b); }
__device__ __forceinline__ float bf2f(unsigned short b) { return __uint_as_float((unsigned)b << 16); }
__device__ __forceinline__ void glds16(const void* gsrc, unsigned lds_dst) { unsigned keep;
    asm volatile("s_mov_b32 %0, m0\n\ts_mov_b32 m0, %2\n\ts_nop 0\n\tglobal_load_lds_dwordx4 %1, off\n\ts_mov_b32 m0, %0" : "=&s"(keep) : "v"(gsrc), "s"(lds_dst) : "memory"); }
#define ATT_WAIT_BAR() asm volatile("s_waitcnt vmcnt(0) lgkmcnt(0)\n\ts_barrier" ::: "memory")
__device__ __forceinline__ s16x4 vtr(lds_cptr p) { return __builtin_bit_cast(s16x4, __builtin_amdgcn_ds_read_tr16_b64_v4i16((ATT_LAS v4i16_t*)p)); }

__device__ __forceinline__ void qkt(f32x16& p0, f32x16& p1, lds_cptr kp, const bf16x8* qr, const f32x16& cinit) {
#pragma unroll
    for (int d0 = 0; d0 < 4; ++d0) {
        const bf16x8 b0 = *(const ATT_LAS bf16x8*)(kp + d0 * 2048);
        const bf16x8 b1 = *(const ATT_LAS bf16x8*)(kp + d0 * 2048 + 512);
        if (d0 == 0) { p0 = __builtin_amdgcn_mfma_f32_32x32x16_bf16(b0, qr[0], cinit, 0, 0, 0); p1 = __builtin_amdgcn_mfma_f32_32x32x16_bf16(b1, qr[0], cinit, 0, 0, 0); }
        else { p0 = __builtin_amdgcn_mfma_f32_32x32x16_bf16(b0, qr[d0], p0, 0, 0, 0); p1 = __builtin_amdgcn_mfma_f32_32x32x16_bf16(b1, qr[d0], p1, 0, 0, 0); }
    }
}
__device__ __forceinline__ void pv(f32x16* o, lds_cptr vp, bf16x8 pa0, bf16x8 pa1, bf16x8 pa2, bf16x8 pa3) {
#pragma unroll
    for (int d0 = 0; d0 < 2; ++d0) { s16x4 lo[4], hi[4];
#pragma unroll
        for (int ks = 0; ks < 4; ++ks) { lo[ks] = vtr(vp + d0 * 4096 + ks * 1024); hi[ks] = vtr(vp + d0 * 4096 + ks * 1024 + 512); }
#define ATT_PK(k) (bf16x8){lo[k][0], lo[k][1], lo[k][2], lo[k][3], hi[k][0], hi[k][1], hi[k][2], hi[k][3]}
        o[d0] = __builtin_amdgcn_mfma_f32_32x32x16_bf16(pa0, ATT_PK(0), o[d0], 0, 0, 0);
        o[d0] = __builtin_amdgcn_mfma_f32_32x32x16_bf16(pa1, ATT_PK(1), o[d0], 0, 0, 0);
        o[d0] = __builtin_amdgcn_mfma_f32_32x32x16_bf16(pa2, ATT_PK(2), o[d0], 0, 0, 0);
        o[d0] = __builtin_amdgcn_mfma_f32_32x32x16_bf16(pa3, ATT_PK(3), o[d0], 0, 0, 0);
#undef ATT_PK
    }
}
__device__ __forceinline__ bf16x8 pack8(const float* a) { u32x4 w; w.x = cvtpk_s(a[0], a[1]); w.y = cvtpk_s(a[2], a[3]); w.z = cvtpk_s(a[4], a[5]); w.w = cvtpk_s(a[6], a[7]); return __builtin_bit_cast(bf16x8, w); }

template <bool MASK> __device__ __forceinline__ void sb_tile(const f32x16& p0, const f32x16& p1, float& Rsum, int qrel, int hi, bf16x8& pa0, bf16x8& pa1, bf16x8& pa2, bf16x8& pa3) {
    float run = Rsum; unsigned pw[16];
#pragma unroll
    for (int g = 7; g >= 0; --g) {
        float z[4], sp[4];
#pragma unroll
        for (int e = 0; e < 4; ++e) { const int idx = 4 * g + e; z[e] = (idx < 16) ? p0[idx] : p1[idx - 16];
            sp[e] = __builtin_fmaxf(z[e], 0.f) + __builtin_amdgcn_logf(1.0f + __builtin_amdgcn_exp2f(-__builtin_fabsf(z[e])));
            if (MASK) { if (8 * g + 4 * hi + e >= qrel) sp[e] = 0.f; } }
        const float e2 = sp[3], e1 = sp[3] + sp[2], e0 = e1 + sp[1], T = e0 + sp[0];
        const auto rr = __builtin_amdgcn_permlane32_swap(__float_as_uint(T), __float_as_uint(T), false, false);
        const float tev = __uint_as_float(rr[0]), tod = __uint_as_float(rr[1]);
        const float off = run + (hi ? 0.f : tod);
        run += tev + tod;
        float a[4];
        a[0] = __builtin_amdgcn_exp2f((z[0] - sp[0]) - (off + e0)); a[1] = __builtin_amdgcn_exp2f((z[1] - sp[1]) - (off + e1));
        a[2] = __builtin_amdgcn_exp2f((z[2] - sp[2]) - (off + e2)); a[3] = __builtin_amdgcn_exp2f((z[3] - sp[3]) - off);
        if (MASK) {
#pragma unroll
            for (int e = 0; e < 4; ++e) if (8 * g + 4 * hi + e >= qrel) a[e] = 0.f; }
        pw[2 * g] = cvtpk_s(a[0], a[1]); pw[2 * g + 1] = cvtpk_s(a[2], a[3]);
    }
    Rsum = run;
    pa0 = __builtin_bit_cast(bf16x8, (u32x4){pw[0], pw[1], pw[2], pw[3]}); pa1 = __builtin_bit_cast(bf16x8, (u32x4){pw[4], pw[5], pw[6], pw[7]});
    pa2 = __builtin_bit_cast(bf16x8, (u32x4){pw[8], pw[9], pw[10], pw[11]}); pa3 = __builtin_bit_cast(bf16x8, (u32x4){pw[12], pw[13], pw[14], pw[15]});
}

struct SbArgs { const bf16_t* proj; bf16_t* mix; };
template <bool EARLY> __device__ __forceinline__ void sb_unit(int h, int qb, const SbArgs& A, lds_ptr shm) {
    int tid = threadIdx.x; asm volatile("" : "+v"(tid));
    const int lane = tid & 63, r32 = lane & 31, hi = lane >> 5; const int wid = __builtin_amdgcn_readfirstlane(tid >> 6);
    const int q0 = qb * 256;
    const bf16_t* Qw = A.proj + (size_t)(q0 + wid * 32) * PITCH + COL_QA + h * 64;
    const bf16_t* Kh = A.proj + COL_KA + h * 64; const bf16_t* Vh = A.proj + COL_VA + h * 64;
    const unsigned lds0 = (unsigned)(size_t)shm;
    ATT_LAS float* wsf = (ATT_LAS float*)(shm + LDS_WS) + wid * 64;
    volatile ATT_LAS unsigned* flags = (volatile ATT_LAS unsigned*)(shm + LDS_FLAG);
    const bf16_t* ksrc = Kh + (size_t)lane * PITCH + wid * 8;
    const bf16_t* vsrc = Vh + (size_t)(16 * (wid & 3) + (lane >> 2)) * PITCH + (wid >> 2) * 32 + (lane & 3) * 8;
    const unsigned kdst = lds0 + LDS_K + wid * 1024, vdst = lds0 + LDS_V + wid * 1024;
    const lds_cptr kp0 = (lds_cptr)shm + LDS_K + hi * 1024 + r32 * 16;
    const lds_cptr vp0 = (lds_cptr)shm + LDS_V + ((lane >> 4) & 1) * 32 + (lane & 3) * 8 + (4 * hi + ((lane & 15) >> 2)) * 64;
#define SB_DMA(jt, slot) do { glds16(ksrc + (size_t)(jt) * 64 * PITCH, (unsigned)__builtin_amdgcn_readfirstlane(kdst + (slot))); glds16(vsrc + (size_t)(jt) * 64 * PITCH, (unsigned)__builtin_amdgcn_readfirstlane(vdst + (slot))); } while (0)
    const int NT = 4 * qb + 4, jdiag = 4 * qb + (wid >> 1), qrel = 32 * (wid & 1) + r32;
    if (lane == 0) { flags[wid] = 0u; flags[8 + wid] = 0u; }
    SB_DMA(NT - 1, 0);
    bf16x8 qr[4];
#pragma unroll
    for (int d0 = 0; d0 < 4; ++d0) qr[d0] = *(const bf16x8*)(Qw + (size_t)r32 * PITCH + d0 * 16 + hi * 8);
    f32x16 o[2]; o[0] = f32x16{}; o[1] = f32x16{}; const f32x16 zero = f32x16{};
    float Rsum = 0.f; bool dead = false;
    for (int it = 0;; ++it) {
        const int jt = NT - 1 - it, slot = (it & 1) * SLOTB;
        ATT_WAIT_BAR();
        if (EARLY && it > 0) { const int fb = ((it - 1) & 1) * 8; unsigned all = 1u;
#pragma unroll
            for (int w = 0; w < 8; ++w) all &= flags[fb + w];
            if (all) break; }
        if (jt > 0) SB_DMA(jt - 1, slot ^ SLOTB);
        if (jt <= jdiag && !dead) {
            f32x16 p0, p1; bf16x8 pa0, pa1, pa2, pa3;
            qkt(p0, p1, kp0 + slot, qr, zero);
            __builtin_amdgcn_sched_barrier(0);
            if (jt == jdiag) sb_tile<true>(p0, p1, Rsum, qrel, hi, pa0, pa1, pa2, pa3); else sb_tile<false>(p0, p1, Rsum, qrel, hi, pa0, pa1, pa2, pa3);
            __builtin_amdgcn_sched_barrier(0);
            pv(o, vp0 + slot, pa0, pa1, pa2, pa3);
            if (EARLY) dead = __all(Rsum > SB_DEAD);
        }
        if (EARLY && lane == 0) flags[(it & 1) * 8 + wid] = dead ? 1u : 0u;
        if (jt == 0) break;
    }
#undef SB_DMA
    { ATT_LAS bf16_t* stg = (ATT_LAS bf16_t*)(shm + LDS_OST) + wid * 2048;
#pragma unroll
      for (int r = 0; r < 16; ++r) { const int orow = crow(r, hi);
#pragma unroll
          for (int d0 = 0; d0 < 2; ++d0) stg[orow * 64 + d0 * 32 + r32] = (bf16_t)(cvtpk_s(o[d0][r], 0.f) & 0xffffu); }
      asm volatile("s_waitcnt lgkmcnt(0)" ::: "memory");
      const bf16_t* Gw = A.proj + (size_t)(q0 + wid * 32) * PITCH + COL_GA + h * 64; bf16_t* Mw = A.mix + (size_t)(q0 + wid * 32) * 1024 + h * 64;
#pragma unroll
      for (int i = 0; i < 4; ++i) { const int row = i * 8 + (lane >> 3), ch = lane & 7; const u32x4 v = *(const ATT_LAS u32x4*)(stg + row * 64 + ch * 8); const u32x4 gv = *(const u32x4*)(Gw + (size_t)row * PITCH + ch * 8);
          u32x4 w;
#pragma unroll
          for (int k = 0; k < 4; ++k) { const float lo = __uint_as_float(v[k] << 16) * __uint_as_float(gv[k] << 16), hi2 = __uint_as_float(v[k] & 0xffff0000u) * __uint_as_float(gv[k] & 0xffff0000u); w[k] = cvtpk_s(lo, hi2); }
          *(u32x4*)(Mw + (size_t)row * 1024 + ch * 8) = w; } }
    asm volatile("s_waitcnt vmcnt(0) lgkmcnt(0)\n\ts_barrier" ::: "memory");
}

struct DilArgs { const bf16_t* proj; unsigned char* ws; float* lp; const float* qg; const float* kg; };
template <unsigned long long OB0, unsigned long long OB1, unsigned long long OB2> __device__ __forceinline__ void dil_unit(int h, int p, int c, int blk, const DilArgs& A, lds_ptr shm) {
    int tid = threadIdx.x; asm volatile("" : "+v"(tid));
    const int lane = tid & 63, r32 = lane & 31, hi = lane >> 5; const int wid = __builtin_amdgcn_readfirstlane(tid >> 6);
    const int rsh = 2 * p, u0 = blk * 256;
    const unsigned lds0 = (unsigned)(size_t)shm;
    ATT_LAS float* wsf = (ATT_LAS float*)(shm + LDS_WS) + wid * 64;
    const bf16_t* Kh = A.proj + COL_KD + h * 64; const bf16_t* Vh = A.proj + COL_VD + h * 64;
    const unsigned kdst = lds0 + LDS_K + wid * 1024, vdst = lds0 + LDS_V + wid * 1024;
    const lds_cptr kp0 = (lds_cptr)shm + LDS_K + hi * 1024 + r32 * 16;
    const lds_cptr vp0 = (lds_cptr)shm + LDS_V + ((lane >> 4) & 1) * 32 + (lane & 3) * 8 + (4 * hi + ((lane & 15) >> 2)) * 64;
    const int kbase_k = u0 - 128 + lane, kbase_v = u0 - 128 + 16 * (wid & 3) + (lane >> 2);
#define DIL_DMA(j, slot) do { int ik_ = kbase_k + 64 * (j); ik_ = ik_ < 0 ? 0 : ik_; int iv_ = kbase_v + 64 * (j); iv_ = iv_ < 0 ? 0 : iv_; \
        glds16(Kh + (size_t)(c + (ik_ << rsh)) * PITCH + wid * 8, (unsigned)__builtin_amdgcn_readfirstlane(kdst + (slot))); \
        glds16(Vh + (size_t)(c + (iv_ << rsh)) * PITCH + (wid >> 2) * 32 + (lane & 3) * 8, (unsigned)__builtin_amdgcn_readfirstlane(vdst + (slot))); } while (0)
    const int jstart = (blk == 0) ? 2 : 0;
    DIL_DMA(jstart, 0);
    float gq = __builtin_fabsf(A.qg[lane]), gk = __builtin_fabsf(A.kg[lane]);
#pragma unroll
    for (int s = 1; s < 64; s <<= 1) { gq = __builtin_fmaxf(gq, __shfl_xor(gq, s)); gk = __builtin_fmaxf(gk, __shfl_xor(gk, s)); }
    const float Mb = 64.0f * 0.125f * 1.4426950408889634f * 1.02f * gq * gk;
    f32x16 negm;
#pragma unroll
    for (int r = 0; r < 16; ++r) negm[r] = -Mb;
    const int tq = c + ((u0 + wid * 32 + r32) << rsh);
    const bf16_t* Qp = A.proj + (size_t)tq * PITCH + COL_QD + h * 64;
    bf16x8 qr[4];
#pragma unroll
    for (int d0 = 0; d0 < 4; ++d0) qr[d0] = *(const bf16x8*)(Qp + d0 * 16 + hi * 8);
    f32x16 o[2]; o[0] = f32x16{}; o[1] = f32x16{};
    float l_reg = 0.f;
    const int j0 = wid >> 1, qoff = 32 * (wid & 1) + r32;
    for (int j = jstart; j < 6; ++j) {
        const int slot = ((j - jstart) & 1) * SLOTB;
        ATT_WAIT_BAR();
        if (j < 5) DIL_DMA(j + 1, slot ^ SLOTB);
        const int jrel = j - j0;
        if (jrel >= 0 && jrel <= 2) {
            f32x16 p0, p1; qkt(p0, p1, kp0 + slot, qr, negm);
            float a[32];
#pragma unroll
            for (int idx = 0; idx < 32; ++idx) { const float z = (idx < 16) ? p0[idx] : p1[idx - 16]; float v = __builtin_amdgcn_exp2f(z);
                const int key = (idx < 16) ? crow(idx, hi) : 32 + crow(idx - 16, hi); const int d = key - qoff;
                if (jrel == 0) { if (d < 0) v = 0.f; } else if (jrel == 2) { if (d > 0) v = 0.f; }
                a[idx] = v; l_reg += v; }
            pv(o, vp0 + slot, pack8(a), pack8(a + 8), pack8(a + 16), pack8(a + 24));
        }
    }
#undef DIL_DMA
    { const auto rr = __builtin_amdgcn_permlane32_swap(__float_as_uint(l_reg), __float_as_uint(l_reg), false, false); l_reg = __uint_as_float(rr[0]) + __uint_as_float(rr[1]); }
    if (hi == 0) { wsf[32 + r32] = l_reg; A.lp[((size_t)p * SEQ + tq) * 12 + h] = l_reg; }
    asm volatile("s_waitcnt lgkmcnt(0)" ::: "memory");
    float rli[16];
#pragma unroll
    for (int r = 0; r < 16; ++r) rli[r] = __builtin_amdgcn_rcpf(wsf[32 + crow(r, hi)]);
    { ATT_LAS bf16_t* stg = (ATT_LAS bf16_t*)(shm + LDS_OST) + wid * 2048;
#pragma unroll
      for (int r = 0; r < 16; ++r) { const int orow = crow(r, hi);
#pragma unroll
          for (int d0 = 0; d0 < 2; ++d0) stg[orow * 64 + d0 * 32 + r32] = (bf16_t)(cvtpk_s(o[d0][r] * rli[r], 0.f) & 0xffffu); }
      asm volatile("s_waitcnt lgkmcnt(0)" ::: "memory");
      const unsigned long long obo = (p == 0) ? OB0 : ((p == 1) ? OB1 : OB2); bf16_t* Ob = (bf16_t*)(A.ws + obo) + h * 64; const int op = (p == 1) ? 1024 : 768;
#pragma unroll
      for (int i = 0; i < 4; ++i) { const int row = i * 8 + (lane >> 3), ch = lane & 7; const u32x4 v = *(const ATT_LAS u32x4*)(stg + row * 64 + ch * 8);
          const int t = c + ((u0 + wid * 32 + row) << rsh);
          *(u32x4*)(Ob + (size_t)t * op + ch * 8) = v; } }
    asm volatile("s_waitcnt vmcnt(0) lgkmcnt(0)\n\ts_barrier" ::: "memory");
}
#undef ATT_WAIT_BAR
}
constexpr int NWAVES = 8;
constexpr int N_LAUNCHES = MK_N_LAUNCHES;
constexpr int DEPTH = 4, SEQ = 16384, DM = 1024, NIN = 4096;
constexpr int N_PHASES = 1 + 4 * DEPTH;
constexpr size_t MiB = 1u << 20;
constexpr size_t WS_CTL = 0, CTL_ZERO_BYTES = 1 * MiB;
constexpr size_t WS_ROPE = 1 * MiB;
constexpr size_t WS_SSQ = 2 * MiB;
constexpr size_t WS_LP = 3 * MiB;
constexpr size_t WS_W = 6 * MiB, W_STRIDE = 10 * MiB, W_OUT_OFF = 8 * MiB;
constexpr size_t WS_XB = 26 * MiB;
constexpr size_t WS_MIX = 58 * MiB;
constexpr size_t WS_O3 = 90 * MiB;
constexpr size_t WS_PROJ = 114 * MiB;
constexpr size_t WS_END = 242 * MiB;
constexpr int CW_BAR = 4096;
constexpr int CW_QUEUE = 16384;
constexpr int RING_OFF = 0, RING_BYTES = 131072;
constexpr int LDSCTL_OFF = RING_BYTES, MISC_OFF = LDSCTL_OFF + 320;
constexpr int LDS_BYTES = 147456;
static_assert(att::LDS_END <= RING_BYTES, "attention scratch fits the ring region");

#define GAS __attribute__((address_space(1)))
#define LAS __attribute__((address_space(3)))
typedef unsigned short bf16;
typedef unsigned v4u __attribute__((ext_vector_type(4)));
typedef float f32x4 __attribute__((ext_vector_type(4)));
typedef GAS unsigned gu32;
#define RLX_AGENT __ATOMIC_RELAXED, __HIP_MEMORY_SCOPE_AGENT
#define LDS_WAIT() asm volatile("s_waitcnt lgkmcnt(0)" ::: "memory")
#define VM_WAIT() asm volatile("s_waitcnt vmcnt(0)" ::: "memory")
__device__ __forceinline__ unsigned f2bf(float f) { unsigned u = __builtin_bit_cast(unsigned, f); return (u + 0x7fffu + ((u >> 16) & 1u)) >> 16; }
__device__ __forceinline__ unsigned pk2(float lo, float hi) { return f2bf(lo) | (f2bf(hi) << 16); }
#define XB_TMO      128
#define XB_XCNT(j)  (256  + 64 * (j))
#define XB_XSUB(j)  (1280 + 64 * (j))
#define XB_XGEN(j)  (2304 + 64 * (j))
#define XB_TOP      3328
#define XB_TOPGEN   3392
#define XCD_BAR_WORDS 3456
#define XB_SPIN_CAP (1u << 18)

__device__ __forceinline__ unsigned xb_ld(unsigned* p)              { return __hip_atomic_load(p, __ATOMIC_RELAXED, __HIP_MEMORY_SCOPE_AGENT); }
__device__ __forceinline__ unsigned xb_add(unsigned* p, unsigned v) { return __hip_atomic_fetch_add(p, v, __ATOMIC_RELAXED, __HIP_MEMORY_SCOPE_AGENT); }
__device__ __forceinline__ unsigned xb_xcc_id() { return (unsigned)__builtin_amdgcn_s_getreg((3 << 11) | 20) & 0xFu; }
#define XB_SPIN(cond, bar) do { unsigned _sp = 0; while (cond) { __builtin_amdgcn_s_sleep(1); \
    if ((++_sp & 255u) == 0u) { if (xb_ld(&(bar)[XB_TMO])) break; if (_sp > XB_SPIN_CAP) { atomicAdd(&(bar)[XB_TMO], 1u); break; } } } } while (0)

struct XcdBarrier {
    unsigned* bar; unsigned x;
    volatile LAS unsigned* st;
};

__device__ __forceinline__ XcdBarrier xcd_barrier_post(unsigned* bar, volatile LAS unsigned* st) {
    XcdBarrier b; b.bar = bar; b.x = xb_xcc_id(); b.st = st;
    if (threadIdx.x == 0) (void)xb_add(&bar[XB_XCNT(b.x)], 1u);
    return b;
}
__device__ __forceinline__ void xcd_barrier_complete(unsigned* bar, unsigned x, unsigned& nloc, unsigned& nx) {
    const unsigned G = gridDim.x * gridDim.y * gridDim.z;
    unsigned sum, cnt, mine, sp = 0u;
    for (;;) {
        sum = 0u; cnt = 0u; mine = 0u;
#pragma unroll
        for (unsigned j = 0; j < 16; ++j) { const unsigned c = xb_ld(&bar[XB_XCNT(j)]); sum += c; cnt += (c > 0u) ? 1u : 0u; mine = (j == x) ? c : mine; }
        if (sum == G) break;
        __builtin_amdgcn_s_sleep(1);
        if ((++sp & 255u) == 0u) { if (xb_ld(&bar[XB_TMO])) break; if (sp > XB_SPIN_CAP) { atomicAdd(&bar[XB_TMO], 1u); break; } }
    }
    nloc = mine > 0u ? mine : 1u; nx = cnt > 0u ? cnt : 1u;
}

__device__ __forceinline__ void xcd_barrier(const XcdBarrier& b) {
    asm volatile("s_waitcnt vmcnt(0)" ::: "memory");
    __syncthreads();
    if (threadIdx.x == 0) {
        unsigned* bar = b.bar;
        __builtin_amdgcn_s_waitcnt(0);
        unsigned nloc = b.st[0], nx = b.st[1];
        if (nloc == 0u) { xcd_barrier_complete(bar, b.x, nloc, nx); b.st[0] = nloc; b.st[1] = nx; }
        const unsigned old = xb_add(&bar[XB_XSUB(b.x)], 1u);
        const unsigned gen = old / nloc;
        if (old + 1u == (gen + 1u) * nloc) {
            __builtin_amdgcn_fence(__ATOMIC_RELEASE, "agent");
            asm volatile("s_waitcnt vmcnt(0)" ::: "memory");
            const unsigned og = xb_add(&bar[XB_TOP], 1u);
            const unsigned tg = og / nx;
            if (og + 1u == (tg + 1u) * nx) xb_add(&bar[XB_TOPGEN], 1u);
            else XB_SPIN(xb_ld(&bar[XB_TOPGEN]) == tg, bar);
            __builtin_amdgcn_fence(__ATOMIC_ACQUIRE, "agent");
            xb_add(&bar[XB_XGEN(b.x)], 1u);
            asm volatile("s_waitcnt vmcnt(0)" ::: "memory");
        } else {
            XB_SPIN(xb_ld(&bar[XB_XGEN(b.x)]) == gen, bar);
            __builtin_amdgcn_fence(__ATOMIC_ACQUIRE, "agent");
            asm volatile("s_waitcnt vmcnt(0)" ::: "memory");
        }
    }
    __syncthreads();
}
__device__ __forceinline__ float wave_sum(float v) {
#pragma unroll
    for (int o = 1; o < 64; o <<= 1) v += __shfl_xor(v, o);
    return v;
}
template <bool PERMN> __device__ __forceinline__ void transpose_item(const float* W, int K, int N, bf16* WT, const float* gk, LAS float* scr, int item, int lane) {
    const int nblk = N / 32, kb = item / nblk, nb = item % nblk, k0 = 64 * kb, n0 = 32 * nb;
#pragma unroll 8
    for (int i = 0; i < 32; ++i) { const int kk = 2 * i + (lane >> 5); float w = W[(size_t)(k0 + kk) * N + n0 + (lane & 31)]; if (gk) w *= gk[k0 + kk]; scr[kk * 33 + (lane & 31)] = w; }
    LDS_WAIT(); asm volatile("" ::: "memory");
    const int c = lane & 7;
#pragma unroll
    for (int j = 0; j < 4; ++j) { const int n = (lane >> 3) + 8 * j; const LAS float* s = scr + (8 * c) * 33 + n;
        v4u o; o.x = pk2(s[0 * 33], s[1 * 33]); o.y = pk2(s[2 * 33], s[3 * 33]); o.z = pk2(s[4 * 33], s[5 * 33]); o.w = pk2(s[6 * 33], s[7 * 33]);
        const int col = n0 + n; const int pos = PERMN ? ((col & ~255) + 128 * ((col >> 5) & 1) + 32 * ((col >> 6) & 3) + (col & 31)) : col;
        *(GAS v4u*)(WT + (size_t)pos * K + k0 + 8 * c) = o; }
    LDS_WAIT(); asm volatile("" ::: "memory");
}
struct KArgs { const float* x; const float* norm_g; const float* w_in; const float* q_norm_g; const float* k_norm_g; const float* w_out; float* out; unsigned char* ws; int ph_lo, ph_hi; };

__device__ __forceinline__ void convert_weights(const KArgs& a, int l, LAS unsigned char* lds, int vcu, int G) {
    int tid = threadIdx.x; asm volatile("" : "+v"(tid)); const int lane = tid & 63, wave = __builtin_amdgcn_readfirstlane(tid >> 6); const int gw = vcu * NWAVES + wave, NGW = G * NWAVES;
    LAS float* scr = (LAS float*)(lds + RING_OFF + wave * 16384);
    bf16* WinT = (bf16*)(a.ws + WS_W + (size_t)(l & 1) * W_STRIDE); bf16* WoutT = (bf16*)(a.ws + WS_W + (size_t)(l & 1) * W_STRIDE + W_OUT_OFF);
    constexpr int I_IN = (DM / 64) * (NIN / 32), I_OUT = (DM / 64) * (DM / 32);
    for (int it = gw; it < I_IN + I_OUT; it += NGW) {
        if (it < I_IN) transpose_item<true>(a.w_in + (size_t)l * DM * NIN, DM, NIN, WinT, a.norm_g + l * DM, scr, it, lane);
        else transpose_item<false>(a.w_out + (size_t)l * DM * DM, DM, DM, WoutT, nullptr, scr, it - I_IN, lane);
    }
}
__device__ __forceinline__ void sincos_acc(float angf, float& c, float& s) {
    const double ang = (double)angf; const double kq = __builtin_rint(ang * 0.63661977236758134308);
    const double r = __builtin_fma(-kq, 1.5707963267948966192, ang) - kq * 6.123233995736766036e-17; const double r2 = r * r;
    double sp = -1.0 / 1307674368000.0; sp = sp * r2 + 1.0 / 6227020800.0; sp = sp * r2 - 1.0 / 39916800.0; sp = sp * r2 + 1.0 / 362880.0; sp = sp * r2 - 1.0 / 5040.0; sp = sp * r2 + 1.0 / 120.0; sp = sp * r2 - 1.0 / 6.0; sp = sp * r2 * r + r;
    double cp = 1.0 / 87178291200.0; cp = cp * r2 - 1.0 / 479001600.0; cp = cp * r2 + 1.0 / 3628800.0; cp = cp * r2 - 1.0 / 40320.0; cp = cp * r2 + 1.0 / 720.0; cp = cp * r2 - 1.0 / 24.0; cp = cp * r2 + 0.5; cp = 1.0 - cp * r2;
    const int q = ((int)kq) & 3;
    const double sv = (q == 0) ? sp : (q == 1) ? cp : (q == 2) ? -sp : -cp, cv = (q == 0) ? cp : (q == 1) ? -sp : (q == 2) ? -cp : sp;
    c = (float)cv; s = (float)sv;
}
__device__ __forceinline__ float inv_freq(int i) {
    return i == 0 ? 1.0f : i == 1 ? 0.193922758102417f : i == 2 ? 0.03760603070259094f : i == 3 ? 0.00729266507551074f : i == 4 ? 0.001414213445968926f : i == 5 ? 0.00027424818836152554f : i == 6 ? 5.318296462064609e-05f : 1.0313385246263351e-05f;
}

#ifndef EN_A
#define EN_A 1
#endif
#ifndef EN_B
#define EN_B 1
#endif
#ifndef EN_B2
#define EN_B2 1
#endif
#ifndef EN_C
#define EN_C 1
#endif
#ifndef EN_P0
#define EN_P0 1
#endif
#ifndef EN_SB
#define EN_SB 1
#endif
#ifndef EN_DIL
#define EN_DIL 1
#endif
__global__ void __launch_bounds__(NWAVES * 64, 2) hsdg_fwd(KArgs args) {
    extern __shared__ __attribute__((aligned(16))) unsigned char lds_raw[];
    LAS unsigned char* lds = (LAS unsigned char*)lds_raw;
    volatile LAS unsigned* MISC = (volatile LAS unsigned*)(lds + MISC_OFF);
    const int tid0 = threadIdx.x;
    const int G = gridDim.x; const int bx = blockIdx.x; const int vcu = (G % 8 == 0) ? (bx % 8) * (G / 8) + bx / 8 : bx;
    unsigned char* ws = args.ws;
    gu32* ctl = (gu32*)(ws + WS_CTL);
    for (int u = tid0; u < (LDS_BYTES - LDSCTL_OFF) / 4; u += NWAVES * 64) ((LAS unsigned*)(lds + LDSCTL_OFF))[u] = 0u;
    __syncthreads();
    XcdBarrier bar; bar.bar = (unsigned*)(ctl + CW_BAR); bar.x = 0; bar.st = nullptr;
    if (N_LAUNCHES == 1) bar = xcd_barrier_post((unsigned*)(ctl + CW_BAR), MISC + 8);
#define GRID_BAR() do { if (N_LAUNCHES == 1) xcd_barrier(bar); } while (0)
    const int lo = args.ph_lo, hi = args.ph_hi;
#define IN(k) (lo <= (k) && (k) < hi)
#define BOTH(k) (IN(k) && IN((k) + 1))
    float* rope = (float*)(ws + WS_ROPE); float* ssq = (float*)(ws + WS_SSQ); float* lp = (float*)(ws + WS_LP);
    bf16* XB = (bf16*)(ws + WS_XB); bf16* MIX = (bf16*)(ws + WS_MIX); bf16* O3 = (bf16*)(ws + WS_O3); bf16* PROJ = (bf16*)(ws + WS_PROJ);

    if (EN_P0 && IN(0)) {
        convert_weights(args, 0, lds, vcu, G);
        int tid = threadIdx.x; asm volatile("" : "+v"(tid)); const int lane = tid & 63, wave = __builtin_amdgcn_readfirstlane(tid >> 6); const int gw = vcu * NWAVES + wave, NGW = G * NWAVES;
        for (int m = gw; m < SEQ; m += NGW) {
            const GAS f32x4* xr = (const GAS f32x4*)(args.x + (size_t)m * DM) + lane; f32x4 v[4]; float s2 = 0.f;
#pragma unroll
            for (int j = 0; j < 4; ++j) { v[j] = xr[64 * j]; s2 += (v[j].x * v[j].x + v[j].y * v[j].y) + (v[j].z * v[j].z + v[j].w * v[j].w); }
            s2 = wave_sum(s2);
            GAS unsigned long long* o8 = (GAS unsigned long long*)(XB + (size_t)m * DM) + lane;
#pragma unroll
            for (int j = 0; j < 4; ++j) o8[64 * j] = (unsigned long long)pk2(v[j].x, v[j].y) | ((unsigned long long)pk2(v[j].z, v[j].w) << 32);
            if (lane < 4) ssq[(size_t)lane * SEQ + m] = (lane == 0) ? s2 : 0.f;
        }
        for (int i = bx * (NWAVES * 64) + tid; i < SEQ * 8; i += G * NWAVES * 64) { const int pos = i >> 3, k = i & 7; float c, s; sincos_acc((float)pos * inv_freq(k), c, s); rope[pos * 16 + k] = c; rope[pos * 16 + 8 + k] = s; }
        if (BOTH(0)) GRID_BAR();
    }
    for (int l = 0; l < DEPTH; ++l) {
        const int pA = 1 + 4 * l, pB = pA + 1, pB2 = pA + 2, pC = pA + 3;
        bf16* WinT = (bf16*)(ws + WS_W + (size_t)(l & 1) * W_STRIDE); bf16* WoutT = (bf16*)(ws + WS_W + (size_t)(l & 1) * W_STRIDE + W_OUT_OFF);
        const float* qg = args.q_norm_g + l * 64; const float* kg = args.k_norm_g + l * 64;
        if (EN_A && IN(pA)) {
            pg8::Gemm g{XB, WinT, SEQ, NIN, DM}; pg8::StaticOrder S; S.init(SEQ, NIN, G, bx);
            pg8::EpiInProj E{PROJ, ssq, qg, kg, rope};
            pg8::gemm_phase<pg8::EpiInProj, pg8::StaticOrder, true, true>(lds + RING_OFF, g, S, E);
            if (BOTH(pA)) GRID_BAR();
        }
        if (EN_B && IN(pB)) {
            const att::SbArgs SA{PROJ, MIX};
            const att::DilArgs DA{PROJ, ws, lp, qg, kg};
            unsigned* qhead = (unsigned*)(ctl + CW_QUEUE + 64 * l);
            volatile LAS unsigned* qw = (volatile LAS unsigned*)(lds + RING_OFF + att::LDS_Q);
            constexpr unsigned NUNITS = 256u + 2304u;
            int tid = threadIdx.x; asm volatile("" : "+v"(tid));
            unsigned nxt = 0u;
            if (tid == 0) nxt = atomicAdd(qhead, 1u);
            for (;;) {
                if (tid == 0) { qw[0] = nxt; nxt = atomicAdd(qhead, 1u); }
                LDS_WAIT(); __builtin_amdgcn_s_barrier(); asm volatile("" ::: "memory");
                const unsigned ui = __builtin_amdgcn_readfirstlane(qw[0]);
                if (ui >= NUNITS) break;
                if (ui < 256u) { if (EN_SB) att::sb_unit<SB_EARLY_EXIT != 0>((int)(ui & 3u), 63 - (int)(ui >> 2), SA, (att::lds_ptr)(lds + RING_OFF)); }
                else { const unsigned d = ui - 256u; const int h = (int)(d / 192u), rem = (int)(d % 192u), p = rem >> 6, ub = rem & 63; const int bpc = 64 >> (2 * p);
                    if (EN_DIL) att::dil_unit<WS_XB, WS_MIX + 512, WS_O3>(h, p, ub / bpc, ub % bpc, DA, (att::lds_ptr)(lds + RING_OFF)); }
            }
            if (BOTH(pB)) GRID_BAR();
        }
        if (EN_B2 && IN(pB2)) {
            int tid = threadIdx.x; asm volatile("" : "+v"(tid));
            for (int i = bx * (NWAVES * 64) + tid; i < SEQ * 96; i += G * NWAVES * 64) {
                const int t = i / 96, r = i % 96, h = r >> 3, ch = r & 7;
                const float l1 = lp[((size_t)0 * SEQ + t) * 12 + h], l2 = lp[((size_t)1 * SEQ + t) * 12 + h], l3 = lp[((size_t)2 * SEQ + t) * 12 + h];
                const float inv = 1.0f / (l1 + l2 + l3); const float w1 = l1 * inv, w2 = l2 * inv, w3 = l3 * inv;
                const v4u o1 = *(const GAS v4u*)(XB + (size_t)t * 768 + h * 64 + ch * 8), o2 = *(const GAS v4u*)(MIX + (size_t)t * 1024 + 256 + h * 64 + ch * 8), o3 = *(const GAS v4u*)(O3 + (size_t)t * 768 + h * 64 + ch * 8);
                const v4u gv = *(const GAS v4u*)(PROJ + (size_t)t * att::PITCH + att::COL_GD + h * 64 + ch * 8);
                v4u w;
#pragma unroll
                for (int k = 0; k < 4; ++k) {
                    const float a = (w1 * __uint_as_float(o1[k] << 16) + w2 * __uint_as_float(o2[k] << 16) + w3 * __uint_as_float(o3[k] << 16)) * __uint_as_float(gv[k] << 16);
                    const float b = (w1 * __uint_as_float(o1[k] & 0xffff0000u) + w2 * __uint_as_float(o2[k] & 0xffff0000u) + w3 * __uint_as_float(o3[k] & 0xffff0000u)) * __uint_as_float(gv[k] & 0xffff0000u);
                    w[k] = pk2(a, b); }
                *(GAS v4u*)(MIX + (size_t)t * 1024 + 256 + h * 64 + ch * 8) = w;
            }
            if (l + 1 < DEPTH) convert_weights(args, l + 1, lds, vcu, G);
            if (BOTH(pB2)) GRID_BAR();
        }
        if (EN_C && IN(pC)) {
            pg8::Gemm g{MIX, WoutT, SEQ, DM, DM}; pg8::StaticOrder S; S.init(SEQ, DM, G, bx);
            pg8::EpiOutProj E{l == 0 ? args.x : args.out, args.out, XB, ssq};
            pg8::gemm_phase<pg8::EpiOutProj, pg8::StaticOrder, false, true>(lds + RING_OFF, g, S, E);
            if (pC + 1 < N_PHASES && BOTH(pC)) GRID_BAR();
        }
    }
#undef IN
#undef BOTH
#undef GRID_BAR
}

extern "C" void kernel_launch(void* const* d_in, const int* in_sizes, int n_in, void* d_out, int out_size, void* d_ws, size_t ws_size, hipStream_t stream) {
    static int grid = 0;
    if (grid == 0) {
        if (n_in != 6 || in_sizes[0] != SEQ * DM || out_size != SEQ * DM || ws_size < WS_END) { fprintf(stderr, "kernel_launch: unexpected shapes / workspace (n_in %d, in0 %d, out %d, ws %zu, need %zu)\n", n_in, n_in > 0 ? in_sizes[0] : -1, out_size, ws_size, (size_t)WS_END); grid = -1; return; }
        int dev = 0, cus = 0, per_cu = 0;
        if (hipGetDevice(&dev) != hipSuccess || hipDeviceGetAttribute(&cus, hipDeviceAttributeMultiprocessorCount, dev) != hipSuccess) { fprintf(stderr, "kernel_launch: device query failed\n"); grid = -1; return; }
        if (hipFuncSetAttribute((const void*)hsdg_fwd, hipFuncAttributeMaxDynamicSharedMemorySize, LDS_BYTES) != hipSuccess) { fprintf(stderr, "kernel_launch: hipFuncSetAttribute failed\n"); grid = -1; return; }
        if (hipOccupancyMaxActiveBlocksPerMultiprocessor(&per_cu, (const void*)hsdg_fwd, NWAVES * 64, LDS_BYTES) != hipSuccess || per_cu < 1) fprintf(stderr, "kernel_launch: note: occupancy query reports %d workgroups per CU\n", per_cu);
        (void)hipGetLastError();
        grid = cus;
        if (grid != 256) fprintf(stderr, "kernel_launch: %d CUs; the out-proj phase assumes 256 workgroups\n", grid);
    }
    if (grid < 0) return;
    if (hipMemsetAsync((char*)d_ws + WS_CTL, 0, CTL_ZERO_BYTES, stream) != hipSuccess) { fprintf(stderr, "kernel_launch: hipMemsetAsync failed\n"); return; }
    KArgs a{};
    a.x = (const float*)d_in[0]; a.norm_g = (const float*)d_in[1]; a.w_in = (const float*)d_in[2]; a.q_norm_g = (const float*)d_in[3]; a.k_norm_g = (const float*)d_in[4]; a.w_out = (const float*)d_in[5];
    a.out = (float*)d_out; a.ws = (unsigned char*)d_ws;
    if (N_LAUNCHES == 1) { a.ph_lo = 0; a.ph_hi = N_PHASES; hipLaunchKernelGGL(hsdg_fwd, dim3(grid), dim3(NWAVES * 64), LDS_BYTES, stream, a); }
    else for (int ph = 0; ph < N_PHASES; ++ph) { a.ph_lo = ph; a.ph_hi = ph + 1; hipLaunchKernelGGL(hsdg_fwd, dim3(grid), dim3(NWAVES * 64), LDS_BYTES, stream, a); }
    const hipError_t le = hipPeekAtLastError();
    if (le != hipSuccess) fprintf(stderr, "kernel_launch: launch failed: %s\n", hipGetErrorName(le));
}
```

```cpp
#include <hip/hip_runtime.h>
#include <cstdio>
#include <cstdint>
#ifndef MK_N_LAUNCHES
#define MK_N_LAUNCHES 1
#endif
#ifndef SB_EARLY_EXIT
#define SB_EARLY_EXIT 1
#endif
template <int X> __device__ __forceinline__ float lx_xor(float v) { return __builtin_bit_cast(float, __builtin_amdgcn_ds_swizzle(__builtin_bit_cast(int, v), (X << 10) | 0x1f)); }
__device__ __forceinline__ int lx_lane() { int l; asm volatile("v_mbcnt_lo_u32_b32 %0, -1, 0\n\tv_mbcnt_hi_u32_b32 %0, -1, %0" : "=v"(l)); return l; }
__device__ __forceinline__ float lx_xor32(float v) { return __builtin_bit_cast(float, __builtin_amdgcn_ds_bpermute((lx_lane() ^ 32) << 2, __builtin_bit_cast(int, v))); }
__device__ __forceinline__ float lx_sum32(float v) { return v + lx_xor32(v); }
__device__ __forceinline__ float lx_max32(float v) { return __builtin_fmaxf(v, lx_xor32(v)); }
__device__ __forceinline__ float lx_wave_sum(float v) { v += lx_xor<1>(v); v += lx_xor<2>(v); v += lx_xor<4>(v); v += lx_xor<8>(v); v += lx_xor<16>(v); return lx_sum32(v); }
__device__ __forceinline__ float lx_wave_max(float v) { v = __builtin_fmaxf(v, lx_xor<1>(v)); v = __builtin_fmaxf(v, lx_xor<2>(v)); v = __builtin_fmaxf(v, lx_xor<4>(v)); v = __builtin_fmaxf(v, lx_xor<8>(v)); v = __builtin_fmaxf(v, lx_xor<16>(v)); return lx_max32(v); }
__device__ __forceinline__ int lx_tid(int wave) { return wave * 64 + lx_lane(); }
namespace pg8 {
#define PG8_LAS __attribute__((address_space(3)))
typedef unsigned short bf16_t;
typedef short bf16x8 __attribute__((ext_vector_type(8)));
typedef float f32x4 __attribute__((ext_vector_type(4)));
typedef unsigned u32x4 __attribute__((ext_vector_type(4)));
constexpr int BM = 256, BK = 64, HALF = 128, HTB = HALF * BK * 2  , STAGE_BYTES = 8 * HTB, NXCD = 8, WGM = 8;

__host__ __device__ __forceinline__ int lds_byte(int r, int c) { const int st = (r >> 4) * 2 + (c >> 5), rr = r & 15, cc = c & 31, ob = rr * 64 + cc * 2; return st * 1024 + (ob ^ (((ob >> 9) & 1) << 5)); }
__host__ __device__ __forceinline__ void stage_rc(int b, int& R, int& C) { const int st = b / 1024, sb = b % 1024, swz = sb ^ (((sb >> 9) & 1) << 5); R = (st >> 1) * 16 + swz / 64; C = (st & 1) * 32 + (swz % 64) / 2; }
__host__ __device__ __forceinline__ int perm32(int rho) { const int n = rho >> 4, i = rho & 15; return 8 * (i >> 2) + 4 * n + (i & 3); }

struct Unit { int pm, pn; };
struct Gemm { const bf16_t* A; const bf16_t* Bt; int M, N, K; };

struct StaticOrder {
    int nM, nN, nwg, G, c;
    __host__ __device__ void init(int M, int N, int G_, int c_) { nM = M / BM; nN = N / BM; nwg = nM * nN; G = G_; c = c_; }
    __host__ __device__ bool next(int i, Unit& u) const {
        const long L = (long)i * G + c; if (L >= nwg) return false;
        int wgid = (int)L; { const int q = nwg / NXCD, r = nwg % NXCD, xcd = wgid % NXCD, off = wgid / NXCD; wgid = (xcd < r ? xcd * (q + 1) : r * (q + 1) + (xcd - r) * q) + off; }
        const int nig = WGM * nN, gid = wgid / nig, fm = gid * WGM, gsz = (nM - fm) < WGM ? (nM - fm) : WGM;
        u.pm = fm + ((wgid % nig) % gsz); u.pn = (wgid % nig) / gsz; return true;
    }
    __device__ __forceinline__ void a_ready(const Unit&) const {}
    __device__ __forceinline__ void done(const Unit&) const {}
};

typedef float f32x2 __attribute__((ext_vector_type(2)));
typedef __bf16 bf16x2_t __attribute__((ext_vector_type(2)));
__device__ __forceinline__ unsigned cvtpk(float lo, float hi) { f32x2 v = {lo, hi}; bf16x2_t b = __builtin_convertvector(v, bf16x2_t); return __builtin_bit_cast(unsigned, b); }
constexpr int SEQ = 16384; constexpr int PROWS = SEQ + SEQ / 16; constexpr size_t TSTRIDE = (size_t)PROWS * 64;
constexpr float EPSV = 1e-6f;
constexpr float QSCALE = 0.125f * 1.4426950408889634f;

constexpr float ROT_C[8][8] = {{1.000000000e+00f, 1.000000000e+00f, 1.000000000e+00f, 1.000000000e+00f, 1.000000000e+00f, 1.000000000e+00f, 1.000000000e+00f, 1.000000000e+00f}, {-9.576594803e-01f, -9.992462676e-01f, 8.243765167e-01f, 9.932003006e-01f, 9.997440110e-01f, 9.999903729e-01f, 9.999996380e-01f, 9.999999864e-01f}, {8.342233605e-01f, 9.969862065e-01f, 3.591932825e-01f, 9.728936743e-01f, 9.989761749e-01f, 9.999614917e-01f, 9.999985518e-01f, 9.999999455e-01f}, {-6.401443395e-01f, -9.932232238e-01f, -2.321555027e-01f, 9.393562789e-01f, 9.976968850e-01f, 9.999133569e-01f, 9.999967417e-01f, 9.999998775e-01f}, {-6.928958219e-01f, 9.521417467e-01f, 1.010103862e-01f, 5.950558964e-01f, 9.836606931e-01f, 9.993839260e-01f, 9.999768296e-01f, 9.999991287e-01f}, {8.711474010e-01f, -9.395588652e-01f, 6.464173313e-01f, 4.974463326e-01f, 9.793355680e-01f, 9.992203026e-01f, 9.999706750e-01f, 9.999988972e-01f}, {-9.756293128e-01f, 9.255596318e-01f, 9.647721496e-01f, 3.930717976e-01f, 9.745090446e-01f, 9.990374400e-01f, 9.999637963e-01f, 9.999986385e-01f}, {9.974939203e-01f, -9.101651497e-01f, 9.442536768e-01f, 2.833517226e-01f, 9.691835939e-01f, 9.988353416e-01f, 9.999561936e-01f, 9.999983526e-01f}};
constexpr float ROT_S[8][8] = {{0.000000000e+00f, 0.000000000e+00f, 0.000000000e+00f, 0.000000000e+00f, 0.000000000e+00f, 0.000000000e+00f, 0.000000000e+00f, 0.000000000e+00f}, {-2.879033167e-01f, 3.881876802e-02f, 5.660418348e-01f, 1.164180522e-01f, 2.262548431e-02f, 4.387956933e-03f, 8.509273312e-04f, 1.650141632e-04f}, {5.514266812e-01f, -7.757901811e-02f, 9.332631922e-01f, 2.312528888e-01f, 4.523938487e-02f, 8.775829378e-03f, 1.701854046e-03f, 3.300283219e-04f}, {-7.682546613e-01f, 1.162223206e-01f, 9.726786841e-01f, 3.429428252e-01f, 6.783012386e-02f, 1.316353285e-02f, 2.552779529e-03f, 4.950424716e-04f}, {7.210377105e-01f, -3.056568242e-01f, -9.948853712e-01f, 8.036843162e-01f, 1.800323329e-01f, 3.509655897e-02f, 6.807366895e-03f, 1.320112928e-03f}, {-4.910215939e-01f, 3.423874103e-01f, -7.629840324e-01f, 8.674947529e-01f, 2.022420461e-01f, 3.948147472e-02f, 7.658272045e-03f, 1.485126930e-03f}, {2.194252584e-01f, -3.786018594e-01f, -2.630868667e-01f, 9.195077824e-01f, 2.243482159e-01f, 4.386563028e-02f, 8.509171650e-03f, 1.650140891e-03f}, {7.075223608e-02f, 4.142455796e-01f, 3.292187630e-01f, 9.590160589e-01f, 2.463395243e-01f, 4.824894124e-02f, 9.360065094e-03f, 1.815154807e-03f}};
struct EpiInProj {
    static constexpr bool PERM = true, AFTER_DRAIN = false;
    unsigned char* wsb; const float* qg; const float* kg;
    static constexpr size_t OFF_ROPE = (size_t)1 << 20, OFF_SSQ = (size_t)2 << 20, OFF_P = (size_t)110 << 20;
    __device__ __forceinline__ void operator()(const f32x4 (&acc)[2][2][4][2], const Unit& u, int wr, int wc, int fr, int fq) const {
        bf16_t* const P = (bf16_t*)(wsb + OFF_P); const float* const ssq = (const float*)(wsb + OFF_SSQ); const float* const rope = (const float*)(wsb + OFF_ROPE);
        const int pn = u.pn;
        const int kind = (pn == 0) ? 0 : ((pn == 3 || pn >= 13) ? 1 : ((pn >= 4 && pn <= 6) ? 2 : ((pn >= 7 && pn <= 9) ? 3 : 4)));
        bf16_t* const tens = P + (size_t)(pn * 4 + wc) * TSTRIDE + 8 * fq;
        const int row0 = u.pm * BM + wr * 64 + fr;
        f32x4 sq[8];
#pragma unroll
        for (int j = 0; j < 8; ++j) sq[j] = *(const f32x4*)(ssq + (size_t)(row0 + (j >> 2) * HALF + (j & 3) * 16) * 4);
        f32x4 g[2][2], cb[2], sb[2];
#pragma unroll
        for (int bj = 0; bj < 2; ++bj)
#pragma unroll
            for (int n = 0; n < 2; ++n) g[bj][n] = (f32x4){1.f, 1.f, 1.f, 1.f};
#pragma unroll
        for (int n = 0; n < 2; ++n) { cb[n] = (f32x4){1.f, 1.f, 1.f, 1.f}; sb[n] = (f32x4){0.f, 0.f, 0.f, 0.f}; }
        if (kind == 2 || kind == 3) { const float* gp = (kind == 2) ? qg : kg;
#pragma unroll
            for (int bj = 0; bj < 2; ++bj)
#pragma unroll
                for (int n = 0; n < 2; ++n) g[bj][n] = *(const f32x4*)(gp + 32 * bj + 8 * fq + 4 * n);
#pragma unroll
            for (int n = 0; n < 2; ++n) { cb[n] = *(const f32x4*)(rope + (size_t)row0 * 16 + 4 * n); sb[n] = *(const f32x4*)(rope + (size_t)row0 * 16 + 8 + 4 * n); } }
        float rs[8];
#pragma unroll
        for (int j = 0; j < 8; ++j) rs[j] = __builtin_amdgcn_rsqf(((sq[j][0] + sq[j][1]) + (sq[j][2] + sq[j][3])) * (1.0f / 1024.0f) + EPSV);
#pragma unroll
        for (int ai = 0; ai < 2; ++ai)
#pragma unroll
            for (int m = 0; m < 4; ++m) {
                const int row = row0 + ai * HALF + m * 16;
                f32x4 v[2][2];
#pragma unroll
                for (int bj = 0; bj < 2; ++bj)
#pragma unroll
                    for (int n = 0; n < 2; ++n) v[bj][n] = acc[ai][bj][m][n] * rs[ai * 4 + m];
                if (kind == 0) {
#pragma unroll
                    for (int bj = 0; bj < 2; ++bj)
#pragma unroll
                        for (int n = 0; n < 2; ++n) v[bj][n] = v[bj][n] * QSCALE;
                } else if (kind == 1) {
#pragma unroll
                    for (int bj = 0; bj < 2; ++bj)
#pragma unroll
                        for (int n = 0; n < 2; ++n)
#pragma unroll
                            for (int e = 0; e < 4; ++e) { const float x = v[bj][n][e]; v[bj][n][e] = x * __builtin_amdgcn_rcpf(1.0f + __builtin_amdgcn_exp2f(-1.4426950408889634f * x)); }
                } else if (kind == 2 || kind == 3) {
                    float hs = 0.f;
#pragma unroll
                    for (int bj = 0; bj < 2; ++bj)
#pragma unroll
                        for (int n = 0; n < 2; ++n) { const f32x4 x = v[bj][n]; hs += (x[0] * x[0] + x[1] * x[1]) + (x[2] * x[2] + x[3] * x[3]); }
                    hs += lx_xor<16>(hs); hs = lx_sum32(hs);
                    const float hr = __builtin_amdgcn_rsqf(hs * (1.0f / 64.0f) + EPSV);
#pragma unroll
                    for (int bj = 0; bj < 2; ++bj)
#pragma unroll
                        for (int n = 0; n < 2; ++n) v[bj][n] = v[bj][n] * hr * g[bj][n];
#pragma unroll
                    for (int n = 0; n < 2; ++n)
#pragma unroll
                        for (int e = 0; e < 4; ++e) { const int i = 4 * n + e; const float cr = ROT_C[ai * 4 + m][i], sr = ROT_S[ai * 4 + m][i];
                            const float cc = cb[n][e] * cr - sb[n][e] * sr, ss2 = sb[n][e] * cr + cb[n][e] * sr;
                            const float own = v[0][n][e]; const float oth = lx_xor<16>(own);
                            const float r0 = own * cc - oth * ss2, r1 = own * cc + oth * ss2;
                            v[0][n][e] = (fq == 0) ? r0 : ((fq == 1) ? r1 : own); }
                    if (kind == 2) {
#pragma unroll
                        for (int bj = 0; bj < 2; ++bj)
#pragma unroll
                            for (int n = 0; n < 2; ++n) v[bj][n] = v[bj][n] * QSCALE;
                    }
                }
                bf16_t* rowp = tens + (size_t)(row + (row >> 4)) * 64;
#pragma unroll
                for (int bj = 0; bj < 2; ++bj) { u32x4 w; w.x = cvtpk(v[bj][0][0], v[bj][0][1]); w.y = cvtpk(v[bj][0][2], v[bj][0][3]); w.z = cvtpk(v[bj][1][0], v[bj][1][1]); w.w = cvtpk(v[bj][1][2], v[bj][1][3]);
                    *(u32x4*)(rowp + 32 * bj) = w; }
            }
    }
};

struct EpiOutProj {
    static constexpr bool PERM = true, AFTER_DRAIN = true;
    const float* xin; float* xout; bf16_t* xb; float* ssq;
    __device__ __forceinline__ void fused(f32x4 (&acc)[2][2][4][2], const Unit& u, int wr, int wc, int fr, int fq, PG8_LAS unsigned char* lds, int wid, int lane) const {
        PG8_LAS float* Pw = (PG8_LAS float*)lds;
        const size_t off0 = (size_t)(u.pm * BM + wr * 64 + fr) * 1024 + u.pn * BM + wc * 32 + 8 * fq;
        f32x4 pre[2][2][2][2];
#define EOP_LOAD(buf, pr) do { _Pragma("unroll") for (int q_ = 0; q_ < 2; ++q_) { const int j_ = 2 * (pr) + q_; const size_t o_ = off0 + (size_t)((j_ >> 2) * HALF + (j_ & 3) * 16) * 1024; \
            _Pragma("unroll") for (int bj = 0; bj < 2; ++bj) { pre[buf][q_][bj][0] = *(const f32x4*)(xin + o_ + bj * HALF); pre[buf][q_][bj][1] = *(const f32x4*)(xin + o_ + bj * HALF + 4); } } } while (0)
        EOP_LOAD(0, 0); asm volatile("" ::: "memory"); EOP_LOAD(1, 1); asm volatile("" ::: "memory");
#pragma unroll
        for (int pr = 0; pr < 4; ++pr) {
#pragma unroll
            for (int q = 0; q < 2; ++q) { const int j = 2 * pr + q, ai = j >> 2, m = j & 3; const int rt = ai * HALF + wr * 64 + m * 16 + fr; const size_t off = off0 + (size_t)(ai * HALF + m * 16) * 1024;
                float s = 0.f;
#pragma unroll
                for (int bj = 0; bj < 2; ++bj) {
                    const f32x4 a0 = pre[pr & 1][q][bj][0] + acc[ai][bj][m][0], a1 = pre[pr & 1][q][bj][1] + acc[ai][bj][m][1];
                    *(f32x4*)(xout + off + bj * HALF) = a0; *(f32x4*)(xout + off + bj * HALF + 4) = a1;
                    u32x4 w; w.x = cvtpk(a0[0], a0[1]); w.y = cvtpk(a0[2], a0[3]); w.z = cvtpk(a1[0], a1[1]); w.w = cvtpk(a1[2], a1[3]);
                    *(u32x4*)(xb + off + bj * HALF) = w;
                    s += ((a0[0] * a0[0] + a0[1] * a0[1]) + (a0[2] * a0[2] + a0[3] * a0[3])) + ((a1[0] * a1[0] + a1[1] * a1[1]) + (a1[2] * a1[2] + a1[3] * a1[3]));
                }
                s += lx_xor<16>(s); s = lx_sum32(s);
                if (fq == 0) Pw[rt * 4 + wc] = s; }
            asm volatile("" ::: "memory");
            if (pr + 2 < 4) { EOP_LOAD(pr & 1, pr + 2); asm volatile("" ::: "memory"); }
        }
#undef EOP_LOAD
        asm volatile("s_waitcnt lgkmcnt(0)" ::: "memory"); __builtin_amdgcn_s_barrier(); asm volatile("" ::: "memory");
        const int t = wid * 64 + lane;
        if (t < 256) { const float s = (Pw[t * 4 + 0] + Pw[t * 4 + 1]) + (Pw[t * 4 + 2] + Pw[t * 4 + 3]); ssq[(size_t)(u.pm * BM + t) * 4 + u.pn] = s; }
        asm volatile("s_waitcnt lgkmcnt(0)" ::: "memory"); __builtin_amdgcn_s_barrier(); asm volatile("" ::: "memory");
    }
};

template <class Epi, class Sched, bool ALIGN_EPI = false, bool SP2 = false>
__device__ __forceinline__ void gemm_phase(PG8_LAS unsigned char* lds, const Gemm g, const Sched& S, const Epi& E, int wave) {
    int wid = wave; asm volatile("" : "+s"(wid)); const int tid = lx_tid(wid);
    const int lane = tid & 63, wr = wid >> 2, wc = wid & 3, fr = lane & 15, fq = lane >> 4;
    const int K = g.K, nt = K / BK;
    unsigned voffA[2], voffB[2];
#pragma unroll
    for (int i = 0; i < 2; ++i) { int R, C; stage_rc(tid * 16 + i * 8192, R, C); const int Rb = Epi::PERM ? ((R & ~31) + perm32(R & 31)) : R;
        voffA[i] = (unsigned)(R * K + C) * 2u; voffB[i] = (unsigned)(Rb * K + C) * 2u; }
    const size_t kstep = (size_t)(BK * 2);
    const size_t hstep = (size_t)HALF * K * 2;
    const size_t tstep = 2 * hstep;
    const unsigned ldsw = (unsigned)wid * 1024u;
    const int aoff = lds_byte(wr * 64 + fr, fq * 8), boff = lds_byte(wc * 32 + fr, fq * 8);
#define PG8_SA(b, h) (((b) * 2 + (h)) * HTB)
#define PG8_SB(b, h) ((4 + (b) * 2 + (h)) * HTB)
#define PG8_STAGE(bufoff, gbase, voff) do { _Pragma("unroll") for (int _i = 0; _i < 2; ++_i) \
        __builtin_amdgcn_global_load_lds((const unsigned*)((const char*)(gbase) + (voff)[_i]), (PG8_LAS unsigned*)(lds + (bufoff) + ldsw + _i * 8192), 16, 0, 0); } while (0)
#define PG8_LDA(dst, b, h) do { _Pragma("unroll") for (int m = 0; m < 4; ++m) _Pragma("unroll") for (int k = 0; k < 2; ++k) dst[m][k] = *(const PG8_LAS bf16x8*)(lds + PG8_SA(b, h) + aoff + m * 2048 + k * 1024); } while (0)
#define PG8_LDB(dst, b, h) do { _Pragma("unroll") for (int n = 0; n < 2; ++n) _Pragma("unroll") for (int k = 0; k < 2; ++k) dst[n][k] = *(const PG8_LAS bf16x8*)(lds + PG8_SB(b, h) + boff + n * 2048 + k * 1024); } while (0)
#define PG8_MMA(ai, bj, At, Bt) do { __builtin_amdgcn_s_setprio(1); _Pragma("unroll") for (int m = 0; m < 4; ++m) _Pragma("unroll") for (int n = 0; n < 2; ++n) _Pragma("unroll") for (int k = 0; k < 2; ++k) \
        acc[ai][bj][m][n] = __builtin_amdgcn_mfma_f32_16x16x32_bf16(Bt[n][k], At[m][k], acc[ai][bj][m][n], 0, 0, 0); __builtin_amdgcn_s_setprio(0); } while (0)
#define PG8_WAIT_V(n) asm volatile("s_waitcnt vmcnt(" #n ")" ::: "memory")
#define PG8_WAIT_L(n) asm volatile("s_waitcnt lgkmcnt(" #n ")" ::: "memory")
#define PG8_BAR __builtin_amdgcn_s_barrier()
#define PG8_SCHED __builtin_amdgcn_sched_barrier(0)
    Unit cur, nxt; int ui = 0;
    if (!S.next(0, cur)) return;
    f32x4 acc[2][2][4][2];
#pragma unroll
    for (int a = 0; a < 2; ++a)
#pragma unroll
        for (int b = 0; b < 2; ++b)
#pragma unroll
            for (int m = 0; m < 4; ++m)
#pragma unroll
                for (int n = 0; n < 2; ++n) acc[a][b][m][n] = (f32x4){0.f, 0.f, 0.f, 0.f};
    bf16x8 At[4][2], B0[2][2], B1[2][2];
    const char* cA = (const char*)g.A + (size_t)cur.pm * tstep; const char* cB = (const char*)g.Bt + (size_t)cur.pn * tstep;
    S.a_ready(cur);
    if constexpr (SP2) {
        PG8_STAGE(PG8_SB(0, 0), cB, voffB); PG8_STAGE(PG8_SB(0, 1), cB + hstep, voffB); PG8_STAGE(PG8_SA(0, 0), cA, voffA); PG8_STAGE(PG8_SA(0, 1), cA + hstep, voffA);
        if (wr == 1) PG8_BAR;
        PG8_WAIT_V(2); PG8_BAR;
        PG8_STAGE(PG8_SB(1, 0), cB + kstep, voffB); PG8_STAGE(PG8_SA(1, 0), cA + kstep, voffA); PG8_STAGE(PG8_SB(1, 1), cB + hstep + kstep, voffB);
        PG8_WAIT_V(6); PG8_BAR;
    } else {
        PG8_STAGE(PG8_SB(0, 0), cB, voffB); PG8_STAGE(PG8_SA(0, 0), cA, voffA); PG8_STAGE(PG8_SB(0, 1), cB + hstep, voffB); PG8_STAGE(PG8_SA(0, 1), cA + hstep, voffA);
        if (wr == 1) PG8_BAR;
        PG8_WAIT_V(4); PG8_BAR;
        PG8_STAGE(PG8_SB(1, 0), cB + kstep, voffB); PG8_STAGE(PG8_SA(1, 0), cA + kstep, voffA); PG8_STAGE(PG8_SB(1, 1), cB + hstep + kstep, voffB);
        PG8_WAIT_V(6); PG8_BAR;
    }
    for (;;) {
        const bool has_next = S.next(ui + 1, nxt);
        const char* nA = has_next ? (const char*)g.A + (size_t)nxt.pm * tstep : cA; const char* nB = has_next ? (const char*)g.Bt + (size_t)nxt.pn * tstep : cB;
        for (int t = 0; t < nt; t += 2) {
            const bool last = (t == nt - 2);
            const char* a1 = cA + (size_t)(t + 1) * kstep;
            const char* a2 = last ? nA : cA + (size_t)(t + 2) * kstep; const char* b2 = last ? nB : cB + (size_t)(t + 2) * kstep;
            const char* a3 = a2 + kstep; const char* b3 = b2 + kstep;
            if (last && has_next) S.a_ready(nxt);
            if constexpr (SP2) {
            PG8_LDB(B0, 0, 0); PG8_LDB(B1, 0, 1); PG8_SCHED; PG8_LDA(At, 0, 0); PG8_STAGE(PG8_SA(1, 1), a1 + hstep, voffA);
            PG8_WAIT_V(8); PG8_WAIT_L(0); PG8_BAR; PG8_MMA(0, 0, At, B0); PG8_MMA(0, 1, At, B1); PG8_BAR; PG8_SCHED;
            PG8_LDA(At, 0, 1); PG8_STAGE(PG8_SB(0, 0), b2, voffB); PG8_STAGE(PG8_SB(0, 1), b2 + hstep, voffB); PG8_STAGE(PG8_SA(0, 0), a2, voffA);
            PG8_WAIT_V(8); PG8_WAIT_L(0); PG8_BAR; PG8_MMA(1, 0, At, B0); PG8_MMA(1, 1, At, B1); PG8_BAR; PG8_SCHED;
            PG8_LDB(B0, 1, 0); PG8_LDB(B1, 1, 1); PG8_SCHED; PG8_LDA(At, 1, 0); PG8_STAGE(PG8_SA(0, 1), a2 + hstep, voffA);
            PG8_WAIT_V(8); PG8_WAIT_L(0); PG8_BAR; PG8_MMA(0, 0, At, B0); PG8_MMA(0, 1, At, B1); PG8_BAR; PG8_SCHED;
            PG8_LDA(At, 1, 1); PG8_STAGE(PG8_SB(1, 0), b3, voffB); PG8_STAGE(PG8_SB(1, 1), b3 + hstep, voffB); PG8_STAGE(PG8_SA(1, 0), a3, voffA);
            PG8_WAIT_V(8); PG8_WAIT_L(0); PG8_BAR; PG8_MMA(1, 0, At, B0); PG8_MMA(1, 1, At, B1); PG8_BAR; PG8_SCHED;
            } else {
            PG8_LDB(B0, 0, 0); PG8_SCHED; PG8_LDA(At, 0, 0); PG8_STAGE(PG8_SA(1, 1), a1 + hstep, voffA);
            PG8_WAIT_L(8); PG8_BAR; PG8_WAIT_L(0); PG8_MMA(0, 0, At, B0); PG8_BAR; PG8_SCHED;
            PG8_LDB(B1, 0, 1); PG8_STAGE(PG8_SB(0, 0), b2, voffB);
            PG8_BAR; PG8_WAIT_L(0); PG8_MMA(0, 1, At, B1); PG8_BAR;
            PG8_LDA(At, 0, 1); PG8_STAGE(PG8_SA(0, 0), a2, voffA);
            PG8_BAR; PG8_WAIT_L(0); PG8_MMA(1, 0, At, B0); PG8_BAR; PG8_SCHED;
            PG8_STAGE(PG8_SB(0, 1), b2 + hstep, voffB);
            PG8_WAIT_V(6); PG8_BAR; PG8_MMA(1, 1, At, B1); PG8_BAR;
            PG8_LDB(B0, 1, 0); PG8_SCHED; PG8_LDA(At, 1, 0); PG8_STAGE(PG8_SA(0, 1), a2 + hstep, voffA);
            PG8_WAIT_L(8); PG8_BAR; PG8_WAIT_L(0); PG8_MMA(0, 0, At, B0); PG8_BAR; PG8_SCHED;
            PG8_LDB(B1, 1, 1); PG8_STAGE(PG8_SB(1, 0), b3, voffB);
            PG8_BAR; PG8_WAIT_L(0); PG8_MMA(0, 1, At, B1); PG8_BAR;
            PG8_LDA(At, 1, 1); PG8_STAGE(PG8_SA(1, 0), a3, voffA);
            PG8_BAR; PG8_WAIT_L(0); PG8_MMA(1, 0, At, B0); PG8_BAR; PG8_SCHED;
            PG8_STAGE(PG8_SB(1, 1), b3 + hstep, voffB);
            PG8_WAIT_V(6); PG8_BAR; PG8_MMA(1, 1, At, B1); PG8_BAR;
            }
        }
        if constexpr (ALIGN_EPI) { if (wr == 0) PG8_BAR; }
        if constexpr (!Epi::AFTER_DRAIN) { E(acc, cur, wr, wc, fr, fq);
            S.done(cur); }
        if (!has_next) break;
#pragma unroll
        for (int a = 0; a < 2; ++a)
#pragma unroll
            for (int b = 0; b < 2; ++b)
#pragma unroll
                for (int m = 0; m < 4; ++m)
#pragma unroll
                    for (int n = 0; n < 2; ++n) acc[a][b][m][n] = (f32x4){0.f, 0.f, 0.f, 0.f};
        cur = nxt; cA = nA; cB = nB; ++ui;
        if constexpr (ALIGN_EPI) { if (wr == 1) PG8_BAR; }
    }
    PG8_WAIT_V(0);
    if constexpr (!ALIGN_EPI) { if (wr == 0) PG8_BAR; }
    PG8_BAR;
    if constexpr (Epi::AFTER_DRAIN) { E.fused(acc, cur, wr, wc, fr, fq, lds, wid, lane); S.done(cur); }
#undef PG8_SA
#undef PG8_SB
#undef PG8_STAGE
#undef PG8_LDA
#undef PG8_LDB
#undef PG8_MMA
#undef PG8_WAIT_V
#undef PG8_WAIT_L
#undef PG8_BAR
#undef PG8_SCHED
}
}
namespace att {
#define ATT_LAS __attribute__((address_space(3)))
using bf16x8 = __attribute__((ext_vector_type(8))) short;
using s16x4 = __attribute__((ext_vector_type(4))) short;
using f32x16 = __attribute__((ext_vector_type(16))) float;
using u32x4 = __attribute__((ext_vector_type(4))) unsigned;
typedef unsigned short bf16_t;
typedef ATT_LAS const char* lds_cptr;
typedef ATT_LAS char* lds_ptr;
typedef short v4i16_t __attribute__((ext_vector_type(4)));
typedef float f32x2_t __attribute__((ext_vector_type(2))); typedef __bf16 bf16x2_t __attribute__((ext_vector_type(2)));
constexpr int SEQ = 16384;
constexpr int PROWS = SEQ + SEQ / 16; constexpr size_t TSTRIDE = (size_t)PROWS * 64;
constexpr int T_QA = 0, T_KA = 4, T_VA = 8, T_GA = 12, T_QD = 16, T_KD = 28, T_VD = 40, T_GD = 52;
__device__ __forceinline__ int prow(int t) { return t + (t >> 4); }
constexpr int SLOTB = 8192, NSLOT = 6;
constexpr int LDS_K = 0, LDS_K2 = NSLOT * SLOTB, LDS_V = 2 * NSLOT * SLOTB, LDS_WS = 3 * NSLOT * SLOTB, LDS_FLAG = LDS_WS + 8 * 64 * 4, LDS_END = LDS_FLAG + 128;
constexpr int LDS_OST = LDS_K2;
#define ATT_BAR_L() asm volatile("s_waitcnt lgkmcnt(0)\n\ts_barrier" ::: "memory")
constexpr float SB_DEAD = 152.0f;
__device__ __forceinline__ int crow(int r, int hi) { return (r & 3) + 8 * (r >> 2) + 4 * hi; }
__device__ __forceinline__ unsigned cvtpk_s(float lo, float hi) { f32x2_t v = {lo, hi}; bf16x2_t b = __builtin_convertvector(v, bf16x2_t); return __builtin_bit_cast(unsigned, b); }
__device__ __forceinline__ float bf2f(unsigned short b) { return __uint_as_float((unsigned)b << 16); }
__device__ __forceinline__ void glds16(const void* gsrc, unsigned lds_dst) { unsigned keep;
    asm volatile("s_mov_b32 %0, m0\n\ts_mov_b32 m0, %2\n\ts_nop 0\n\tglobal_load_lds_dwordx4 %1, off\n\ts_mov_b32 m0, %0" : "=&s"(keep) : "v"(gsrc), "s"(lds_dst) : "memory"); }
__device__ __forceinline__ void glds16s(unsigned voff, const void* sbase, unsigned lds_dst) { unsigned keep;
    const unsigned long long a_ = (unsigned long long)sbase;
    const unsigned long long b_ = (unsigned long long)(unsigned)__builtin_amdgcn_readfirstlane((int)(unsigned)a_) | ((unsigned long long)(unsigned)__builtin_amdgcn_readfirstlane((int)(unsigned)(a_ >> 32)) << 32);
    asm volatile("s_nop 4\n\ts_mov_b32 %0, m0\n\ts_mov_b32 m0, %3\n\ts_nop 0\n\tglobal_load_lds_dwordx4 %1, %2\n\ts_mov_b32 m0, %0" : "=&s"(keep) : "v"(voff), "s"(b_), "s"(lds_dst) : "memory"); }
#define ATT_WAIT_BAR(N) asm volatile("s_waitcnt vmcnt(" #N ") lgkmcnt(0)\n\ts_barrier" ::: "memory")
__device__ __forceinline__ s16x4 vtr(lds_cptr p) { return __builtin_bit_cast(s16x4, __builtin_amdgcn_ds_read_tr16_b64_v4i16((ATT_LAS v4i16_t*)p)); }

__device__ __forceinline__ void qkt(f32x16& p0, f32x16& p1, lds_cptr ks, const int (&koff)[4], const bf16x8* qr, const f32x16& cinit) {
#pragma unroll
    for (int d0 = 0; d0 < 4; ++d0) {
        const bf16x8 b0 = *(const ATT_LAS bf16x8*)(ks + koff[d0]);
        const bf16x8 b1 = *(const ATT_LAS bf16x8*)(ks + koff[d0] + 4096);
        if (d0 == 0) { p0 = __builtin_amdgcn_mfma_f32_32x32x16_bf16(b0, qr[0], cinit, 0, 0, 0); p1 = __builtin_amdgcn_mfma_f32_32x32x16_bf16(b1, qr[0], cinit, 0, 0, 0); }
        else { p0 = __builtin_amdgcn_mfma_f32_32x32x16_bf16(b0, qr[d0], p0, 0, 0, 0); p1 = __builtin_amdgcn_mfma_f32_32x32x16_bf16(b1, qr[d0], p1, 0, 0, 0); }
    }
}
__device__ __forceinline__ void pv(f32x16* o, lds_cptr vp, bf16x8 pa0, bf16x8 pa1, bf16x8 pa2, bf16x8 pa3) {
#pragma unroll
    for (int d0 = 0; d0 < 2; ++d0) { s16x4 lo[4], hi[4];
#pragma unroll
        for (int ks = 0; ks < 4; ++ks) { lo[ks] = vtr(vp + d0 * 4096 + ks * 1024); hi[ks] = vtr(vp + d0 * 4096 + ks * 1024 + 512); }
#define ATT_PK(k) (bf16x8){lo[k][0], lo[k][1], lo[k][2], lo[k][3], hi[k][0], hi[k][1], hi[k][2], hi[k][3]}
        o[d0] = __builtin_amdgcn_mfma_f32_32x32x16_bf16(ATT_PK(0), pa0, o[d0], 0, 0, 0);
        o[d0] = __builtin_amdgcn_mfma_f32_32x32x16_bf16(ATT_PK(1), pa1, o[d0], 0, 0, 0);
        o[d0] = __builtin_amdgcn_mfma_f32_32x32x16_bf16(ATT_PK(2), pa2, o[d0], 0, 0, 0);
        o[d0] = __builtin_amdgcn_mfma_f32_32x32x16_bf16(ATT_PK(3), pa3, o[d0], 0, 0, 0);
#undef ATT_PK
    }
}
__device__ __forceinline__ void ot_rows(const f32x16* o, lds_ptr stg, int q, int hi, int lane, u32x4* sv) {
#pragma unroll
    for (int d0 = 0; d0 < 2; ++d0)
#pragma unroll
        for (int pr = 0; pr < 2; ++pr) { const int g = 2 * pr;
            const unsigned ax = cvtpk_s(o[d0][4 * g], o[d0][4 * g + 1]), ay = cvtpk_s(o[d0][4 * g + 2], o[d0][4 * g + 3]), bx = cvtpk_s(o[d0][4 * g + 4], o[d0][4 * g + 5]), by = cvtpk_s(o[d0][4 * g + 6], o[d0][4 * g + 7]);
            const auto rx = __builtin_amdgcn_permlane32_swap(ax, bx, false, false); const auto ry = __builtin_amdgcn_permlane32_swap(ay, by, false, false);
            *(ATT_LAS u32x4*)(stg + q * 128 + (((4 * d0 + 2 * pr + hi) ^ (q & 7)) << 4)) = (u32x4){rx[0], ry[0], rx[1], ry[1]}; }
    asm volatile("s_waitcnt lgkmcnt(0)" ::: "memory");
#pragma unroll
    for (int i = 0; i < 4; ++i) { const int rw = 8 * i + (lane >> 3); sv[i] = *(const ATT_LAS u32x4*)(stg + rw * 128 + (((lane & 7) ^ (rw & 7)) << 4)); }
}
__device__ __forceinline__ bf16x8 pack8(const float* a) { u32x4 w; w.x = cvtpk_s(a[0], a[1]); w.y = cvtpk_s(a[2], a[3]); w.z = cvtpk_s(a[4], a[5]); w.w = cvtpk_s(a[6], a[7]); return __builtin_bit_cast(bf16x8, w); }

template <bool MASK> __device__ __forceinline__ void sb_tile(const f32x16& p0, const f32x16& p1, float& Rsum, int qrel, int hi, bf16x8& pa0, bf16x8& pa1, bf16x8& pa2, bf16x8& pa3) {
    float run = Rsum; unsigned pw[16];
#pragma unroll
    for (int g = 7; g >= 0; --g) {
        float z[4], sp[4];
#pragma unroll
        for (int e = 0; e < 4; ++e) { const int idx = 4 * g + e; z[e] = (idx < 16) ? p0[idx] : p1[idx - 16];
            sp[e] = __builtin_fmaxf(z[e], 0.f) + __builtin_amdgcn_logf(1.0f + __builtin_amdgcn_exp2f(-__builtin_fabsf(z[e])));
            if (MASK) { if (8 * g + 4 * hi + e >= qrel) sp[e] = 0.f; } }
        const float e2 = sp[3], e1 = sp[3] + sp[2], e0 = e1 + sp[1], T = e0 + sp[0];
        const auto rr = __builtin_amdgcn_permlane32_swap(__float_as_uint(T), __float_as_uint(T), false, false);
        const float tev = __uint_as_float(rr[0]), tod = __uint_as_float(rr[1]);
        const float off = run + (hi ? 0.f : tod);
        run += tev + tod;
        float a[4];
        a[0] = __builtin_amdgcn_exp2f((z[0] - sp[0]) - (off + e0)); a[1] = __builtin_amdgcn_exp2f((z[1] - sp[1]) - (off + e1));
        a[2] = __builtin_amdgcn_exp2f((z[2] - sp[2]) - (off + e2)); a[3] = __builtin_amdgcn_exp2f((z[3] - sp[3]) - off);
        if (MASK) {
#pragma unroll
            for (int e = 0; e < 4; ++e) if (8 * g + 4 * hi + e >= qrel) a[e] = 0.f; }
        pw[2 * g] = cvtpk_s(a[0], a[1]); pw[2 * g + 1] = cvtpk_s(a[2], a[3]);
    }
    Rsum = run;
    pa0 = __builtin_bit_cast(bf16x8, (u32x4){pw[0], pw[1], pw[2], pw[3]}); pa1 = __builtin_bit_cast(bf16x8, (u32x4){pw[4], pw[5], pw[6], pw[7]});
    pa2 = __builtin_bit_cast(bf16x8, (u32x4){pw[8], pw[9], pw[10], pw[11]}); pa3 = __builtin_bit_cast(bf16x8, (u32x4){pw[12], pw[13], pw[14], pw[15]});
}

struct SbArgs { const bf16_t* proj; bf16_t* mix; };
template <bool EARLY> __device__ __forceinline__ void sb_unit(int h, int qb, const SbArgs& A, lds_ptr shm, int wave) {
    int wid = wave; asm volatile("" : "+s"(wid)); const int tid = lx_tid(wid);
    const int lane = tid & 63, r32 = lane & 31, hi = lane >> 5;
    const int q0 = qb * 256;
    const bf16_t* Qh = A.proj + (size_t)(T_QA + h) * TSTRIDE; const bf16_t* Kh = A.proj + (size_t)(T_KA + h) * TSTRIDE; const bf16_t* Vh = A.proj + (size_t)(T_VA + h) * TSTRIDE;
    const unsigned lds0 = (unsigned)(size_t)shm;
    volatile ATT_LAS unsigned* flags = (volatile ATT_LAS unsigned*)(shm + LDS_FLAG);
    const unsigned kdst = lds0 + LDS_K + wid * 1024, vdst = lds0 + LDS_V + wid * 1024;
    const lds_cptr ks0 = (lds_cptr)shm + LDS_K; int koff[4];
#pragma unroll
    for (int d0 = 0; d0 < 4; ++d0) koff[d0] = r32 * 128 + (((2 * d0 + hi) ^ ((r32 >> 1) & 7)) << 4);
    const lds_cptr vp0 = (lds_cptr)shm + LDS_V + ((lane >> 4) & 1) * 32 + (lane & 3) * 8 + (4 * hi + ((lane & 15) >> 2)) * 64;
#define SB_DMA(jt, slot) do { const int jt_ = (jt) < 0 ? 0 : (jt); const int l_ = lx_lane(); const int kkey_ = 8 * wid + (l_ >> 3), vkey_ = 16 * (wid & 3) + (l_ >> 2); \
        const unsigned voffK_ = (unsigned)((prow(kkey_) * 64 + ((l_ & 7) ^ ((kkey_ >> 1) & 7)) * 8) * 2), voffV_ = (unsigned)((prow(vkey_) * 64 + (wid >> 2) * 32 + (l_ & 3) * 8) * 2); \
        glds16s(voffK_, (const char*)Kh + (size_t)jt_ * (68 * 128), (unsigned)__builtin_amdgcn_readfirstlane(kdst + (slot))); \
        glds16s(voffV_, (const char*)Vh + (size_t)jt_ * (68 * 128), (unsigned)__builtin_amdgcn_readfirstlane(vdst + (slot))); } while (0)
    const int jtop = 4 * qb + 3, jd = 4 * qb + (wid >> 1), qrel = 32 * (wid & 1) + r32;
    if (lane == 0) { flags[wid] = 0u; flags[8 + wid] = 0u; }
    bf16x8 qr[4];
    { const bf16_t* Qp = Qh + (size_t)prow(q0 + wid * 32 + r32) * 64;
#pragma unroll
      for (int d0 = 0; d0 < 4; ++d0) qr[d0] = *(const bf16x8*)(Qp + d0 * 16 + hi * 8); }
    const lds_ptr qst = shm + LDS_OST + wid * 4096 + lane * 16;
#pragma unroll
    for (int d0 = 0; d0 < 4; ++d0) *(ATT_LAS bf16x8*)(qst + d0 * 1024) = qr[d0];
    asm volatile("" ::: "memory");
#pragma unroll
    for (int i = 0; i < 6; ++i) SB_DMA(jtop - i, ((jtop - i + 6000) % 6) * SLOTB);
    f32x16 o[2]; o[0] = f32x16{}; o[1] = f32x16{}; const f32x16 zero = f32x16{};
    float Rsum = 0.f; bool dead = false;
    for (int s = 0;; ++s) {
        const int jt = jd - s;
        if (s == 0) ATT_WAIT_BAR(4); else ATT_WAIT_BAR(2);
        if (s > 0) { const int fb = ((s - 1) & 1) * 8; unsigned all = 1u;
#pragma unroll
            for (int w = 0; w < 8; ++w) all &= flags[fb + w];
            if (all) break; }
        if (s > 0) SB_DMA(jtop - s - 5, ((jtop - s + 1 + 6000) % 6) * SLOTB);
        if (jt >= 0 && !dead) {
            const int slot = ((jt + 6000) % 6) * SLOTB;
            f32x16 p0, p1; bf16x8 pa0, pa1, pa2, pa3;
            { bf16x8 qf[4];
#pragma unroll
              for (int d0 = 0; d0 < 4; ++d0) qf[d0] = *(const ATT_LAS bf16x8*)(qst + d0 * 1024);
              qkt(p0, p1, ks0 + slot, koff, qf, zero); }
            __builtin_amdgcn_sched_barrier(0);
            if (s == 0) sb_tile<true>(p0, p1, Rsum, qrel, hi, pa0, pa1, pa2, pa3); else sb_tile<false>(p0, p1, Rsum, qrel, hi, pa0, pa1, pa2, pa3);
            __builtin_amdgcn_sched_barrier(0);
            pv(o, vp0 + slot, pa0, pa1, pa2, pa3);
            if (EARLY) dead = __all(Rsum > SB_DEAD);
        }
        const bool fin = dead || (jt <= 0);
        if (lane == 0) flags[(s & 1) * 8 + wid] = fin ? 1u : 0u;
    }
#undef SB_DMA
    asm volatile("s_waitcnt vmcnt(0)" ::: "memory");
    { const int l2 = lx_lane();
      u32x4 sv[4]; ot_rows(o, shm + LDS_OST + wid * 4096, l2 & 31, l2 >> 5, l2, sv);
      const bf16_t* Gh = A.proj + (size_t)(T_GA + h) * TSTRIDE; bf16_t* Mw = A.mix + (size_t)(q0 + wid * 32) * 1024 + h * 64;
#pragma unroll
      for (int i = 0; i < 4; ++i) { const int row = i * 8 + (l2 >> 3), chn = l2 & 7; const u32x4 gv = *(const u32x4*)(Gh + (size_t)prow(q0 + wid * 32 + row) * 64 + chn * 8);
          u32x4 w;
#pragma unroll
          for (int k = 0; k < 4; ++k) { const float lo = __uint_as_float(sv[i][k] << 16) * __uint_as_float(gv[k] << 16), hi2 = __uint_as_float(sv[i][k] & 0xffff0000u) * __uint_as_float(gv[k] & 0xffff0000u); w[k] = cvtpk_s(lo, hi2); }
          *(u32x4*)(Mw + (size_t)row * 1024 + chn * 8) = w; } }
    ATT_BAR_L();
}

struct DilArgs { const bf16_t* proj; bf16_t* o1; bf16_t* mix; float* lp; unsigned* gcnt; const float* qg; const float* kg; };
template <int DUMMY = 0> __device__ __forceinline__ void dil_phase(int v, int G, const DilArgs& A, lds_ptr shm, int wave) {
    int wid = wave; asm volatile("" : "+s"(wid)); const int tid = lx_tid(wid);
    const int lane = tid & 63, r32 = lane & 31, hi = lane >> 5;
    const unsigned lds0 = (unsigned)(size_t)shm;
    ATT_LAS float* wsf = (ATT_LAS float*)(shm + LDS_WS) + wid * 64;
    const unsigned kdst0 = lds0 + LDS_K + wid * 1024, vdst = lds0 + LDS_V + wid * 1024;
    const lds_cptr ks00 = (lds_cptr)shm + LDS_K; int koff[4];
#pragma unroll
    for (int d0 = 0; d0 < 4; ++d0) koff[d0] = r32 * 128 + (((2 * d0 + hi) ^ ((r32 >> 1) & 7)) << 4);
    const lds_cptr vp0 = (lds_cptr)shm + LDS_V + ((lane >> 4) & 1) * 32 + (lane & 3) * 8 + (4 * hi + ((lane & 15) >> 2)) * 64;
    const int kkey = 8 * wid + (lane >> 3), kch = ((lane & 7) ^ ((kkey >> 1) & 7)) * 8, vkey = 16 * (wid & 3) + (lane >> 2), vch = (wid >> 2) * 32 + (lane & 3) * 8;
    float gq = __builtin_fabsf(A.qg[lane]), gk = __builtin_fabsf(A.kg[lane]);
    gq = lx_wave_max(gq); gk = lx_wave_max(gk);
    const float Mb = 64.0f * 0.125f * 1.4426950408889634f * 1.02f * gq * gk;
    f32x16 negm;
#pragma unroll
    for (int r = 0; r < 16; ++r) negm[r] = -Mb;
    const __amdgpu_buffer_rsrc_t o1_rsrc = __builtin_amdgcn_make_buffer_rsrc((void*)A.o1, 0, SEQ * 768 * 2, 0x00020000);
    const __amdgpu_buffer_rsrc_t mix_rsrc = __builtin_amdgcn_make_buffer_rsrc((void*)A.mix, 0, SEQ * 1024 * 2, 0x00020000);
#define DIL_DECODE(k, H, P, C, BLK) const int q_##H = 3 * (v >> 5) + (k) / 3, H = q_##H >> 1, P = (k) % 3, C = (v & 31) >> (5 - 2 * P), BLK = (q_##H & 1) * (32 >> (2 * P)) + ((v & 31) & ((32 >> (2 * P)) - 1))
#define DIL_ISSUE_K(H, P, C, BLK, KB) do { const int rsh_ = 2 * P; const unsigned kdst = kdst0 + (KB) * (LDS_K2 - LDS_K); const unsigned vo_ = (unsigned)((prow(C + (kkey << rsh_)) * 64 + kch) * 2); \
        const char* kb_ = (const char*)(A.proj + (size_t)(T_KD + H) * TSTRIDE) + (long)((BLK * 256 - 128) << rsh_) * 136; \
        _Pragma("unroll") for (int j = 0; j < 6; ++j) glds16s(vo_, kb_ + (long)((64 * j) << rsh_) * 136, (unsigned)__builtin_amdgcn_readfirstlane(kdst + j * SLOTB)); } while (0)
#define DIL_ISSUE_V(H, P, C, BLK) do { const int rsh_ = 2 * P; const unsigned vo_ = (unsigned)((prow(C + (vkey << rsh_)) * 64 + vch) * 2); \
        const char* vb_ = (const char*)(A.proj + (size_t)(T_VD + H) * TSTRIDE) + (long)((BLK * 256 - 128) << rsh_) * 136; \
        _Pragma("unroll") for (int j = 0; j < 6; ++j) glds16s(vo_, vb_ + (long)((64 * j) << rsh_) * 136, (unsigned)__builtin_amdgcn_readfirstlane(vdst + j * SLOTB)); } while (0)
#define DIL_LOADQ(QR, H, P, C, BLK) do { const bf16_t* Qp_ = A.proj + (size_t)(T_QD + H) * TSTRIDE + (size_t)prow(C + ((BLK * 256 + wid * 32 + r32) << (2 * P))) * 64; \
        _Pragma("unroll") for (int d0 = 0; d0 < 4; ++d0) QR[d0] = *(const bf16x8*)(Qp_ + d0 * 16 + hi * 8); } while (0)
    if (G != 256) return;
    bf16x8 qr[4];
    { DIL_DECODE(0, h0, p0_, c0, b0); DIL_ISSUE_K(h0, p0_, c0, b0, 0); DIL_LOADQ(qr, h0, p0_, c0, b0); DIL_ISSUE_V(h0, p0_, c0, b0); }
    for (int k = 0; k < 9; ++k) {
        DIL_DECODE(k, h, p, c, blk);
        const int rsh = 2 * p, u0 = blk * 256;
        if (k == 0) asm volatile("s_waitcnt vmcnt(6) lgkmcnt(0)\n\ts_barrier" ::: "memory"); else asm volatile("s_waitcnt vmcnt(11) lgkmcnt(0)\n\ts_barrier" ::: "memory");
        const int kb = k & 1; const lds_cptr ks0 = ks00 + kb * (LDS_K2 - LDS_K);
        if (k + 1 < 9) { DIL_DECODE(k + 1, hn, pn, cn, bn); DIL_ISSUE_K(hn, pn, cn, bn, kb ^ 1); }
        unsigned pw[5][8]; float l_reg = 0.f;
#pragma unroll
        for (int hh = 0; hh < 5; ++hh) {
            const int ht = wid + hh;
#pragma unroll
            for (int e = 0; e < 8; ++e) pw[hh][e] = 0u;
            if (blk == 0 && ht < 4) continue;
            const lds_cptr ks = ks0 + (ht >> 1) * SLOTB + (ht & 1) * 4096;
            f32x16 s;
#pragma unroll
            for (int d0 = 0; d0 < 4; ++d0) { const bf16x8 b = *(const ATT_LAS bf16x8*)(ks + koff[d0]); s = __builtin_amdgcn_mfma_f32_32x32x16_bf16(b, qr[d0], d0 == 0 ? negm : s, 0, 0, 0); }
#pragma unroll
            for (int g = 0; g < 4; ++g) { float a[4];
#pragma unroll
                for (int e = 0; e < 4; ++e) { float vv = __builtin_amdgcn_exp2f(s[4 * g + e]);
                    const int dd = 8 * g + 4 * hi + e - r32;
                    if (hh == 0) { if (dd < 0) vv = 0.f; } else if (hh == 4) { if (dd > 0) vv = 0.f; }
                    a[e] = vv; l_reg += vv; }
                pw[hh][2 * g] = cvtpk_s(a[0], a[1]); pw[hh][2 * g + 1] = cvtpk_s(a[2], a[3]); }
        }
        l_reg = lx_sum32(l_reg);
        unsigned* const gc = A.gcnt + (3 * (v >> 5) + k / 3) * 64;
        if (p == 2 && wid == 0) {
            unsigned spins = 0u;
            while (__hip_atomic_load(gc, __ATOMIC_RELAXED, __HIP_MEMORY_SCOPE_AGENT) < 32u) { __builtin_amdgcn_s_sleep(2); if (++spins > (1u << 22)) break; }
            __builtin_amdgcn_fence(__ATOMIC_ACQUIRE, "agent"); asm volatile("s_waitcnt vmcnt(0)" ::: "memory"); }
        if (k == 8) asm volatile("s_waitcnt vmcnt(0) lgkmcnt(0)\n\ts_barrier" ::: "memory");
        else if (k % 3 == 1) asm volatile("s_waitcnt vmcnt(11) lgkmcnt(0)\n\ts_barrier" ::: "memory"); else asm volatile("s_waitcnt vmcnt(6) lgkmcnt(0)\n\ts_barrier" ::: "memory");
        u32x4 a0[4], a1[4], gvv[4]; float lsum = 0.f;
        if (p == 2) { const bf16_t* Gh = A.proj + (size_t)(T_GD + h) * TSTRIDE;
#pragma unroll
            for (int i = 0; i < 4; ++i) { const int t = c + ((u0 + wid * 32 + i * 8 + (lane >> 3)) << rsh);
                a0[i] = *(const u32x4*)(A.o1 + (size_t)t * 768 + h * 64 + (lane & 7) * 8); a1[i] = *(const u32x4*)(A.mix + (size_t)t * 1024 + 256 + h * 64 + (lane & 7) * 8);
                gvv[i] = *(const u32x4*)(Gh + (size_t)prow(t) * 64 + (lane & 7) * 8); }
            const int tq0 = c + ((u0 + wid * 32 + r32) << rsh); lsum = A.lp[((size_t)0 * SEQ + tq0) * 12 + h] + A.lp[((size_t)1 * SEQ + tq0) * 12 + h]; }
        if (k + 1 < 9) { DIL_DECODE(k + 1, hn, pn, cn, bn); DIL_LOADQ(qr, hn, pn, cn, bn); }
        f32x16 o[2];
        o[0] = f32x16{}; o[1] = f32x16{};
#pragma unroll
        for (int hh = 0; hh < 5; ++hh) {
            const int ht = wid + hh;
            if (blk == 0 && ht < 4) continue;
            const lds_cptr vp = vp0 + (ht >> 1) * SLOTB + (ht & 1) * 2048;
            const bf16x8 pa0 = __builtin_bit_cast(bf16x8, (u32x4){pw[hh][0], pw[hh][1], pw[hh][2], pw[hh][3]}), pa1 = __builtin_bit_cast(bf16x8, (u32x4){pw[hh][4], pw[hh][5], pw[hh][6], pw[hh][7]});
#pragma unroll
            for (int d0 = 0; d0 < 2; ++d0) { const s16x4 l0 = vtr(vp + d0 * 4096), h0_ = vtr(vp + d0 * 4096 + 512), l1 = vtr(vp + d0 * 4096 + 1024), h1_ = vtr(vp + d0 * 4096 + 1536);
                o[d0] = __builtin_amdgcn_mfma_f32_32x32x16_bf16((bf16x8){l0[0], l0[1], l0[2], l0[3], h0_[0], h0_[1], h0_[2], h0_[3]}, pa0, o[d0], 0, 0, 0);
                o[d0] = __builtin_amdgcn_mfma_f32_32x32x16_bf16((bf16x8){l1[0], l1[1], l1[2], l1[3], h1_[0], h1_[1], h1_[2], h1_[3]}, pa1, o[d0], 0, 0, 0); }
        }
        ATT_BAR_L();
        if (p == 0 && k + 1 < 9) { DIL_DECODE(k + 1, hn, pn, cn, bn); DIL_ISSUE_V(hn, pn, cn, bn); }
        { const int tq = c + ((u0 + wid * 32 + r32) << rsh);
          if (p == 2 && hi == 0) wsf[r32] = __builtin_amdgcn_rcpf(lsum + l_reg);
          u32x4 sv[4]; ot_rows(o, shm + LDS_K + kb * (LDS_K2 - LDS_K) + wid * 4096, r32, hi, lane, sv);
          asm volatile("" ::: "memory");
          if (p != 2) {
#pragma unroll
              for (int i = 0; i < 4; ++i) { const int t = c + ((u0 + wid * 32 + i * 8 + (lane >> 3)) << rsh);
                  if (p == 0) __builtin_amdgcn_raw_buffer_store_b128(sv[i], o1_rsrc, (unsigned)((t * 768 + h * 64 + (lane & 7) * 8) * 2), 0, 16);
                  else __builtin_amdgcn_raw_buffer_store_b128(sv[i], mix_rsrc, (unsigned)((t * 1024 + 256 + h * 64 + (lane & 7) * 8) * 2), 0, 16); }
              if (hi == 0) __hip_atomic_store((unsigned*)(A.lp + ((size_t)p * SEQ + tq) * 12 + h), __float_as_uint(l_reg), __ATOMIC_RELAXED, __HIP_MEMORY_SCOPE_AGENT);
              asm volatile("" ::: "memory");
              if (p == 1) {
                  asm volatile("s_waitcnt vmcnt(0) lgkmcnt(0)\n\ts_barrier" ::: "memory");
                  if (tid == 0) __hip_atomic_fetch_add(gc, 1u, __ATOMIC_RELAXED, __HIP_MEMORY_SCOPE_AGENT);
                  if (k + 1 < 9) { DIL_DECODE(k + 1, hn, pn, cn, bn); DIL_ISSUE_V(hn, pn, cn, bn); }
              }
          } else {
              float inv[4];
#pragma unroll
              for (int i = 0; i < 4; ++i) inv[i] = wsf[i * 8 + (lane >> 3)];
#pragma unroll
              for (int i = 0; i < 4; ++i) { u32x4 w;
#pragma unroll
                  for (int e = 0; e < 4; ++e) {
                      const float lo = (__uint_as_float(a0[i][e] << 16) + __uint_as_float(a1[i][e] << 16) + __uint_as_float(sv[i][e] << 16)) * inv[i] * __uint_as_float(gvv[i][e] << 16);
                      const float hi2 = (__uint_as_float(a0[i][e] & 0xffff0000u) + __uint_as_float(a1[i][e] & 0xffff0000u) + __uint_as_float(sv[i][e] & 0xffff0000u)) * inv[i] * __uint_as_float(gvv[i][e] & 0xffff0000u);
                      w[e] = cvtpk_s(lo, hi2); }
                  sv[i] = w; }
              asm volatile("" ::: "memory");
#pragma unroll
              for (int i = 0; i < 4; ++i) { const int t = c + ((u0 + wid * 32 + i * 8 + (lane >> 3)) << rsh); *(u32x4*)(A.mix + (size_t)t * 1024 + 256 + h * 64 + (lane & 7) * 8) = sv[i]; }
              if (hi == 0) A.lp[((size_t)2 * SEQ + tq) * 12 + h] = l_reg;
              asm volatile("" ::: "memory");
              if (k + 1 < 9) { DIL_DECODE(k + 1, hn, pn, cn, bn); DIL_ISSUE_V(hn, pn, cn, bn); }
          } }
    }
#undef DIL_DECODE
#undef DIL_ISSUE_K
#undef DIL_ISSUE_V
#undef DIL_LOADQ
    ATT_BAR_L();
}
#undef ATT_WAIT_BAR
#undef ATT_BAR_L
}
constexpr int NWAVES = 8;
constexpr int N_LAUNCHES = MK_N_LAUNCHES;
constexpr int DEPTH = 4, SEQ = 16384, DM = 1024, NIN = 4096;
constexpr int N_PHASES = 1 + 3 * DEPTH;
constexpr size_t MiB = 1u << 20;
constexpr size_t WS_CTL = 0, CTL_ZERO_BYTES = 128 * 1024;
constexpr size_t WS_ROPE = 1 * MiB;
constexpr size_t WS_SSQ = 2 * MiB;
constexpr size_t WS_LP = 3 * MiB;
constexpr size_t WS_W = 6 * MiB, W_STRIDE = 10 * MiB, W_OUT_OFF = 8 * MiB;
constexpr size_t WS_XB = 46 * MiB;
constexpr size_t WS_MIX = 78 * MiB;
constexpr size_t WS_PROJ = 110 * MiB;
constexpr size_t WS_END = 246 * MiB;
constexpr int CW_BAR = 4096;
static_assert((16384 + 4 * 8 * 3 * 64) * 4 <= 128 * 1024, "control words inside the memset region");
constexpr int CW_GRP = 16384;
constexpr int RING_OFF = 0, RING_BYTES = 131072;
constexpr int LDSCTL_OFF = 151552, MISC_OFF = LDSCTL_OFF + 320;
constexpr int LDS_BYTES = 153600;
static_assert(att::LDS_END <= LDSCTL_OFF && RING_BYTES <= LDSCTL_OFF, "phase scratch below the control words");

#define GAS __attribute__((address_space(1)))
#define LAS __attribute__((address_space(3)))
typedef unsigned short bf16;
typedef unsigned v4u __attribute__((ext_vector_type(4)));
typedef float f32x4 __attribute__((ext_vector_type(4)));
typedef GAS unsigned gu32;
#define RLX_AGENT __ATOMIC_RELAXED, __HIP_MEMORY_SCOPE_AGENT
#define LDS_WAIT() asm volatile("s_waitcnt lgkmcnt(0)" ::: "memory")
#define VM_WAIT() asm volatile("s_waitcnt vmcnt(0)" ::: "memory")
__device__ __forceinline__ unsigned f2bf(float f) { unsigned u = __builtin_bit_cast(unsigned, f); return (u + 0x7fffu + ((u >> 16) & 1u)) >> 16; }
__device__ __forceinline__ unsigned pk2(float lo, float hi) { return f2bf(lo) | (f2bf(hi) << 16); }
#define XB_TMO      128
#define XB_XCNT(j)  (256  + 64 * (j))
#define XB_XSUB(j)  (1280 + 64 * (j))
#define XB_XGEN(j)  (2304 + 64 * (j))
#define XB_TOP      3328
#define XB_TOPGEN   3392
#define XCD_BAR_WORDS 3456
#define XB_SPIN_CAP (1u << 18)

__device__ __forceinline__ unsigned xb_ld(unsigned* p)              { return __hip_atomic_load(p, __ATOMIC_RELAXED, __HIP_MEMORY_SCOPE_AGENT); }
__device__ __forceinline__ unsigned xb_add(unsigned* p, unsigned v) { return __hip_atomic_fetch_add(p, v, __ATOMIC_RELAXED, __HIP_MEMORY_SCOPE_AGENT); }
__device__ __forceinline__ unsigned xb_xcc_id() { return (unsigned)__builtin_amdgcn_s_getreg((3 << 11) | 20) & 0xFu; }
#define XB_SPIN(cond, bar) do { unsigned _sp = 0; while (cond) { __builtin_amdgcn_s_sleep(1); \
    if ((++_sp & 255u) == 0u) { if (xb_ld(&(bar)[XB_TMO])) break; if (_sp > XB_SPIN_CAP) { atomicAdd(&(bar)[XB_TMO], 1u); break; } } } } while (0)

struct XcdBarrier {
    unsigned* bar; unsigned x;
    volatile LAS unsigned* st;
};

__device__ __forceinline__ XcdBarrier xcd_barrier_post(unsigned* bar, volatile LAS unsigned* st, bool leader) {
    XcdBarrier b; b.bar = bar; b.x = xb_xcc_id(); b.st = st;
    if (leader) (void)xb_add(&bar[XB_XCNT(b.x)], 1u);
    return b;
}
__device__ __forceinline__ void xcd_barrier_complete(unsigned* bar, unsigned x, unsigned& nloc, unsigned& nx) {
    const unsigned G = gridDim.x * gridDim.y * gridDim.z;
    unsigned sum, cnt, mine, sp = 0u;
    for (;;) {
        sum = 0u; cnt = 0u; mine = 0u;
#pragma unroll
        for (unsigned j = 0; j < 16; ++j) { const unsigned c = xb_ld(&bar[XB_XCNT(j)]); sum += c; cnt += (c > 0u) ? 1u : 0u; mine = (j == x) ? c : mine; }
        if (sum == G) break;
        __builtin_amdgcn_s_sleep(1);
        if ((++sp & 255u) == 0u) { if (xb_ld(&bar[XB_TMO])) break; if (sp > XB_SPIN_CAP) { atomicAdd(&bar[XB_TMO], 1u); break; } }
    }
    nloc = mine > 0u ? mine : 1u; nx = cnt > 0u ? cnt : 1u;
}

__device__ __forceinline__ void xcd_barrier(const XcdBarrier& b, bool leader) {
    asm volatile("s_waitcnt vmcnt(0)" ::: "memory");
    __syncthreads();
    if (leader) {
        unsigned* bar = b.bar;
        __builtin_amdgcn_s_waitcnt(0);
        unsigned nloc = b.st[0], nx = b.st[1];
        if (nloc == 0u) { xcd_barrier_complete(bar, b.x, nloc, nx); b.st[0] = nloc; b.st[1] = nx; }
        const unsigned old = xb_add(&bar[XB_XSUB(b.x)], 1u);
        const unsigned gen = old / nloc;
        if (old + 1u == (gen + 1u) * nloc) {
            __builtin_amdgcn_fence(__ATOMIC_RELEASE, "agent");
            asm volatile("s_waitcnt vmcnt(0)" ::: "memory");
            const unsigned og = xb_add(&bar[XB_TOP], 1u);
            const unsigned tg = og / nx;
            if (og + 1u == (tg + 1u) * nx) xb_add(&bar[XB_TOPGEN], 1u);
            else XB_SPIN(xb_ld(&bar[XB_TOPGEN]) == tg, bar);
            __builtin_amdgcn_fence(__ATOMIC_ACQUIRE, "agent");
            xb_add(&bar[XB_XGEN(b.x)], 1u);
            asm volatile("s_waitcnt vmcnt(0)" ::: "memory");
        } else {
            XB_SPIN(xb_ld(&bar[XB_XGEN(b.x)]) == gen, bar);
            __builtin_amdgcn_fence(__ATOMIC_ACQUIRE, "agent");
            asm volatile("s_waitcnt vmcnt(0)" ::: "memory");
        }
    }
    __syncthreads();
}
__device__ __forceinline__ float wave_sum(float v) {
    return lx_wave_sum(v);
}
template <bool PERMN> __device__ __forceinline__ void transpose_item(const float* W, int K, int N, bf16* WT, const float* gk, LAS float* scr, int item, int lane) {
    const int nblk = N / 32, kb = item / nblk, nb = item % nblk, k0 = 64 * kb, n0 = 32 * nb;
    float wv[32];
#pragma unroll
    for (int i = 0; i < 32; ++i) wv[i] = W[(size_t)(k0 + 2 * i + (lane >> 5)) * N + n0 + (lane & 31)];
    if (gk) {
#pragma unroll
        for (int i = 0; i < 32; ++i) wv[i] *= gk[k0 + 2 * i + (lane >> 5)]; }
#pragma unroll
    for (int i = 0; i < 32; ++i) scr[(2 * i + (lane >> 5)) * 33 + (lane & 31)] = wv[i];
    LDS_WAIT(); asm volatile("" ::: "memory");
    const int c = lane & 7;
#pragma unroll
    for (int j = 0; j < 4; ++j) { const int n = (lane >> 3) + 8 * j; const LAS float* s = scr + (8 * c) * 33 + n;
        v4u o; o.x = pk2(s[0 * 33], s[1 * 33]); o.y = pk2(s[2 * 33], s[3 * 33]); o.z = pk2(s[4 * 33], s[5 * 33]); o.w = pk2(s[6 * 33], s[7 * 33]);
        const int col = n0 + n; const int pos = PERMN ? ((col & ~255) + 128 * ((col >> 5) & 1) + 32 * ((col >> 6) & 3) + (col & 31)) : col;
        *(GAS v4u*)(WT + (size_t)pos * K + k0 + 8 * c) = o; }
    LDS_WAIT(); asm volatile("" ::: "memory");
}
struct KArgs { const float* x; const float* norm_g; const float* w_in; const float* q_norm_g; const float* k_norm_g; const float* w_out; float* out; unsigned char* ws; int ph_lo, ph_hi; };

__device__ __forceinline__ void convert_weights(const KArgs& a, int l, LAS unsigned char* lds, int vcu, int G, int wave0) {
    const int wave = wave0; const int tid = lx_tid(wave); const int lane = tid & 63; const int gw = vcu * NWAVES + wave, NGW = G * NWAVES;
    LAS float* scr = (LAS float*)(lds + RING_OFF + wave * 16384);
    bf16* WinT = (bf16*)(a.ws + WS_W + (size_t)l * W_STRIDE); bf16* WoutT = (bf16*)(a.ws + WS_W + (size_t)l * W_STRIDE + W_OUT_OFF);
    constexpr int I_IN = (DM / 64) * (NIN / 32), I_OUT = (DM / 64) * (DM / 32);
    for (int it = gw; it < I_IN + I_OUT; it += NGW) {
        if (it < I_IN) transpose_item<true>(a.w_in + (size_t)l * DM * NIN, DM, NIN, WinT, a.norm_g + l * DM, scr, it, lane);
        else transpose_item<false>(a.w_out + (size_t)l * DM * DM, DM, DM, WoutT, nullptr, scr, it - I_IN, lane);
    }
}
__device__ __forceinline__ void sincos_acc(float angf, float& c, float& s) {
    const double ang = (double)angf; const double kq = __builtin_rint(ang * 0.63661977236758134308);
    const double r = __builtin_fma(-kq, 1.5707963267948966192, ang) - kq * 6.123233995736766036e-17; const double r2 = r * r;
    double sp = -1.0 / 1307674368000.0; sp = sp * r2 + 1.0 / 6227020800.0; sp = sp * r2 - 1.0 / 39916800.0; sp = sp * r2 + 1.0 / 362880.0; sp = sp * r2 - 1.0 / 5040.0; sp = sp * r2 + 1.0 / 120.0; sp = sp * r2 - 1.0 / 6.0; sp = sp * r2 * r + r;
    double cp = 1.0 / 87178291200.0; cp = cp * r2 - 1.0 / 479001600.0; cp = cp * r2 + 1.0 / 3628800.0; cp = cp * r2 - 1.0 / 40320.0; cp = cp * r2 + 1.0 / 720.0; cp = cp * r2 - 1.0 / 24.0; cp = cp * r2 + 0.5; cp = 1.0 - cp * r2;
    const int q = ((int)kq) & 3;
    const double sv = (q == 0) ? sp : (q == 1) ? cp : (q == 2) ? -sp : -cp, cv = (q == 0) ? cp : (q == 1) ? -sp : (q == 2) ? -cp : sp;
    c = (float)cv; s = (float)sv;
}
__device__ __forceinline__ float inv_freq(int i) {
    return i == 0 ? 1.0f : i == 1 ? 0.193922758102417f : i == 2 ? 0.03760603070259094f : i == 3 ? 0.00729266507551074f : i == 4 ? 0.001414213445968926f : i == 5 ? 0.00027424818836152554f : i == 6 ? 5.318296462064609e-05f : 1.0313385246263351e-05f;
}

__global__ void __launch_bounds__(NWAVES * 64, 2) hsdg_fwd(KArgs args) {
    extern __shared__ __attribute__((aligned(16))) unsigned char lds_raw[];
    LAS unsigned char* lds = (LAS unsigned char*)lds_raw;
    volatile LAS unsigned* MISC = (volatile LAS unsigned*)(lds + MISC_OFF);
    const int wave0 = __builtin_amdgcn_readfirstlane((int)threadIdx.x >> 6); const int tid0 = lx_tid(wave0);
    const int G = gridDim.x; const int bx = blockIdx.x; const int vcu = (G % 8 == 0) ? (bx % 8) * (G / 8) + bx / 8 : bx;
    unsigned char* ws = args.ws;
    gu32* ctl = (gu32*)(ws + WS_CTL);
    for (int u = tid0; u < (LDS_BYTES - LDSCTL_OFF) / 4; u += NWAVES * 64) ((LAS unsigned*)(lds + LDSCTL_OFF))[u] = 0u;
    __syncthreads();
    XcdBarrier bar; bar.bar = (unsigned*)(ctl + CW_BAR); bar.x = 0; bar.st = nullptr;
    if (N_LAUNCHES == 1) bar = xcd_barrier_post((unsigned*)(ctl + CW_BAR), MISC + 8, tid0 == 0);
#define GRID_BAR() do { if (N_LAUNCHES == 1) xcd_barrier(bar, lx_tid(wave0) == 0); } while (0)
    const int lo = args.ph_lo, hi = args.ph_hi;
#define IN(k) (lo <= (k) && (k) < hi)
#define BOTH(k) (IN(k) && IN((k) + 1))
#define PHASE_PTRS() unsigned char* wsp = ws; asm volatile("" : "+s"(wsp)); float* rope = (float*)(wsp + WS_ROPE); float* ssq = (float*)(wsp + WS_SSQ); float* lp = (float*)(wsp + WS_LP); \
        bf16* XB = (bf16*)(wsp + WS_XB); bf16* MIX = (bf16*)(wsp + WS_MIX); bf16* PROJ = (bf16*)(wsp + WS_PROJ); (void)rope; (void)ssq; (void)lp; (void)XB; (void)MIX; (void)PROJ

    if (IN(0)) {
        PHASE_PTRS(); for (int l = 0; l < DEPTH; ++l) convert_weights(args, l, lds, vcu, G, wave0);
        const int wave = wave0; const int tid = lx_tid(wave); const int lane = tid & 63; const int gw = vcu * NWAVES + wave, NGW = G * NWAVES;
        for (int m = gw; m < SEQ; m += 4 * NGW) {
            f32x4 v[4][4]; float s2[4];
#pragma unroll
            for (int q = 0; q < 4; ++q) { const int mm = m + q * NGW; const GAS f32x4* xr = (const GAS f32x4*)(args.x + (size_t)(mm < SEQ ? mm : m) * DM) + lane;
#pragma unroll
                for (int j = 0; j < 4; ++j) v[q][j] = xr[64 * j]; }
#pragma unroll
            for (int q = 0; q < 4; ++q) { float a = 0.f;
#pragma unroll
                for (int j = 0; j < 4; ++j) a += (v[q][j].x * v[q][j].x + v[q][j].y * v[q][j].y) + (v[q][j].z * v[q][j].z + v[q][j].w * v[q][j].w);
                s2[q] = wave_sum(a); }
#pragma unroll
            for (int q = 0; q < 4; ++q) { const int mm = m + q * NGW; if (mm < SEQ) {
                GAS unsigned long long* o8 = (GAS unsigned long long*)(XB + (size_t)mm * DM) + lane;
#pragma unroll
                for (int j = 0; j < 4; ++j) o8[64 * j] = (unsigned long long)pk2(v[q][j].x, v[q][j].y) | ((unsigned long long)pk2(v[q][j].z, v[q][j].w) << 32);
                if (lane < 4) ssq[(size_t)mm * 4 + lane] = (lane == 0) ? s2[q] : 0.f; } }
        }
        for (int i = bx * (NWAVES * 64) + tid; i < SEQ * 8; i += G * NWAVES * 64) { const int pos = i >> 3, k = i & 7; float c, s; sincos_acc((float)pos * inv_freq(k), c, s); rope[pos * 16 + k] = c; rope[pos * 16 + 8 + k] = s; }
        if (BOTH(0)) GRID_BAR();
    }
    for (int l = 0; l < DEPTH; ++l) {
        const int pA = 1 + 3 * l, pB = pA + 1, pC = pA + 2;
        if (IN(pA)) {
            PHASE_PTRS(); bf16* WinT = (bf16*)(wsp + WS_W + (size_t)l * W_STRIDE); const float* qg = args.q_norm_g + l * 64; const float* kg = args.k_norm_g + l * 64;
            pg8::Gemm g{XB, WinT, SEQ, NIN, DM}; pg8::StaticOrder S; S.init(SEQ, NIN, G, bx);
            { static_assert(pg8::EpiInProj::OFF_ROPE == WS_ROPE && pg8::EpiInProj::OFF_SSQ == WS_SSQ && pg8::EpiInProj::OFF_P == WS_PROJ, "workspace offsets"); pg8::EpiInProj E{wsp, qg, kg};
            pg8::gemm_phase<pg8::EpiInProj, pg8::StaticOrder, true, true>(lds + RING_OFF, g, S, E, wave0); }
            if (BOTH(pA)) GRID_BAR();
        }
        if (IN(pB)) {
            PHASE_PTRS(); const float* qg = args.q_norm_g + l * 64; const float* kg = args.k_norm_g + l * 64; gu32* ctlp = (gu32*)(wsp + WS_CTL);
            const att::SbArgs SA{PROJ, MIX};
            const att::DilArgs DA{PROJ, XB, MIX, lp, (unsigned*)(ctlp + CW_GRP + l * 8 * 3 * 64), qg, kg};
            for (int u = vcu; u < 256; u += G) att::sb_unit<SB_EARLY_EXIT != 0>(u >> 6, u & 63, SA, (att::lds_ptr)(lds + RING_OFF), wave0);
            att::dil_phase<0>(vcu, G, DA, (att::lds_ptr)(lds + RING_OFF), wave0);
            if (BOTH(pB)) GRID_BAR();
        }
        if (IN(pC)) {
            PHASE_PTRS(); bf16* WoutT = (bf16*)(wsp + WS_W + (size_t)l * W_STRIDE + W_OUT_OFF);
            pg8::Gemm g{MIX, WoutT, SEQ, DM, DM}; pg8::StaticOrder S; S.init(SEQ, DM, G, bx);
            pg8::EpiOutProj E{l == 0 ? args.x : args.out, args.out, XB, ssq};
            pg8::gemm_phase<pg8::EpiOutProj, pg8::StaticOrder, false, true>(lds + RING_OFF, g, S, E, wave0);
            if (pC + 1 < N_PHASES && BOTH(pC)) GRID_BAR();
        }
    }
#undef IN
#undef BOTH
#undef GRID_BAR
}

extern "C" void kernel_launch(void* const* d_in, const int* in_sizes, int n_in, void* d_out, int out_size, void* d_ws, size_t ws_size, hipStream_t stream) {
    static int grid = 0;
    if (grid == 0) {
        if (n_in != 6 || in_sizes[0] != SEQ * DM || out_size != SEQ * DM || ws_size < WS_END) { fprintf(stderr, "kernel_launch: unexpected shapes / workspace (n_in %d, in0 %d, out %d, ws %zu, need %zu)\n", n_in, n_in > 0 ? in_sizes[0] : -1, out_size, ws_size, (size_t)WS_END); grid = -1; return; }
        int dev = 0, cus = 0, per_cu = 0;
        if (hipGetDevice(&dev) != hipSuccess || hipDeviceGetAttribute(&cus, hipDeviceAttributeMultiprocessorCount, dev) != hipSuccess) { fprintf(stderr, "kernel_launch: device query failed\n"); grid = -1; return; }
        if (hipFuncSetAttribute((const void*)hsdg_fwd, hipFuncAttributeMaxDynamicSharedMemorySize, LDS_BYTES) != hipSuccess) { fprintf(stderr, "kernel_launch: hipFuncSetAttribute failed\n"); grid = -1; return; }
        if (hipOccupancyMaxActiveBlocksPerMultiprocessor(&per_cu, (const void*)hsdg_fwd, NWAVES * 64, LDS_BYTES) != hipSuccess || per_cu < 1) fprintf(stderr, "kernel_launch: note: occupancy query reports %d workgroups per CU\n", per_cu);
        (void)hipGetLastError();
        grid = cus;
        if (grid != 256) fprintf(stderr, "kernel_launch: %d CUs; the out-proj phase assumes 256 workgroups\n", grid);
    }
    if (grid < 0) return;
    if (hipMemsetAsync((char*)d_ws + WS_CTL, 0, CTL_ZERO_BYTES, stream) != hipSuccess) { fprintf(stderr, "kernel_launch: hipMemsetAsync failed\n"); return; }
    KArgs a{};
    a.x = (const float*)d_in[0]; a.norm_g = (const float*)d_in[1]; a.w_in = (const float*)d_in[2]; a.q_norm_g = (const float*)d_in[3]; a.k_norm_g = (const float*)d_in[4]; a.w_out = (const float*)d_in[5];
    a.out = (float*)d_out; a.ws = (unsigned char*)d_ws;
    if (N_LAUNCHES == 1) { a.ph_lo = 0; a.ph_hi = N_PHASES; hipLaunchKernelGGL(hsdg_fwd, dim3(grid), dim3(NWAVES * 64), LDS_BYTES, stream, a); }
    else for (int ph = 0; ph < N_PHASES; ++ph) { a.ph_lo = ph; a.ph_hi = ph + 1; hipLaunchKernelGGL(hsdg_fwd, dim3(grid), dim3(NWAVES * 64), LDS_BYTES, stream, a); }
    const hipError_t le = hipPeekAtLastError();
    if (le != hipSuccess) fprintf(stderr, "kernel_launch: launch failed: %s\n", hipGetErrorName(le));
}
```

```cpp
#include <hip/hip_runtime.h>
#include <cstdio>
#include <cstdint>
#ifndef MK_N_LAUNCHES
#define MK_N_LAUNCHES 1
#endif
#ifndef SB_EARLY_EXIT
#define SB_EARLY_EXIT 1
#endif
template <int X> __device__ __forceinline__ float lx_xor(float v) { return __builtin_bit_cast(float, __builtin_amdgcn_ds_swizzle(__builtin_bit_cast(int, v), (X << 10) | 0x1f)); }
__device__ __forceinline__ int lx_lane() { int l; asm volatile("v_mbcnt_lo_u32_b32 %0, -1, 0\n\tv_mbcnt_hi_u32_b32 %0, -1, %0" : "=v"(l)); return l; }
__device__ __forceinline__ float lx_xor32(float v) { return __builtin_bit_cast(float, __builtin_amdgcn_ds_bpermute((lx_lane() ^ 32) << 2, __builtin_bit_cast(int, v))); }
__device__ __forceinline__ float lx_sum32(float v) { return v + lx_xor32(v); }
__device__ __forceinline__ float lx_max32(float v) { return __builtin_fmaxf(v, lx_xor32(v)); }
__device__ __forceinline__ float lx_wave_sum(float v) { v += lx_xor<1>(v); v += lx_xor<2>(v); v += lx_xor<4>(v); v += lx_xor<8>(v); v += lx_xor<16>(v); return lx_sum32(v); }
__device__ __forceinline__ float lx_wave_max(float v) { v = __builtin_fmaxf(v, lx_xor<1>(v)); v = __builtin_fmaxf(v, lx_xor<2>(v)); v = __builtin_fmaxf(v, lx_xor<4>(v)); v = __builtin_fmaxf(v, lx_xor<8>(v)); v = __builtin_fmaxf(v, lx_xor<16>(v)); return lx_max32(v); }
__device__ __forceinline__ int lx_tid(int wave) { return wave * 64 + lx_lane(); }
namespace pg8 {
#define PG8_LAS __attribute__((address_space(3)))
typedef unsigned short bf16_t;
typedef short bf16x8 __attribute__((ext_vector_type(8)));
typedef float f32x4 __attribute__((ext_vector_type(4)));
typedef unsigned u32x4 __attribute__((ext_vector_type(4)));
constexpr int BM = 256, BK = 64, HALF = 128, HTB = HALF * BK * 2  , STAGE_BYTES = 8 * HTB, NXCD = 8, WGM = 8;

__host__ __device__ __forceinline__ int lds_byte(int r, int c) { const int st = (r >> 4) * 2 + (c >> 5), rr = r & 15, cc = c & 31, ob = rr * 64 + cc * 2; return st * 1024 + (ob ^ (((ob >> 9) & 1) << 5)); }
__host__ __device__ __forceinline__ void stage_rc(int b, int& R, int& C) { const int st = b / 1024, sb = b % 1024, swz = sb ^ (((sb >> 9) & 1) << 5); R = (st >> 1) * 16 + swz / 64; C = (st & 1) * 32 + (swz % 64) / 2; }
__host__ __device__ __forceinline__ int perm32(int rho) { const int n = rho >> 4, i = rho & 15; return 8 * (i >> 2) + 4 * n + (i & 3); }

struct Unit { int pm, pn; };
struct Gemm { const bf16_t* A; const bf16_t* Bt; int M, N, K; };

struct StaticOrder {
    int nM, nN, nwg, G, c;
    __host__ __device__ void init(int M, int N, int G_, int c_) { nM = M / BM; nN = N / BM; nwg = nM * nN; G = G_; c = c_; }
    __host__ __device__ bool next(int i, Unit& u) const {
        const long L = (long)i * G + c; if (L >= nwg) return false;
        int wgid = (int)L; { const int q = nwg / NXCD, r = nwg % NXCD, xcd = wgid % NXCD, off = wgid / NXCD; wgid = (xcd < r ? xcd * (q + 1) : r * (q + 1) + (xcd - r) * q) + off; }
        const int nig = WGM * nN, gid = wgid / nig, fm = gid * WGM, gsz = (nM - fm) < WGM ? (nM - fm) : WGM;
        u.pm = fm + ((wgid % nig) % gsz); u.pn = (wgid % nig) / gsz; return true;
    }
    __device__ __forceinline__ void a_ready(const Unit&) const {}
    __device__ __forceinline__ void done(const Unit&) const {}
};

typedef float f32x2 __attribute__((ext_vector_type(2)));
typedef __bf16 bf16x2_t __attribute__((ext_vector_type(2)));
__device__ __forceinline__ unsigned cvtpk(float lo, float hi) { f32x2 v = {lo, hi}; bf16x2_t b = __builtin_convertvector(v, bf16x2_t); return __builtin_bit_cast(unsigned, b); }
constexpr int SEQ = 16384; constexpr int PROWS = SEQ + SEQ / 16; constexpr size_t TSTRIDE = (size_t)PROWS * 64;
constexpr float EPSV = 1e-6f;
constexpr float QSCALE = 0.125f * 1.4426950408889634f;

constexpr float ROT_C[8][8] = {{1.000000000e+00f, 1.000000000e+00f, 1.000000000e+00f, 1.000000000e+00f, 1.000000000e+00f, 1.000000000e+00f, 1.000000000e+00f, 1.000000000e+00f}, {-9.576594803e-01f, -9.992462676e-01f, 8.243765167e-01f, 9.932003006e-01f, 9.997440110e-01f, 9.999903729e-01f, 9.999996380e-01f, 9.999999864e-01f}, {8.342233605e-01f, 9.969862065e-01f, 3.591932825e-01f, 9.728936743e-01f, 9.989761749e-01f, 9.999614917e-01f, 9.999985518e-01f, 9.999999455e-01f}, {-6.401443395e-01f, -9.932232238e-01f, -2.321555027e-01f, 9.393562789e-01f, 9.976968850e-01f, 9.999133569e-01f, 9.999967417e-01f, 9.999998775e-01f}, {-6.928958219e-01f, 9.521417467e-01f, 1.010103862e-01f, 5.950558964e-01f, 9.836606931e-01f, 9.993839260e-01f, 9.999768296e-01f, 9.999991287e-01f}, {8.711474010e-01f, -9.395588652e-01f, 6.464173313e-01f, 4.974463326e-01f, 9.793355680e-01f, 9.992203026e-01f, 9.999706750e-01f, 9.999988972e-01f}, {-9.756293128e-01f, 9.255596318e-01f, 9.647721496e-01f, 3.930717976e-01f, 9.745090446e-01f, 9.990374400e-01f, 9.999637963e-01f, 9.999986385e-01f}, {9.974939203e-01f, -9.101651497e-01f, 9.442536768e-01f, 2.833517226e-01f, 9.691835939e-01f, 9.988353416e-01f, 9.999561936e-01f, 9.999983526e-01f}};
constexpr float ROT_S[8][8] = {{0.000000000e+00f, 0.000000000e+00f, 0.000000000e+00f, 0.000000000e+00f, 0.000000000e+00f, 0.000000000e+00f, 0.000000000e+00f, 0.000000000e+00f}, {-2.879033167e-01f, 3.881876802e-02f, 5.660418348e-01f, 1.164180522e-01f, 2.262548431e-02f, 4.387956933e-03f, 8.509273312e-04f, 1.650141632e-04f}, {5.514266812e-01f, -7.757901811e-02f, 9.332631922e-01f, 2.312528888e-01f, 4.523938487e-02f, 8.775829378e-03f, 1.701854046e-03f, 3.300283219e-04f}, {-7.682546613e-01f, 1.162223206e-01f, 9.726786841e-01f, 3.429428252e-01f, 6.783012386e-02f, 1.316353285e-02f, 2.552779529e-03f, 4.950424716e-04f}, {7.210377105e-01f, -3.056568242e-01f, -9.948853712e-01f, 8.036843162e-01f, 1.800323329e-01f, 3.509655897e-02f, 6.807366895e-03f, 1.320112928e-03f}, {-4.910215939e-01f, 3.423874103e-01f, -7.629840324e-01f, 8.674947529e-01f, 2.022420461e-01f, 3.948147472e-02f, 7.658272045e-03f, 1.485126930e-03f}, {2.194252584e-01f, -3.786018594e-01f, -2.630868667e-01f, 9.195077824e-01f, 2.243482159e-01f, 4.386563028e-02f, 8.509171650e-03f, 1.650140891e-03f}, {7.075223608e-02f, 4.142455796e-01f, 3.292187630e-01f, 9.590160589e-01f, 2.463395243e-01f, 4.824894124e-02f, 9.360065094e-03f, 1.815154807e-03f}};
struct EpiInProj {
    static constexpr bool PERM = true, AFTER_DRAIN = false;
    unsigned char* wsb; const float* qg; const float* kg;
    static constexpr size_t OFF_ROPE = (size_t)1 << 20, OFF_SSQ = (size_t)2 << 20, OFF_P = (size_t)110 << 20;
    __device__ __forceinline__ void operator()(const f32x4 (&acc)[2][2][4][2], const Unit& u, int wr, int wc, int fr, int fq) const {
        bf16_t* const P = (bf16_t*)(wsb + OFF_P); const float* const ssq = (const float*)(wsb + OFF_SSQ); const float* const rope = (const float*)(wsb + OFF_ROPE);
        const int pn = u.pn;
        const int kind = (pn == 0) ? 0 : ((pn == 3 || pn >= 13) ? 1 : ((pn >= 4 && pn <= 6) ? 2 : ((pn >= 7 && pn <= 9) ? 3 : 4)));
        bf16_t* const tens = P + (size_t)(pn * 4 + wc) * TSTRIDE + 8 * fq;
        const int row0 = u.pm * BM + wr * 64 + fr;
        f32x4 sq[8];
#pragma unroll
        for (int j = 0; j < 8; ++j) sq[j] = *(const f32x4*)(ssq + (size_t)(row0 + (j >> 2) * HALF + (j & 3) * 16) * 4);
        f32x4 g[2][2], cb[2], sb[2];
#pragma unroll
        for (int bj = 0; bj < 2; ++bj)
#pragma unroll
            for (int n = 0; n < 2; ++n) g[bj][n] = (f32x4){1.f, 1.f, 1.f, 1.f};
#pragma unroll
        for (int n = 0; n < 2; ++n) { cb[n] = (f32x4){1.f, 1.f, 1.f, 1.f}; sb[n] = (f32x4){0.f, 0.f, 0.f, 0.f}; }
        if (kind == 2 || kind == 3) { const float* gp = (kind == 2) ? qg : kg;
#pragma unroll
            for (int bj = 0; bj < 2; ++bj)
#pragma unroll
                for (int n = 0; n < 2; ++n) g[bj][n] = *(const f32x4*)(gp + 32 * bj + 8 * fq + 4 * n);
#pragma unroll
            for (int n = 0; n < 2; ++n) { cb[n] = *(const f32x4*)(rope + (size_t)row0 * 16 + 4 * n); sb[n] = *(const f32x4*)(rope + (size_t)row0 * 16 + 8 + 4 * n); } }
        float rs[8];
#pragma unroll
        for (int j = 0; j < 8; ++j) rs[j] = __builtin_amdgcn_rsqf(((sq[j][0] + sq[j][1]) + (sq[j][2] + sq[j][3])) * (1.0f / 1024.0f) + EPSV);
#pragma unroll
        for (int ai = 0; ai < 2; ++ai)
#pragma unroll
            for (int m = 0; m < 4; ++m) {
                const int row = row0 + ai * HALF + m * 16;
                f32x4 v[2][2];
#pragma unroll
                for (int bj = 0; bj < 2; ++bj)
#pragma unroll
                    for (int n = 0; n < 2; ++n) v[bj][n] = acc[ai][bj][m][n] * rs[ai * 4 + m];
                if (kind == 0) {
#pragma unroll
                    for (int bj = 0; bj < 2; ++bj)
#pragma unroll
                        for (int n = 0; n < 2; ++n) v[bj][n] = v[bj][n] * QSCALE;
                } else if (kind == 1) {
#pragma unroll
                    for (int bj = 0; bj < 2; ++bj)
#pragma unroll
                        for (int n = 0; n < 2; ++n)
#pragma unroll
                            for (int e = 0; e < 4; ++e) { const float x = v[bj][n][e]; v[bj][n][e] = x * __builtin_amdgcn_rcpf(1.0f + __builtin_amdgcn_exp2f(-1.4426950408889634f * x)); }
                } else if (kind == 2 || kind == 3) {
                    float hs = 0.f;
#pragma unroll
                    for (int bj = 0; bj < 2; ++bj)
#pragma unroll
                        for (int n = 0; n < 2; ++n) { const f32x4 x = v[bj][n]; hs += (x[0] * x[0] + x[1] * x[1]) + (x[2] * x[2] + x[3] * x[3]); }
                    hs += lx_xor<16>(hs); hs = lx_sum32(hs);
                    const float hr = __builtin_amdgcn_rsqf(hs * (1.0f / 64.0f) + EPSV);
#pragma unroll
                    for (int bj = 0; bj < 2; ++bj)
#pragma unroll
                        for (int n = 0; n < 2; ++n) v[bj][n] = v[bj][n] * hr * g[bj][n];
#pragma unroll
                    for (int n = 0; n < 2; ++n)
#pragma unroll
                        for (int e = 0; e < 4; ++e) { const int i = 4 * n + e; const float cr = ROT_C[ai * 4 + m][i], sr = ROT_S[ai * 4 + m][i];
                            const float cc = cb[n][e] * cr - sb[n][e] * sr, ss2 = sb[n][e] * cr + cb[n][e] * sr;
                            const float own = v[0][n][e]; const float oth = lx_xor<16>(own);
                            const float r0 = own * cc - oth * ss2, r1 = own * cc + oth * ss2;
                            v[0][n][e] = (fq == 0) ? r0 : ((fq == 1) ? r1 : own); }
                    if (kind == 2) {
#pragma unroll
                        for (int bj = 0; bj < 2; ++bj)
#pragma unroll
                            for (int n = 0; n < 2; ++n) v[bj][n] = v[bj][n] * QSCALE;
                    }
                }
                bf16_t* rowp = tens + (size_t)(row + (row >> 4)) * 64;
#pragma unroll
                for (int bj = 0; bj < 2; ++bj) { u32x4 w; w.x = cvtpk(v[bj][0][0], v[bj][0][1]); w.y = cvtpk(v[bj][0][2], v[bj][0][3]); w.z = cvtpk(v[bj][1][0], v[bj][1][1]); w.w = cvtpk(v[bj][1][2], v[bj][1][3]);
                    *(u32x4*)(rowp + 32 * bj) = w; }
            }
    }
};

struct EpiOutProj {
    static constexpr bool PERM = true, AFTER_DRAIN = true;
    const float* xin; float* xout; bf16_t* xb; float* ssq; int last;
    __device__ __forceinline__ void fused(f32x4 (&acc)[2][2][4][2], const Unit& u, int wr, int wc, int fr, int fq, PG8_LAS unsigned char* lds, int wid, int lane) const {
        PG8_LAS float* Pw = (PG8_LAS float*)lds;
        const size_t off0 = (size_t)(u.pm * BM + wr * 64 + fr) * 1024 + u.pn * BM + wc * 32 + 8 * fq;
        f32x4 pre[2][2][2][2];
#define EOP_LOAD(buf, pr) do { _Pragma("unroll") for (int q_ = 0; q_ < 2; ++q_) { const int j_ = 2 * (pr) + q_; const size_t o_ = off0 + (size_t)((j_ >> 2) * HALF + (j_ & 3) * 16) * 1024; \
            _Pragma("unroll") for (int bj = 0; bj < 2; ++bj) { pre[buf][q_][bj][0] = *(const f32x4*)(xin + o_ + bj * HALF); pre[buf][q_][bj][1] = *(const f32x4*)(xin + o_ + bj * HALF + 4); } } } while (0)
        EOP_LOAD(0, 0); asm volatile("" ::: "memory"); EOP_LOAD(1, 1); asm volatile("" ::: "memory");
#pragma unroll
        for (int pr = 0; pr < 4; ++pr) {
#pragma unroll
            for (int q = 0; q < 2; ++q) { const int j = 2 * pr + q, ai = j >> 2, m = j & 3; const int rt = ai * HALF + wr * 64 + m * 16 + fr; const size_t off = off0 + (size_t)(ai * HALF + m * 16) * 1024;
                float s = 0.f;
#pragma unroll
                for (int bj = 0; bj < 2; ++bj) {
                    const f32x4 a0 = pre[pr & 1][q][bj][0] + acc[ai][bj][m][0], a1 = pre[pr & 1][q][bj][1] + acc[ai][bj][m][1];
                    *(f32x4*)(xout + off + bj * HALF) = a0; *(f32x4*)(xout + off + bj * HALF + 4) = a1;
                    if (!last) { u32x4 w; w.x = cvtpk(a0[0], a0[1]); w.y = cvtpk(a0[2], a0[3]); w.z = cvtpk(a1[0], a1[1]); w.w = cvtpk(a1[2], a1[3]);
                        *(u32x4*)(xb + off + bj * HALF) = w; }
                    s += ((a0[0] * a0[0] + a0[1] * a0[1]) + (a0[2] * a0[2] + a0[3] * a0[3])) + ((a1[0] * a1[0] + a1[1] * a1[1]) + (a1[2] * a1[2] + a1[3] * a1[3]));
                }
                s += lx_xor<16>(s); s = lx_sum32(s);
                if (fq == 0) Pw[rt * 4 + wc] = s; }
            asm volatile("" ::: "memory");
            if (pr + 2 < 4) { EOP_LOAD(pr & 1, pr + 2); asm volatile("" ::: "memory"); }
        }
#undef EOP_LOAD
        asm volatile("s_waitcnt lgkmcnt(0)" ::: "memory"); __builtin_amdgcn_s_barrier(); asm volatile("" ::: "memory");
        const int t = wid * 64 + lane;
        if (t < 256) { const float s = (Pw[t * 4 + 0] + Pw[t * 4 + 1]) + (Pw[t * 4 + 2] + Pw[t * 4 + 3]); ssq[(size_t)(u.pm * BM + t) * 4 + u.pn] = s; }
        asm volatile("s_waitcnt lgkmcnt(0)" ::: "memory"); __builtin_amdgcn_s_barrier(); asm volatile("" ::: "memory");
    }
};

template <class Epi, class Sched, bool ALIGN_EPI = false, bool SP2 = false>
__device__ __forceinline__ void gemm_phase(PG8_LAS unsigned char* lds, const Gemm g, const Sched& S, const Epi& E, int wave) {
    int wid = wave; asm volatile("" : "+s"(wid)); const int tid = lx_tid(wid);
    const int lane = tid & 63, wr = wid >> 2, wc = wid & 3, fr = lane & 15, fq = lane >> 4;
    const int K = g.K, nt = K / BK;
    unsigned voffA[2], voffB[2];
#pragma unroll
    for (int i = 0; i < 2; ++i) { int R, C; stage_rc(tid * 16 + i * 8192, R, C); const int Rb = Epi::PERM ? ((R & ~31) + perm32(R & 31)) : R;
        voffA[i] = (unsigned)(R * K + C) * 2u; voffB[i] = (unsigned)(Rb * K + C) * 2u; }
    const size_t kstep = (size_t)(BK * 2);
    const size_t hstep = (size_t)HALF * K * 2;
    const size_t tstep = 2 * hstep;
    const unsigned ldsw = (unsigned)wid * 1024u;
    const int aoff = lds_byte(wr * 64 + fr, fq * 8), boff = lds_byte(wc * 32 + fr, fq * 8);
#define PG8_SA(b, h) (((b) * 2 + (h)) * HTB)
#define PG8_SB(b, h) ((4 + (b) * 2 + (h)) * HTB)
#define PG8_STAGE(bufoff, gbase, voff) do { _Pragma("unroll") for (int _i = 0; _i < 2; ++_i) \
        __builtin_amdgcn_global_load_lds((const unsigned*)((const char*)(gbase) + (voff)[_i]), (PG8_LAS unsigned*)(lds + (bufoff) + ldsw + _i * 8192), 16, 0, 0); } while (0)
#define PG8_LDA(dst, b, h) do { _Pragma("unroll") for (int m = 0; m < 4; ++m) _Pragma("unroll") for (int k = 0; k < 2; ++k) dst[m][k] = *(const PG8_LAS bf16x8*)(lds + PG8_SA(b, h) + aoff + m * 2048 + k * 1024); } while (0)
#define PG8_LDB(dst, b, h) do { _Pragma("unroll") for (int n = 0; n < 2; ++n) _Pragma("unroll") for (int k = 0; k < 2; ++k) dst[n][k] = *(const PG8_LAS bf16x8*)(lds + PG8_SB(b, h) + boff + n * 2048 + k * 1024); } while (0)
#define PG8_MMA(ai, bj, At, Bt) do { __builtin_amdgcn_s_setprio(1); _Pragma("unroll") for (int m = 0; m < 4; ++m) _Pragma("unroll") for (int n = 0; n < 2; ++n) _Pragma("unroll") for (int k = 0; k < 2; ++k) \
        acc[ai][bj][m][n] = __builtin_amdgcn_mfma_f32_16x16x32_bf16(Bt[n][k], At[m][k], acc[ai][bj][m][n], 0, 0, 0); __builtin_amdgcn_s_setprio(0); } while (0)
#define PG8_WAIT_V(n) asm volatile("s_waitcnt vmcnt(" #n ")" ::: "memory")
#define PG8_WAIT_L(n) asm volatile("s_waitcnt lgkmcnt(" #n ")" ::: "memory")
#define PG8_BAR __builtin_amdgcn_s_barrier()
#define PG8_SCHED __builtin_amdgcn_sched_barrier(0)
    Unit cur, nxt; int ui = 0;
    if (!S.next(0, cur)) return;
    f32x4 acc[2][2][4][2];
#pragma unroll
    for (int a = 0; a < 2; ++a)
#pragma unroll
        for (int b = 0; b < 2; ++b)
#pragma unroll
            for (int m = 0; m < 4; ++m)
#pragma unroll
                for (int n = 0; n < 2; ++n) acc[a][b][m][n] = (f32x4){0.f, 0.f, 0.f, 0.f};
    bf16x8 At[4][2], B0[2][2], B1[2][2];
    const char* cA = (const char*)g.A + (size_t)cur.pm * tstep; const char* cB = (const char*)g.Bt + (size_t)cur.pn * tstep;
    S.a_ready(cur);
    if constexpr (SP2) {
        PG8_STAGE(PG8_SB(0, 0), cB, voffB); PG8_STAGE(PG8_SB(0, 1), cB + hstep, voffB); PG8_STAGE(PG8_SA(0, 0), cA, voffA); PG8_STAGE(PG8_SA(0, 1), cA + hstep, voffA);
        if (wr == 1) PG8_BAR;
        PG8_WAIT_V(2); PG8_BAR;
        PG8_STAGE(PG8_SB(1, 0), cB + kstep, voffB); PG8_STAGE(PG8_SA(1, 0), cA + kstep, voffA); PG8_STAGE(PG8_SB(1, 1), cB + hstep + kstep, voffB);
        PG8_WAIT_V(6); PG8_BAR;
    } else {
        PG8_STAGE(PG8_SB(0, 0), cB, voffB); PG8_STAGE(PG8_SA(0, 0), cA, voffA); PG8_STAGE(PG8_SB(0, 1), cB + hstep, voffB); PG8_STAGE(PG8_SA(0, 1), cA + hstep, voffA);
        if (wr == 1) PG8_BAR;
        PG8_WAIT_V(4); PG8_BAR;
        PG8_STAGE(PG8_SB(1, 0), cB + kstep, voffB); PG8_STAGE(PG8_SA(1, 0), cA + kstep, voffA); PG8_STAGE(PG8_SB(1, 1), cB + hstep + kstep, voffB);
        PG8_WAIT_V(6); PG8_BAR;
    }
    for (;;) {
        const bool has_next = S.next(ui + 1, nxt);
        const char* nA = has_next ? (const char*)g.A + (size_t)nxt.pm * tstep : cA; const char* nB = has_next ? (const char*)g.Bt + (size_t)nxt.pn * tstep : cB;
        for (int t = 0; t < nt; t += 2) {
            const bool last = (t == nt - 2);
            const char* a1 = cA + (size_t)(t + 1) * kstep;
            const char* a2 = last ? nA : cA + (size_t)(t + 2) * kstep; const char* b2 = last ? nB : cB + (size_t)(t + 2) * kstep;
            const char* a3 = a2 + kstep; const char* b3 = b2 + kstep;
            if (last && has_next) S.a_ready(nxt);
            if constexpr (SP2) {
            PG8_LDB(B0, 0, 0); PG8_LDB(B1, 0, 1); PG8_SCHED; PG8_LDA(At, 0, 0); PG8_STAGE(PG8_SA(1, 1), a1 + hstep, voffA);
            PG8_WAIT_V(8); PG8_WAIT_L(0); PG8_BAR; PG8_MMA(0, 0, At, B0); PG8_MMA(0, 1, At, B1); PG8_BAR; PG8_SCHED;
            PG8_LDA(At, 0, 1); PG8_STAGE(PG8_SB(0, 0), b2, voffB); PG8_STAGE(PG8_SB(0, 1), b2 + hstep, voffB); PG8_STAGE(PG8_SA(0, 0), a2, voffA);
            PG8_WAIT_V(8); PG8_WAIT_L(0); PG8_BAR; PG8_MMA(1, 0, At, B0); PG8_MMA(1, 1, At, B1); PG8_BAR; PG8_SCHED;
            PG8_LDB(B0, 1, 0); PG8_LDB(B1, 1, 1); PG8_SCHED; PG8_LDA(At, 1, 0); PG8_STAGE(PG8_SA(0, 1), a2 + hstep, voffA);
            PG8_WAIT_V(8); PG8_WAIT_L(0); PG8_BAR; PG8_MMA(0, 0, At, B0); PG8_MMA(0, 1, At, B1); PG8_BAR; PG8_SCHED;
            PG8_LDA(At, 1, 1); PG8_STAGE(PG8_SB(1, 0), b3, voffB); PG8_STAGE(PG8_SB(1, 1), b3 + hstep, voffB); PG8_STAGE(PG8_SA(1, 0), a3, voffA);
            PG8_WAIT_V(8); PG8_WAIT_L(0); PG8_BAR; PG8_MMA(1, 0, At, B0); PG8_MMA(1, 1, At, B1); PG8_BAR; PG8_SCHED;
            } else {
            PG8_LDB(B0, 0, 0); PG8_SCHED; PG8_LDA(At, 0, 0); PG8_STAGE(PG8_SA(1, 1), a1 + hstep, voffA);
            PG8_WAIT_L(8); PG8_BAR; PG8_WAIT_L(0); PG8_MMA(0, 0, At, B0); PG8_BAR; PG8_SCHED;
            PG8_LDB(B1, 0, 1); PG8_STAGE(PG8_SB(0, 0), b2, voffB);
            PG8_BAR; PG8_WAIT_L(0); PG8_MMA(0, 1, At, B1); PG8_BAR;
            PG8_LDA(At, 0, 1); PG8_STAGE(PG8_SA(0, 0), a2, voffA);
            PG8_BAR; PG8_WAIT_L(0); PG8_MMA(1, 0, At, B0); PG8_BAR; PG8_SCHED;
            PG8_STAGE(PG8_SB(0, 1), b2 + hstep, voffB);
            PG8_WAIT_V(6); PG8_BAR; PG8_MMA(1, 1, At, B1); PG8_BAR;
            PG8_LDB(B0, 1, 0); PG8_SCHED; PG8_LDA(At, 1, 0); PG8_STAGE(PG8_SA(0, 1), a2 + hstep, voffA);
            PG8_WAIT_L(8); PG8_BAR; PG8_WAIT_L(0); PG8_MMA(0, 0, At, B0); PG8_BAR; PG8_SCHED;
            PG8_LDB(B1, 1, 1); PG8_STAGE(PG8_SB(1, 0), b3, voffB);
            PG8_BAR; PG8_WAIT_L(0); PG8_MMA(0, 1, At, B1); PG8_BAR;
            PG8_LDA(At, 1, 1); PG8_STAGE(PG8_SA(1, 0), a3, voffA);
            PG8_BAR; PG8_WAIT_L(0); PG8_MMA(1, 0, At, B0); PG8_BAR; PG8_SCHED;
            PG8_STAGE(PG8_SB(1, 1), b3 + hstep, voffB);
            PG8_WAIT_V(6); PG8_BAR; PG8_MMA(1, 1, At, B1); PG8_BAR;
            }
        }
        if constexpr (ALIGN_EPI) { if (wr == 0) PG8_BAR; }
        if constexpr (!Epi::AFTER_DRAIN) { E(acc, cur, wr, wc, fr, fq);
            S.done(cur); }
        if (!has_next) break;
#pragma unroll
        for (int a = 0; a < 2; ++a)
#pragma unroll
            for (int b = 0; b < 2; ++b)
#pragma unroll
                for (int m = 0; m < 4; ++m)
#pragma unroll
                    for (int n = 0; n < 2; ++n) acc[a][b][m][n] = (f32x4){0.f, 0.f, 0.f, 0.f};
        cur = nxt; cA = nA; cB = nB; ++ui;
        if constexpr (ALIGN_EPI) { if (wr == 1) PG8_BAR; }
    }
    PG8_WAIT_V(0);
    if constexpr (!ALIGN_EPI) { if (wr == 0) PG8_BAR; }
    PG8_BAR;
    if constexpr (Epi::AFTER_DRAIN) { E.fused(acc, cur, wr, wc, fr, fq, lds, wid, lane); S.done(cur); }
#undef PG8_SA
#undef PG8_SB
#undef PG8_STAGE
#undef PG8_LDA
#undef PG8_LDB
#undef PG8_MMA
#undef PG8_WAIT_V
#undef PG8_WAIT_L
#undef PG8_BAR
#undef PG8_SCHED
}
}
namespace att {
#define ATT_LAS __attribute__((address_space(3)))
using bf16x8 = __attribute__((ext_vector_type(8))) short;
using s16x4 = __attribute__((ext_vector_type(4))) short;
using f32x16 = __attribute__((ext_vector_type(16))) float;
using u32x4 = __attribute__((ext_vector_type(4))) unsigned;
typedef unsigned short bf16_t;
typedef ATT_LAS const char* lds_cptr;
typedef ATT_LAS char* lds_ptr;
typedef short v4i16_t __attribute__((ext_vector_type(4)));
typedef float f32x2_t __attribute__((ext_vector_type(2))); typedef __bf16 bf16x2_t __attribute__((ext_vector_type(2)));
constexpr int SEQ = 16384;
constexpr int PROWS = SEQ + SEQ / 16; constexpr size_t TSTRIDE = (size_t)PROWS * 64;
constexpr int T_QA = 0, T_KA = 4, T_VA = 8, T_GA = 12, T_QD = 16, T_KD = 28, T_VD = 40, T_GD = 52;
__device__ __forceinline__ int prow(int t) { return t + (t >> 4); }
constexpr int SLOTB = 8192, NSLOT = 6;
constexpr int LDS_K = 0, LDS_K2 = NSLOT * SLOTB, LDS_V = 2 * NSLOT * SLOTB, LDS_WS = 3 * NSLOT * SLOTB, LDS_FLAG = LDS_WS + 8 * 64 * 4, LDS_END = LDS_FLAG + 128;
constexpr int LDS_OST = LDS_K2;
#define ATT_BAR_L() asm volatile("s_waitcnt lgkmcnt(0)\n\ts_barrier" ::: "memory")
constexpr float SB_DEAD = 152.0f;
__device__ __forceinline__ int crow(int r, int hi) { return (r & 3) + 8 * (r >> 2) + 4 * hi; }
__device__ __forceinline__ unsigned cvtpk_s(float lo, float hi) { f32x2_t v = {lo, hi}; bf16x2_t b = __builtin_convertvector(v, bf16x2_t); return __builtin_bit_cast(unsigned, b); }
__device__ __forceinline__ float bf2f(unsigned short b) { return __uint_as_float((unsigned)b << 16); }
__device__ __forceinline__ void glds16(const void* gsrc, unsigned lds_dst) { unsigned keep;
    asm volatile("s_mov_b32 %0, m0\n\ts_mov_b32 m0, %2\n\ts_nop 0\n\tglobal_load_lds_dwordx4 %1, off\n\ts_mov_b32 m0, %0" : "=&s"(keep) : "v"(gsrc), "s"(lds_dst) : "memory"); }
__device__ __forceinline__ void glds16s(unsigned voff, const void* sbase, unsigned lds_dst) { unsigned keep;
    const unsigned long long a_ = (unsigned long long)sbase;
    const unsigned long long b_ = (unsigned long long)(unsigned)__builtin_amdgcn_readfirstlane((int)(unsigned)a_) | ((unsigned long long)(unsigned)__builtin_amdgcn_readfirstlane((int)(unsigned)(a_ >> 32)) << 32);
    asm volatile("s_nop 4\n\ts_mov_b32 %0, m0\n\ts_mov_b32 m0, %3\n\ts_nop 0\n\tglobal_load_lds_dwordx4 %1, %2\n\ts_mov_b32 m0, %0" : "=&s"(keep) : "v"(voff), "s"(b_), "s"(lds_dst) : "memory"); }
#define ATT_WAIT_BAR(N) asm volatile("s_waitcnt vmcnt(" #N ") lgkmcnt(0)\n\ts_barrier" ::: "memory")
__device__ __forceinline__ s16x4 vtr(lds_cptr p) { return __builtin_bit_cast(s16x4, __builtin_amdgcn_ds_read_tr16_b64_v4i16((ATT_LAS v4i16_t*)p)); }

__device__ __forceinline__ void qkt(f32x16& p0, f32x16& p1, lds_cptr ks, const int (&koff)[4], const bf16x8* qr, const f32x16& cinit) {
#pragma unroll
    for (int d0 = 0; d0 < 4; ++d0) {
        const bf16x8 b0 = *(const ATT_LAS bf16x8*)(ks + koff[d0]);
        const bf16x8 b1 = *(const ATT_LAS bf16x8*)(ks + koff[d0] + 4096);
        if (d0 == 0) { p0 = __builtin_amdgcn_mfma_f32_32x32x16_bf16(b0, qr[0], cinit, 0, 0, 0); p1 = __builtin_amdgcn_mfma_f32_32x32x16_bf16(b1, qr[0], cinit, 0, 0, 0); }
        else { p0 = __builtin_amdgcn_mfma_f32_32x32x16_bf16(b0, qr[d0], p0, 0, 0, 0); p1 = __builtin_amdgcn_mfma_f32_32x32x16_bf16(b1, qr[d0], p1, 0, 0, 0); }
    }
}
__device__ __forceinline__ void pv(f32x16* o, lds_cptr vp, bf16x8 pa0, bf16x8 pa1, bf16x8 pa2, bf16x8 pa3) {
#pragma unroll
    for (int d0 = 0; d0 < 2; ++d0) { s16x4 lo[4], hi[4];
#pragma unroll
        for (int ks = 0; ks < 4; ++ks) { lo[ks] = vtr(vp + d0 * 4096 + ks * 1024); hi[ks] = vtr(vp + d0 * 4096 + ks * 1024 + 512); }
#define ATT_PK(k) (bf16x8){lo[k][0], lo[k][1], lo[k][2], lo[k][3], hi[k][0], hi[k][1], hi[k][2], hi[k][3]}
        o[d0] = __builtin_amdgcn_mfma_f32_32x32x16_bf16(ATT_PK(0), pa0, o[d0], 0, 0, 0);
        o[d0] = __builtin_amdgcn_mfma_f32_32x32x16_bf16(ATT_PK(1), pa1, o[d0], 0, 0, 0);
        o[d0] = __builtin_amdgcn_mfma_f32_32x32x16_bf16(ATT_PK(2), pa2, o[d0], 0, 0, 0);
        o[d0] = __builtin_amdgcn_mfma_f32_32x32x16_bf16(ATT_PK(3), pa3, o[d0], 0, 0, 0);
#undef ATT_PK
    }
}
__device__ __forceinline__ void ot_rows(const f32x16* o, lds_ptr stg, int q, int hi, int lane, u32x4* sv) {
#pragma unroll
    for (int d0 = 0; d0 < 2; ++d0)
#pragma unroll
        for (int pr = 0; pr < 2; ++pr) { const int g = 2 * pr;
            const unsigned ax = cvtpk_s(o[d0][4 * g], o[d0][4 * g + 1]), ay = cvtpk_s(o[d0][4 * g + 2], o[d0][4 * g + 3]), bx = cvtpk_s(o[d0][4 * g + 4], o[d0][4 * g + 5]), by = cvtpk_s(o[d0][4 * g + 6], o[d0][4 * g + 7]);
            const auto rx = __builtin_amdgcn_permlane32_swap(ax, bx, false, false); const auto ry = __builtin_amdgcn_permlane32_swap(ay, by, false, false);
            *(ATT_LAS u32x4*)(stg + q * 128 + (((4 * d0 + 2 * pr + hi) ^ (q & 7)) << 4)) = (u32x4){rx[0], ry[0], rx[1], ry[1]}; }
    asm volatile("s_waitcnt lgkmcnt(0)" ::: "memory");
#pragma unroll
    for (int i = 0; i < 4; ++i) { const int rw = 8 * i + (lane >> 3); sv[i] = *(const ATT_LAS u32x4*)(stg + rw * 128 + (((lane & 7) ^ (rw & 7)) << 4)); }
}
__device__ __forceinline__ bf16x8 pack8(const float* a) { u32x4 w; w.x = cvtpk_s(a[0], a[1]); w.y = cvtpk_s(a[2], a[3]); w.z = cvtpk_s(a[4], a[5]); w.w = cvtpk_s(a[6], a[7]); return __builtin_bit_cast(bf16x8, w); }

template <bool MASK> __device__ __forceinline__ void sb_tile(const f32x16& p0, const f32x16& p1, float& Rsum, int qrel, int hi, bf16x8& pa0, bf16x8& pa1, bf16x8& pa2, bf16x8& pa3) {
    float run = Rsum; unsigned pw[16];
#pragma unroll
    for (int g = 7; g >= 0; --g) {
        float z[4], sp[4];
#pragma unroll
        for (int e = 0; e < 4; ++e) { const int idx = 4 * g + e; z[e] = (idx < 16) ? p0[idx] : p1[idx - 16];
            sp[e] = __builtin_fmaxf(z[e], 0.f) + __builtin_amdgcn_logf(1.0f + __builtin_amdgcn_exp2f(-__builtin_fabsf(z[e])));
            if (MASK) { if (8 * g + 4 * hi + e >= qrel) sp[e] = 0.f; } }
        const float e2 = sp[3], e1 = sp[3] + sp[2], e0 = e1 + sp[1], T = e0 + sp[0];
        const auto rr = __builtin_amdgcn_permlane32_swap(__float_as_uint(T), __float_as_uint(T), false, false);
        const float tev = __uint_as_float(rr[0]), tod = __uint_as_float(rr[1]);
        const float off = run + (hi ? 0.f : tod);
        run += tev + tod;
        float a[4];
        a[0] = __builtin_amdgcn_exp2f((z[0] - sp[0]) - (off + e0)); a[1] = __builtin_amdgcn_exp2f((z[1] - sp[1]) - (off + e1));
        a[2] = __builtin_amdgcn_exp2f((z[2] - sp[2]) - (off + e2)); a[3] = __builtin_amdgcn_exp2f((z[3] - sp[3]) - off);
        if (MASK) {
#pragma unroll
            for (int e = 0; e < 4; ++e) if (8 * g + 4 * hi + e >= qrel) a[e] = 0.f; }
        pw[2 * g] = cvtpk_s(a[0], a[1]); pw[2 * g + 1] = cvtpk_s(a[2], a[3]);
    }
    Rsum = run;
    pa0 = __builtin_bit_cast(bf16x8, (u32x4){pw[0], pw[1], pw[2], pw[3]}); pa1 = __builtin_bit_cast(bf16x8, (u32x4){pw[4], pw[5], pw[6], pw[7]});
    pa2 = __builtin_bit_cast(bf16x8, (u32x4){pw[8], pw[9], pw[10], pw[11]}); pa3 = __builtin_bit_cast(bf16x8, (u32x4){pw[12], pw[13], pw[14], pw[15]});
}

struct SbArgs { const bf16_t* proj; bf16_t* mix; };
template <bool EARLY> __device__ __forceinline__ void sb_unit(int h, int qb, const SbArgs& A, lds_ptr shm, int wave) {
    int wid = wave; asm volatile("" : "+s"(wid)); const int tid = lx_tid(wid);
    const int lane = tid & 63, r32 = lane & 31, hi = lane >> 5;
    const int q0 = qb * 256;
    const bf16_t* Qh = A.proj + (size_t)(T_QA + h) * TSTRIDE; const bf16_t* Kh = A.proj + (size_t)(T_KA + h) * TSTRIDE; const bf16_t* Vh = A.proj + (size_t)(T_VA + h) * TSTRIDE;
    const unsigned lds0 = (unsigned)(size_t)shm;
    volatile ATT_LAS unsigned* flags = (volatile ATT_LAS unsigned*)(shm + LDS_FLAG);
    const unsigned kdst = lds0 + LDS_K + wid * 1024, vdst = lds0 + LDS_V + wid * 1024;
    const lds_cptr ks0 = (lds_cptr)shm + LDS_K; int koff[4];
#pragma unroll
    for (int d0 = 0; d0 < 4; ++d0) koff[d0] = r32 * 128 + (((2 * d0 + hi) ^ ((r32 >> 1) & 7)) << 4);
    const lds_cptr vp0 = (lds_cptr)shm + LDS_V + ((lane >> 4) & 1) * 32 + (lane & 3) * 8 + (4 * hi + ((lane & 15) >> 2)) * 64;
#define SB_DMA(jt, slot) do { const int jt_ = (jt) < 0 ? 0 : (jt); const int l_ = lx_lane(); const int kkey_ = 8 * wid + (l_ >> 3), vkey_ = 16 * (wid & 3) + (l_ >> 2); \
        const unsigned voffK_ = (unsigned)((prow(kkey_) * 64 + ((l_ & 7) ^ ((kkey_ >> 1) & 7)) * 8) * 2), voffV_ = (unsigned)((prow(vkey_) * 64 + (wid >> 2) * 32 + (l_ & 3) * 8) * 2); \
        glds16s(voffK_, (const char*)Kh + (size_t)jt_ * (68 * 128), (unsigned)__builtin_amdgcn_readfirstlane(kdst + (slot))); \
        glds16s(voffV_, (const char*)Vh + (size_t)jt_ * (68 * 128), (unsigned)__builtin_amdgcn_readfirstlane(vdst + (slot))); } while (0)
    const int jtop = 4 * qb + 3, jd = 4 * qb + (wid >> 1), qrel = 32 * (wid & 1) + r32;
    if (lane == 0) { flags[wid] = 0u; flags[8 + wid] = 0u; }
    bf16x8 qr[4];
    { const bf16_t* Qp = Qh + (size_t)prow(q0 + wid * 32 + r32) * 64;
#pragma unroll
      for (int d0 = 0; d0 < 4; ++d0) qr[d0] = *(const bf16x8*)(Qp + d0 * 16 + hi * 8); }
    const lds_ptr qst = shm + LDS_OST + wid * 4096 + lane * 16;
#pragma unroll
    for (int d0 = 0; d0 < 4; ++d0) *(ATT_LAS bf16x8*)(qst + d0 * 1024) = qr[d0];
    asm volatile("" ::: "memory");
#pragma unroll
    for (int i = 0; i < 6; ++i) SB_DMA(jtop - i, ((jtop - i + 6000) % 6) * SLOTB);
    f32x16 o[2]; o[0] = f32x16{}; o[1] = f32x16{}; const f32x16 zero = f32x16{};
    float Rsum = 0.f; bool dead = false;
    for (int s = 0;; ++s) {
        const int jt = jd - s;
        if (s == 0) ATT_WAIT_BAR(4); else ATT_WAIT_BAR(2);
        if (s > 0) { const int fb = ((s - 1) & 1) * 8; unsigned all = 1u;
#pragma unroll
            for (int w = 0; w < 8; ++w) all &= flags[fb + w];
            if (all) break; }
        if (s > 0) SB_DMA(jtop - s - 5, ((jtop - s + 1 + 6000) % 6) * SLOTB);
        if (jt >= 0 && !dead) {
            const int slot = ((jt + 6000) % 6) * SLOTB;
            f32x16 p0, p1; bf16x8 pa0, pa1, pa2, pa3;
            { bf16x8 qf[4];
#pragma unroll
              for (int d0 = 0; d0 < 4; ++d0) qf[d0] = *(const ATT_LAS bf16x8*)(qst + d0 * 1024);
              qkt(p0, p1, ks0 + slot, koff, qf, zero); }
            __builtin_amdgcn_sched_barrier(0);
            if (s == 0) sb_tile<true>(p0, p1, Rsum, qrel, hi, pa0, pa1, pa2, pa3); else sb_tile<false>(p0, p1, Rsum, qrel, hi, pa0, pa1, pa2, pa3);
            __builtin_amdgcn_sched_barrier(0);
            pv(o, vp0 + slot, pa0, pa1, pa2, pa3);
            if (EARLY) dead = __all(Rsum > SB_DEAD);
        }
        const bool fin = dead || (jt <= 0);
        if (lane == 0) flags[(s & 1) * 8 + wid] = fin ? 1u : 0u;
    }
#undef SB_DMA
    asm volatile("s_waitcnt vmcnt(0)" ::: "memory");
    { const int l2 = lx_lane();
      u32x4 sv[4]; ot_rows(o, shm + LDS_OST + wid * 4096, l2 & 31, l2 >> 5, l2, sv);
      const bf16_t* Gh = A.proj + (size_t)(T_GA + h) * TSTRIDE; bf16_t* Mw = A.mix + (size_t)(q0 + wid * 32) * 1024 + h * 64;
#pragma unroll
      for (int i = 0; i < 4; ++i) { const int row = i * 8 + (l2 >> 3), chn = l2 & 7; const u32x4 gv = *(const u32x4*)(Gh + (size_t)prow(q0 + wid * 32 + row) * 64 + chn * 8);
          u32x4 w;
#pragma unroll
          for (int k = 0; k < 4; ++k) { const float lo = __uint_as_float(sv[i][k] << 16) * __uint_as_float(gv[k] << 16), hi2 = __uint_as_float(sv[i][k] & 0xffff0000u) * __uint_as_float(gv[k] & 0xffff0000u); w[k] = cvtpk_s(lo, hi2); }
          *(u32x4*)(Mw + (size_t)row * 1024 + chn * 8) = w; } }
    ATT_BAR_L();
}

struct DilArgs { const bf16_t* proj; bf16_t* o1; bf16_t* mix; float* lp; unsigned* gcnt; const float* qg; const float* kg; };
template <int DUMMY = 0> __device__ __forceinline__ void dil_phase(int v, int G, const DilArgs& A, lds_ptr shm, int wave) {
    int wid = wave; asm volatile("" : "+s"(wid)); const int tid = lx_tid(wid);
    const int lane = tid & 63, r32 = lane & 31, hi = lane >> 5;
    const unsigned lds0 = (unsigned)(size_t)shm;
    ATT_LAS float* wsf = (ATT_LAS float*)(shm + LDS_WS) + wid * 64;
    const unsigned kdst0 = lds0 + LDS_K + wid * 1024, vdst = lds0 + LDS_V + wid * 1024;
    const lds_cptr ks00 = (lds_cptr)shm + LDS_K; int koff[4];
#pragma unroll
    for (int d0 = 0; d0 < 4; ++d0) koff[d0] = r32 * 128 + (((2 * d0 + hi) ^ ((r32 >> 1) & 7)) << 4);
    const lds_cptr vp0 = (lds_cptr)shm + LDS_V + ((lane >> 4) & 1) * 32 + (lane & 3) * 8 + (4 * hi + ((lane & 15) >> 2)) * 64;
    const int kkey = 8 * wid + (lane >> 3), kch = ((lane & 7) ^ ((kkey >> 1) & 7)) * 8, vkey = 16 * (wid & 3) + (lane >> 2), vch = (wid >> 2) * 32 + (lane & 3) * 8;
    float gq = __builtin_fabsf(A.qg[lane]), gk = __builtin_fabsf(A.kg[lane]);
    gq = lx_wave_max(gq); gk = lx_wave_max(gk);
    const float Mb = 64.0f * 0.125f * 1.4426950408889634f * 1.02f * gq * gk;
    f32x16 negm;
#pragma unroll
    for (int r = 0; r < 16; ++r) negm[r] = -Mb;
    const __amdgpu_buffer_rsrc_t o1_rsrc = __builtin_amdgcn_make_buffer_rsrc((void*)A.o1, 0, SEQ * 768 * 2, 0x00020000);
    const __amdgpu_buffer_rsrc_t mix_rsrc = __builtin_amdgcn_make_buffer_rsrc((void*)A.mix, 0, SEQ * 1024 * 2, 0x00020000);
#define DIL_DECODE(k, H, P, C, BLK) const int q_##H = 3 * (v >> 5) + (k) / 3, H = q_##H >> 1, P = (k) % 3, C = (v & 31) >> (5 - 2 * P), BLK = (q_##H & 1) * (32 >> (2 * P)) + ((v & 31) & ((32 >> (2 * P)) - 1))
#define DIL_ISSUE_K(H, P, C, BLK, KB) do { const int rsh_ = 2 * P; const unsigned kdst = kdst0 + (KB) * (LDS_K2 - LDS_K); const unsigned vo_ = (unsigned)((prow(C + (kkey << rsh_)) * 64 + kch) * 2); \
        const char* kb_ = (const char*)(A.proj + (size_t)(T_KD + H) * TSTRIDE) + (long)((BLK * 256 - 128) << rsh_) * 136; \
        _Pragma("unroll") for (int j = 0; j < 6; ++j) glds16s(vo_, kb_ + (long)((64 * j) << rsh_) * 136, (unsigned)__builtin_amdgcn_readfirstlane(kdst + j * SLOTB)); } while (0)
#define DIL_ISSUE_V(H, P, C, BLK) do { const int rsh_ = 2 * P; const unsigned vo_ = (unsigned)((prow(C + (vkey << rsh_)) * 64 + vch) * 2); \
        const char* vb_ = (const char*)(A.proj + (size_t)(T_VD + H) * TSTRIDE) + (long)((BLK * 256 - 128) << rsh_) * 136; \
        _Pragma("unroll") for (int j = 0; j < 6; ++j) glds16s(vo_, vb_ + (long)((64 * j) << rsh_) * 136, (unsigned)__builtin_amdgcn_readfirstlane(vdst + j * SLOTB)); } while (0)
#define DIL_LOADQ(QR, H, P, C, BLK) do { const bf16_t* Qp_ = A.proj + (size_t)(T_QD + H) * TSTRIDE + (size_t)prow(C + ((BLK * 256 + wid * 32 + r32) << (2 * P))) * 64; \
        _Pragma("unroll") for (int d0 = 0; d0 < 4; ++d0) QR[d0] = *(const bf16x8*)(Qp_ + d0 * 16 + hi * 8); } while (0)
    if (G != 256) return;
    bf16x8 qr[4];
    { DIL_DECODE(0, h0, p0_, c0, b0); DIL_ISSUE_K(h0, p0_, c0, b0, 0); DIL_LOADQ(qr, h0, p0_, c0, b0); DIL_ISSUE_V(h0, p0_, c0, b0); }
    for (int k = 0; k < 9; ++k) {
        DIL_DECODE(k, h, p, c, blk);
        const int rsh = 2 * p, u0 = blk * 256;
        if (k == 0) asm volatile("s_waitcnt vmcnt(6) lgkmcnt(0)\n\ts_barrier" ::: "memory"); else asm volatile("s_waitcnt vmcnt(11) lgkmcnt(0)\n\ts_barrier" ::: "memory");
        const int kb = k & 1; const lds_cptr ks0 = ks00 + kb * (LDS_K2 - LDS_K);
        if (k + 1 < 9) { DIL_DECODE(k + 1, hn, pn, cn, bn); DIL_ISSUE_K(hn, pn, cn, bn, kb ^ 1); }
        unsigned pw[5][8]; float l_reg = 0.f;
#pragma unroll
        for (int hh = 0; hh < 5; ++hh) {
            const int ht = wid + hh;
#pragma unroll
            for (int e = 0; e < 8; ++e) pw[hh][e] = 0u;
            if (blk == 0 && ht < 4) continue;
            const lds_cptr ks = ks0 + (ht >> 1) * SLOTB + (ht & 1) * 4096;
            f32x16 s;
#pragma unroll
            for (int d0 = 0; d0 < 4; ++d0) { const bf16x8 b = *(const ATT_LAS bf16x8*)(ks + koff[d0]); s = __builtin_amdgcn_mfma_f32_32x32x16_bf16(b, qr[d0], d0 == 0 ? negm : s, 0, 0, 0); }
#pragma unroll
            for (int g = 0; g < 4; ++g) { float a[4];
#pragma unroll
                for (int e = 0; e < 4; ++e) { float vv = __builtin_amdgcn_exp2f(s[4 * g + e]);
                    const int dd = 8 * g + 4 * hi + e - r32;
                    if (hh == 0) { if (dd < 0) vv = 0.f; } else if (hh == 4) { if (dd > 0) vv = 0.f; }
                    a[e] = vv; l_reg += vv; }
                pw[hh][2 * g] = cvtpk_s(a[0], a[1]); pw[hh][2 * g + 1] = cvtpk_s(a[2], a[3]); }
        }
        l_reg = lx_sum32(l_reg);
        unsigned* const gc = A.gcnt + (3 * (v >> 5) + k / 3) * 64;
        if (p == 2 && wid == 0) {
            unsigned spins = 0u;
            while (__hip_atomic_load(gc, __ATOMIC_RELAXED, __HIP_MEMORY_SCOPE_AGENT) < 32u) { __builtin_amdgcn_s_sleep(2); if (++spins > (1u << 22)) break; }
            __builtin_amdgcn_fence(__ATOMIC_ACQUIRE, "agent"); asm volatile("s_waitcnt vmcnt(0)" ::: "memory"); }
        if (k == 8) asm volatile("s_waitcnt vmcnt(0) lgkmcnt(0)\n\ts_barrier" ::: "memory");
        else if (k % 3 == 1) asm volatile("s_waitcnt vmcnt(11) lgkmcnt(0)\n\ts_barrier" ::: "memory"); else asm volatile("s_waitcnt vmcnt(6) lgkmcnt(0)\n\ts_barrier" ::: "memory");
        u32x4 a0[4], a1[4], gvv[4]; float lsum = 0.f;
        if (p == 2) { const bf16_t* Gh = A.proj + (size_t)(T_GD + h) * TSTRIDE;
#pragma unroll
            for (int i = 0; i < 4; ++i) { const int t = c + ((u0 + wid * 32 + i * 8 + (lane >> 3)) << rsh);
                a0[i] = *(const u32x4*)(A.o1 + (size_t)t * 768 + h * 64 + (lane & 7) * 8); a1[i] = *(const u32x4*)(A.mix + (size_t)t * 1024 + 256 + h * 64 + (lane & 7) * 8);
                gvv[i] = *(const u32x4*)(Gh + (size_t)prow(t) * 64 + (lane & 7) * 8); }
            const int tq0 = c + ((u0 + wid * 32 + r32) << rsh); lsum = A.lp[((size_t)0 * SEQ + tq0) * 12 + h] + A.lp[((size_t)1 * SEQ + tq0) * 12 + h]; }
        if (k + 1 < 9) { DIL_DECODE(k + 1, hn, pn, cn, bn); DIL_LOADQ(qr, hn, pn, cn, bn); }
        f32x16 o[2];
        o[0] = f32x16{}; o[1] = f32x16{};
#pragma unroll
        for (int hh = 0; hh < 5; ++hh) {
            const int ht = wid + hh;
            if (blk == 0 && ht < 4) continue;
            const lds_cptr vp = vp0 + (ht >> 1) * SLOTB + (ht & 1) * 2048;
            const bf16x8 pa0 = __builtin_bit_cast(bf16x8, (u32x4){pw[hh][0], pw[hh][1], pw[hh][2], pw[hh][3]}), pa1 = __builtin_bit_cast(bf16x8, (u32x4){pw[hh][4], pw[hh][5], pw[hh][6], pw[hh][7]});
#pragma unroll
            for (int d0 = 0; d0 < 2; ++d0) { const s16x4 l0 = vtr(vp + d0 * 4096), h0_ = vtr(vp + d0 * 4096 + 512), l1 = vtr(vp + d0 * 4096 + 1024), h1_ = vtr(vp + d0 * 4096 + 1536);
                o[d0] = __builtin_amdgcn_mfma_f32_32x32x16_bf16((bf16x8){l0[0], l0[1], l0[2], l0[3], h0_[0], h0_[1], h0_[2], h0_[3]}, pa0, o[d0], 0, 0, 0);
                o[d0] = __builtin_amdgcn_mfma_f32_32x32x16_bf16((bf16x8){l1[0], l1[1], l1[2], l1[3], h1_[0], h1_[1], h1_[2], h1_[3]}, pa1, o[d0], 0, 0, 0); }
        }
        ATT_BAR_L();
        if (p == 0 && k + 1 < 9) { DIL_DECODE(k + 1, hn, pn, cn, bn); DIL_ISSUE_V(hn, pn, cn, bn); }
        { const int tq = c + ((u0 + wid * 32 + r32) << rsh);
          if (p == 2 && hi == 0) wsf[r32] = __builtin_amdgcn_rcpf(lsum + l_reg);
          u32x4 sv[4]; ot_rows(o, shm + LDS_K + kb * (LDS_K2 - LDS_K) + wid * 4096, r32, hi, lane, sv);
          asm volatile("" ::: "memory");
          if (p != 2) {
#pragma unroll
              for (int i = 0; i < 4; ++i) { const int t = c + ((u0 + wid * 32 + i * 8 + (lane >> 3)) << rsh);
                  if (p == 0) __builtin_amdgcn_raw_buffer_store_b128(sv[i], o1_rsrc, (unsigned)((t * 768 + h * 64 + (lane & 7) * 8) * 2), 0, 16);
                  else __builtin_amdgcn_raw_buffer_store_b128(sv[i], mix_rsrc, (unsigned)((t * 1024 + 256 + h * 64 + (lane & 7) * 8) * 2), 0, 16); }
              if (hi == 0) __hip_atomic_store((unsigned*)(A.lp + ((size_t)p * SEQ + tq) * 12 + h), __float_as_uint(l_reg), __ATOMIC_RELAXED, __HIP_MEMORY_SCOPE_AGENT);
              asm volatile("" ::: "memory");
              if (p == 1) {
                  asm volatile("s_waitcnt vmcnt(0) lgkmcnt(0)\n\ts_barrier" ::: "memory");
                  if (tid == 0) __hip_atomic_fetch_add(gc, 1u, __ATOMIC_RELAXED, __HIP_MEMORY_SCOPE_AGENT);
                  if (k + 1 < 9) { DIL_DECODE(k + 1, hn, pn, cn, bn); DIL_ISSUE_V(hn, pn, cn, bn); }
              }
          } else {
              float inv[4];
#pragma unroll
              for (int i = 0; i < 4; ++i) inv[i] = wsf[i * 8 + (lane >> 3)];
#pragma unroll
              for (int i = 0; i < 4; ++i) { u32x4 w;
#pragma unroll
                  for (int e = 0; e < 4; ++e) {
                      const float lo = (__uint_as_float(a0[i][e] << 16) + __uint_as_float(a1[i][e] << 16) + __uint_as_float(sv[i][e] << 16)) * inv[i] * __uint_as_float(gvv[i][e] << 16);
                      const float hi2 = (__uint_as_float(a0[i][e] & 0xffff0000u) + __uint_as_float(a1[i][e] & 0xffff0000u) + __uint_as_float(sv[i][e] & 0xffff0000u)) * inv[i] * __uint_as_float(gvv[i][e] & 0xffff0000u);
                      w[e] = cvtpk_s(lo, hi2); }
                  sv[i] = w; }
              asm volatile("" ::: "memory");
#pragma unroll
              for (int i = 0; i < 4; ++i) { const int t = c + ((u0 + wid * 32 + i * 8 + (lane >> 3)) << rsh); *(u32x4*)(A.mix + (size_t)t * 1024 + 256 + h * 64 + (lane & 7) * 8) = sv[i]; }
              if (hi == 0) A.lp[((size_t)2 * SEQ + tq) * 12 + h] = l_reg;
              asm volatile("" ::: "memory");
              if (k + 1 < 9) { DIL_DECODE(k + 1, hn, pn, cn, bn); DIL_ISSUE_V(hn, pn, cn, bn); }
          } }
    }
#undef DIL_DECODE
#undef DIL_ISSUE_K
#undef DIL_ISSUE_V
#undef DIL_LOADQ
    ATT_BAR_L();
}
#undef ATT_WAIT_BAR
#undef ATT_BAR_L
}
constexpr int NWAVES = 8;
constexpr int N_LAUNCHES = MK_N_LAUNCHES;
constexpr int DEPTH = 4, SEQ = 16384, DM = 1024, NIN = 4096;
constexpr int N_PHASES = 1 + 3 * DEPTH;
constexpr size_t MiB = 1u << 20;
constexpr size_t WS_CTL = 0, CTL_ZERO_BYTES = 128 * 1024;
constexpr size_t WS_ROPE = 1 * MiB;
constexpr size_t WS_SSQ = 2 * MiB;
constexpr size_t WS_LP = 3 * MiB;
constexpr size_t WS_W = 6 * MiB, W_STRIDE = 10 * MiB, W_OUT_OFF = 8 * MiB;
constexpr size_t WS_XB = 46 * MiB;
constexpr size_t WS_MIX = 78 * MiB;
constexpr size_t WS_PROJ = 110 * MiB;
constexpr size_t WS_END = 246 * MiB;
constexpr int CW_BAR = 4096;
static_assert((16384 + 4 * 8 * 3 * 64) * 4 <= 128 * 1024, "control words inside the memset region");
constexpr int CW_GRP = 16384;
constexpr int RING_OFF = 0, RING_BYTES = 131072;
constexpr int LDSCTL_OFF = 151552, MISC_OFF = LDSCTL_OFF + 320;
constexpr int LDS_BYTES = 153600;
static_assert(att::LDS_END <= LDSCTL_OFF && RING_BYTES <= LDSCTL_OFF, "phase scratch below the control words");

#define GAS __attribute__((address_space(1)))
#define LAS __attribute__((address_space(3)))
typedef unsigned short bf16;
typedef unsigned v4u __attribute__((ext_vector_type(4)));
typedef float f32x4 __attribute__((ext_vector_type(4)));
typedef GAS unsigned gu32;
#define RLX_AGENT __ATOMIC_RELAXED, __HIP_MEMORY_SCOPE_AGENT
#define LDS_WAIT() asm volatile("s_waitcnt lgkmcnt(0)" ::: "memory")
#define VM_WAIT() asm volatile("s_waitcnt vmcnt(0)" ::: "memory")
__device__ __forceinline__ unsigned f2bf(float f) { unsigned u = __builtin_bit_cast(unsigned, f); return (u + 0x7fffu + ((u >> 16) & 1u)) >> 16; }
__device__ __forceinline__ unsigned pk2(float lo, float hi) { return f2bf(lo) | (f2bf(hi) << 16); }
#define XB_TMO      128
#define XB_XCNT(j)  (256  + 64 * (j))
#define XB_XSUB(j)  (1280 + 64 * (j))
#define XB_XGEN(j)  (2304 + 64 * (j))
#define XB_TOP      3328
#define XB_TOPGEN   3392
#define XCD_BAR_WORDS 3456
#define XB_SPIN_CAP (1u << 18)

__device__ __forceinline__ unsigned xb_ld(unsigned* p)              { return __hip_atomic_load(p, __ATOMIC_RELAXED, __HIP_MEMORY_SCOPE_AGENT); }
__device__ __forceinline__ unsigned xb_add(unsigned* p, unsigned v) { return __hip_atomic_fetch_add(p, v, __ATOMIC_RELAXED, __HIP_MEMORY_SCOPE_AGENT); }
__device__ __forceinline__ unsigned xb_xcc_id() { return (unsigned)__builtin_amdgcn_s_getreg((3 << 11) | 20) & 0xFu; }
#define XB_SPIN(cond, bar) do { unsigned _sp = 0; while (cond) { __builtin_amdgcn_s_sleep(1); \
    if ((++_sp & 255u) == 0u) { if (xb_ld(&(bar)[XB_TMO])) break; if (_sp > XB_SPIN_CAP) { atomicAdd(&(bar)[XB_TMO], 1u); break; } } } } while (0)

struct XcdBarrier {
    unsigned* bar; unsigned x;
    volatile LAS unsigned* st;
};

__device__ __forceinline__ XcdBarrier xcd_barrier_post(unsigned* bar, volatile LAS unsigned* st, bool leader) {
    XcdBarrier b; b.bar = bar; b.x = xb_xcc_id(); b.st = st;
    if (leader) (void)xb_add(&bar[XB_XCNT(b.x)], 1u);
    return b;
}
__device__ __forceinline__ void xcd_barrier_complete(unsigned* bar, unsigned x, unsigned& nloc, unsigned& nx) {
    const unsigned G = gridDim.x * gridDim.y * gridDim.z;
    unsigned sum, cnt, mine, sp = 0u;
    for (;;) {
        sum = 0u; cnt = 0u; mine = 0u;
#pragma unroll
        for (unsigned j = 0; j < 16; ++j) { const unsigned c = xb_ld(&bar[XB_XCNT(j)]); sum += c; cnt += (c > 0u) ? 1u : 0u; mine = (j == x) ? c : mine; }
        if (sum == G) break;
        __builtin_amdgcn_s_sleep(1);
        if ((++sp & 255u) == 0u) { if (xb_ld(&bar[XB_TMO])) break; if (sp > XB_SPIN_CAP) { atomicAdd(&bar[XB_TMO], 1u); break; } }
    }
    nloc = mine > 0u ? mine : 1u; nx = cnt > 0u ? cnt : 1u;
}

__device__ __forceinline__ void xcd_barrier(const XcdBarrier& b, bool leader) {
    asm volatile("s_waitcnt vmcnt(0)" ::: "memory");
    __syncthreads();
    if (leader) {
        unsigned* bar = b.bar;
        __builtin_amdgcn_s_waitcnt(0);
        unsigned nloc = b.st[0], nx = b.st[1];
        if (nloc == 0u) { xcd_barrier_complete(bar, b.x, nloc, nx); b.st[0] = nloc; b.st[1] = nx; }
        const unsigned old = xb_add(&bar[XB_XSUB(b.x)], 1u);
        const unsigned gen = old / nloc;
        if (old + 1u == (gen + 1u) * nloc) {
            __builtin_amdgcn_fence(__ATOMIC_RELEASE, "agent");
            asm volatile("s_waitcnt vmcnt(0)" ::: "memory");
            const unsigned og = xb_add(&bar[XB_TOP], 1u);
            const unsigned tg = og / nx;
            if (og + 1u == (tg + 1u) * nx) xb_add(&bar[XB_TOPGEN], 1u);
            else XB_SPIN(xb_ld(&bar[XB_TOPGEN]) == tg, bar);
            __builtin_amdgcn_fence(__ATOMIC_ACQUIRE, "agent");
            xb_add(&bar[XB_XGEN(b.x)], 1u);
            asm volatile("s_waitcnt vmcnt(0)" ::: "memory");
        } else {
            XB_SPIN(xb_ld(&bar[XB_XGEN(b.x)]) == gen, bar);
            __builtin_amdgcn_fence(__ATOMIC_ACQUIRE, "agent");
            asm volatile("s_waitcnt vmcnt(0)" ::: "memory");
        }
    }
    __syncthreads();
}
__device__ __forceinline__ float wave_sum(float v) {
    return lx_wave_sum(v);
}
template <bool PERMN> __device__ __forceinline__ void transpose_item(const float* W, int K, int N, bf16* WT, const float* gk, LAS float* scr, int item, int lane) {
    const int nblk = N / 32, kb = item / nblk, nb = item % nblk, k0 = 64 * kb, n0 = 32 * nb;
    float wv[32];
#pragma unroll
    for (int i = 0; i < 32; ++i) wv[i] = W[(size_t)(k0 + 2 * i + (lane >> 5)) * N + n0 + (lane & 31)];
    if (gk) {
#pragma unroll
        for (int i = 0; i < 32; ++i) wv[i] *= gk[k0 + 2 * i + (lane >> 5)]; }
#pragma unroll
    for (int i = 0; i < 32; ++i) scr[(2 * i + (lane >> 5)) * 33 + (lane & 31)] = wv[i];
    LDS_WAIT(); asm volatile("" ::: "memory");
    const int c = lane & 7;
#pragma unroll
    for (int j = 0; j < 4; ++j) { const int n = (lane >> 3) + 8 * j; const LAS float* s = scr + (8 * c) * 33 + n;
        v4u o; o.x = pk2(s[0 * 33], s[1 * 33]); o.y = pk2(s[2 * 33], s[3 * 33]); o.z = pk2(s[4 * 33], s[5 * 33]); o.w = pk2(s[6 * 33], s[7 * 33]);
        const int col = n0 + n; const int pos = PERMN ? ((col & ~255) + 128 * ((col >> 5) & 1) + 32 * ((col >> 6) & 3) + (col & 31)) : col;
        *(GAS v4u*)(WT + (size_t)pos * K + k0 + 8 * c) = o; }
    LDS_WAIT(); asm volatile("" ::: "memory");
}
struct KArgs { const float* x; const float* norm_g; const float* w_in; const float* q_norm_g; const float* k_norm_g; const float* w_out; float* out; unsigned char* ws; int ph_lo, ph_hi; };

__device__ __forceinline__ void convert_weights(const KArgs& a, int l, LAS unsigned char* lds, int vcu, int G, int wave0) {
    const int wave = wave0; const int tid = lx_tid(wave); const int lane = tid & 63; const int gw = vcu * NWAVES + wave, NGW = G * NWAVES;
    LAS float* scr = (LAS float*)(lds + RING_OFF + wave * 16384);
    bf16* WinT = (bf16*)(a.ws + WS_W + (size_t)l * W_STRIDE); bf16* WoutT = (bf16*)(a.ws + WS_W + (size_t)l * W_STRIDE + W_OUT_OFF);
    constexpr int I_IN = (DM / 64) * (NIN / 32), I_OUT = (DM / 64) * (DM / 32);
    for (int it = gw; it < I_IN + I_OUT; it += NGW) {
        if (it < I_IN) transpose_item<true>(a.w_in + (size_t)l * DM * NIN, DM, NIN, WinT, a.norm_g + l * DM, scr, it, lane);
        else transpose_item<false>(a.w_out + (size_t)l * DM * DM, DM, DM, WoutT, nullptr, scr, it - I_IN, lane);
    }
}
__device__ __forceinline__ void sincos_acc(float angf, float& c, float& s) {
    const double ang = (double)angf; const double kq = __builtin_rint(ang * 0.63661977236758134308);
    const double r = __builtin_fma(-kq, 1.5707963267948966192, ang) - kq * 6.123233995736766036e-17; const double r2 = r * r;
    double sp = -1.0 / 1307674368000.0; sp = sp * r2 + 1.0 / 6227020800.0; sp = sp * r2 - 1.0 / 39916800.0; sp = sp * r2 + 1.0 / 362880.0; sp = sp * r2 - 1.0 / 5040.0; sp = sp * r2 + 1.0 / 120.0; sp = sp * r2 - 1.0 / 6.0; sp = sp * r2 * r + r;
    double cp = 1.0 / 87178291200.0; cp = cp * r2 - 1.0 / 479001600.0; cp = cp * r2 + 1.0 / 3628800.0; cp = cp * r2 - 1.0 / 40320.0; cp = cp * r2 + 1.0 / 720.0; cp = cp * r2 - 1.0 / 24.0; cp = cp * r2 + 0.5; cp = 1.0 - cp * r2;
    const int q = ((int)kq) & 3;
    const double sv = (q == 0) ? sp : (q == 1) ? cp : (q == 2) ? -sp : -cp, cv = (q == 0) ? cp : (q == 1) ? -sp : (q == 2) ? -cp : sp;
    c = (float)cv; s = (float)sv;
}
__device__ __forceinline__ float inv_freq(int i) {
    return i == 0 ? 1.0f : i == 1 ? 0.193922758102417f : i == 2 ? 0.03760603070259094f : i == 3 ? 0.00729266507551074f : i == 4 ? 0.001414213445968926f : i == 5 ? 0.00027424818836152554f : i == 6 ? 5.318296462064609e-05f : 1.0313385246263351e-05f;
}

__global__ void __launch_bounds__(NWAVES * 64, 2) hsdg_fwd(KArgs args) {
    extern __shared__ __attribute__((aligned(16))) unsigned char lds_raw[];
    LAS unsigned char* lds = (LAS unsigned char*)lds_raw;
    volatile LAS unsigned* MISC = (volatile LAS unsigned*)(lds + MISC_OFF);
    const int wave0 = __builtin_amdgcn_readfirstlane((int)threadIdx.x >> 6); const int tid0 = lx_tid(wave0);
    const int G = gridDim.x; const int bx = blockIdx.x; const int vcu = (G % 8 == 0) ? (bx % 8) * (G / 8) + bx / 8 : bx;
    unsigned char* ws = args.ws;
    gu32* ctl = (gu32*)(ws + WS_CTL);
    for (int u = tid0; u < (LDS_BYTES - LDSCTL_OFF) / 4; u += NWAVES * 64) ((LAS unsigned*)(lds + LDSCTL_OFF))[u] = 0u;
    __syncthreads();
    XcdBarrier bar; bar.bar = (unsigned*)(ctl + CW_BAR); bar.x = 0; bar.st = nullptr;
    if (N_LAUNCHES == 1) bar = xcd_barrier_post((unsigned*)(ctl + CW_BAR), MISC + 8, tid0 == 0);
#define GRID_BAR() do { if (N_LAUNCHES == 1) xcd_barrier(bar, lx_tid(wave0) == 0); } while (0)
    const int lo = args.ph_lo, hi = args.ph_hi;
#define IN(k) (lo <= (k) && (k) < hi)
#define BOTH(k) (IN(k) && IN((k) + 1))
#define PHASE_PTRS() unsigned char* wsp = ws; asm volatile("" : "+s"(wsp)); float* rope = (float*)(wsp + WS_ROPE); float* ssq = (float*)(wsp + WS_SSQ); float* lp = (float*)(wsp + WS_LP); \
        bf16* XB = (bf16*)(wsp + WS_XB); bf16* MIX = (bf16*)(wsp + WS_MIX); bf16* PROJ = (bf16*)(wsp + WS_PROJ); (void)rope; (void)ssq; (void)lp; (void)XB; (void)MIX; (void)PROJ

    if (IN(0)) {
        PHASE_PTRS(); for (int l = 0; l < DEPTH; ++l) convert_weights(args, l, lds, vcu, G, wave0);
        const int wave = wave0; const int tid = lx_tid(wave); const int lane = tid & 63; const int gw = vcu * NWAVES + wave, NGW = G * NWAVES;
        for (int m = gw; m < SEQ; m += 4 * NGW) {
            f32x4 v[4][4]; float s2[4];
#pragma unroll
            for (int q = 0; q < 4; ++q) { const int mm = m + q * NGW; const GAS f32x4* xr = (const GAS f32x4*)(args.x + (size_t)(mm < SEQ ? mm : m) * DM) + lane;
#pragma unroll
                for (int j = 0; j < 4; ++j) v[q][j] = xr[64 * j]; }
#pragma unroll
            for (int q = 0; q < 4; ++q) { float a = 0.f;
#pragma unroll
                for (int j = 0; j < 4; ++j) a += (v[q][j].x * v[q][j].x + v[q][j].y * v[q][j].y) + (v[q][j].z * v[q][j].z + v[q][j].w * v[q][j].w);
                s2[q] = wave_sum(a); }
#pragma unroll
            for (int q = 0; q < 4; ++q) { const int mm = m + q * NGW; if (mm < SEQ) {
                GAS unsigned long long* o8 = (GAS unsigned long long*)(XB + (size_t)mm * DM) + lane;
#pragma unroll
                for (int j = 0; j < 4; ++j) o8[64 * j] = (unsigned long long)pk2(v[q][j].x, v[q][j].y) | ((unsigned long long)pk2(v[q][j].z, v[q][j].w) << 32);
                if (lane < 4) ssq[(size_t)mm * 4 + lane] = (lane == 0) ? s2[q] : 0.f; } }
        }
        for (int i = bx * (NWAVES * 64) + tid; i < SEQ * 8; i += G * NWAVES * 64) { const int pos = i >> 3, k = i & 7; float c, s; sincos_acc((float)pos * inv_freq(k), c, s); rope[pos * 16 + k] = c; rope[pos * 16 + 8 + k] = s; }
        if (BOTH(0)) GRID_BAR();
    }
    for (int l = 0; l < DEPTH; ++l) {
        const int pA = 1 + 3 * l, pB = pA + 1, pC = pA + 2;
        if (IN(pA)) {
            PHASE_PTRS(); bf16* WinT = (bf16*)(wsp + WS_W + (size_t)l * W_STRIDE); const float* qg = args.q_norm_g + l * 64; const float* kg = args.k_norm_g + l * 64;
            pg8::Gemm g{XB, WinT, SEQ, NIN, DM}; pg8::StaticOrder S; S.init(SEQ, NIN, G, bx);
            { static_assert(pg8::EpiInProj::OFF_ROPE == WS_ROPE && pg8::EpiInProj::OFF_SSQ == WS_SSQ && pg8::EpiInProj::OFF_P == WS_PROJ, "workspace offsets"); pg8::EpiInProj E{wsp, qg, kg};
            pg8::gemm_phase<pg8::EpiInProj, pg8::StaticOrder, true, true>(lds + RING_OFF, g, S, E, wave0); }
            if (BOTH(pA)) GRID_BAR();
        }
        if (IN(pB)) {
            PHASE_PTRS(); const float* qg = args.q_norm_g + l * 64; const float* kg = args.k_norm_g + l * 64; gu32* ctlp = (gu32*)(wsp + WS_CTL);
            const att::SbArgs SA{PROJ, MIX};
            const att::DilArgs DA{PROJ, XB, MIX, lp, (unsigned*)(ctlp + CW_GRP + l * 8 * 3 * 64), qg, kg};
            for (int u = vcu; u < 256; u += G) att::sb_unit<SB_EARLY_EXIT != 0>(u >> 6, u & 63, SA, (att::lds_ptr)(lds + RING_OFF), wave0);
            att::dil_phase<0>(vcu, G, DA, (att::lds_ptr)(lds + RING_OFF), wave0);
            if (BOTH(pB)) GRID_BAR();
        }
        if (IN(pC)) {
            PHASE_PTRS(); bf16* WoutT = (bf16*)(wsp + WS_W + (size_t)l * W_STRIDE + W_OUT_OFF);
            pg8::Gemm g{MIX, WoutT, SEQ, DM, DM}; pg8::StaticOrder S; S.init(SEQ, DM, G, bx);
            pg8::EpiOutProj E{l == 0 ? args.x : args.out, args.out, XB, ssq, l == DEPTH - 1 ? 1 : 0};
            pg8::gemm_phase<pg8::EpiOutProj, pg8::StaticOrder, false, true>(lds + RING_OFF, g, S, E, wave0);
            if (pC + 1 < N_PHASES && BOTH(pC)) GRID_BAR();
        }
    }
#undef IN
#undef BOTH
#undef GRID_BAR
}

extern "C" void kernel_launch(void* const* d_in, const int* in_sizes, int n_in, void* d_out, int out_size, void* d_ws, size_t ws_size, hipStream_t stream) {
    static int grid = 0;
    if (grid == 0) {
        if (n_in != 6 || in_sizes[0] != SEQ * DM || out_size != SEQ * DM || ws_size < WS_END) { fprintf(stderr, "kernel_launch: unexpected shapes / workspace (n_in %d, in0 %d, out %d, ws %zu, need %zu)\n", n_in, n_in > 0 ? in_sizes[0] : -1, out_size, ws_size, (size_t)WS_END); grid = -1; return; }
        int dev = 0, cus = 0, per_cu = 0;
        if (hipGetDevice(&dev) != hipSuccess || hipDeviceGetAttribute(&cus, hipDeviceAttributeMultiprocessorCount, dev) != hipSuccess) { fprintf(stderr, "kernel_launch: device query failed\n"); grid = -1; return; }
        if (hipFuncSetAttribute((const void*)hsdg_fwd, hipFuncAttributeMaxDynamicSharedMemorySize, LDS_BYTES) != hipSuccess) { fprintf(stderr, "kernel_launch: hipFuncSetAttribute failed\n"); grid = -1; return; }
        if (hipOccupancyMaxActiveBlocksPerMultiprocessor(&per_cu, (const void*)hsdg_fwd, NWAVES * 64, LDS_BYTES) != hipSuccess || per_cu < 1) fprintf(stderr, "kernel_launch: note: occupancy query reports %d workgroups per CU\n", per_cu);
        (void)hipGetLastError();
        grid = cus;
        if (grid != 256) fprintf(stderr, "kernel_launch: %d CUs; the out-proj phase assumes 256 workgroups\n", grid);
    }
    if (grid < 0) return;
    if (hipMemsetAsync((char*)d_ws + WS_CTL, 0, CTL_ZERO_BYTES, stream) != hipSuccess) { fprintf(stderr, "kernel_launch: hipMemsetAsync failed\n"); return; }
    KArgs a{};
    a.x = (const float*)d_in[0]; a.norm_g = (const float*)d_in[1]; a.w_in = (const float*)d_in[2]; a.q_norm_g = (const float*)d_in[3]; a.k_norm_g = (const float*)d_in[4]; a.w_out = (const float*)d_in[5];
    a.out = (float*)d_out; a.ws = (unsigned char*)d_ws;
    if (N_LAUNCHES == 1) { a.ph_lo = 0; a.ph_hi = N_PHASES; hipLaunchKernelGGL(hsdg_fwd, dim3(grid), dim3(NWAVES * 64), LDS_BYTES, stream, a); }
    else for (int ph = 0; ph < N_PHASES; ++ph) { a.ph_lo = ph; a.ph_hi = ph + 1; hipLaunchKernelGGL(hsdg_fwd, dim3(grid), dim3(NWAVES * 64), LDS_BYTES, stream, a); }
    const hipError_t le = hipPeekAtLastError();
    if (le != hipSuccess) fprintf(stderr, "kernel_launch: launch failed: %s\n", hipGetErrorName(le));
}
```

```cpp
#include <hip/hip_runtime.h>
#include <cstdio>
#include <cstdint>
#define PROJ_PAD 0
#ifndef MK_N_LAUNCHES
#define MK_N_LAUNCHES 1
#endif
#ifndef PROJ_PAD
#define PROJ_PAD 1
#endif
#ifndef SB_EARLY_EXIT
#define SB_EARLY_EXIT 1
#endif
template <int X> __device__ __forceinline__ float lx_xor(float v) { return __builtin_bit_cast(float, __builtin_amdgcn_ds_swizzle(__builtin_bit_cast(int, v), (X << 10) | 0x1f)); }
__device__ __forceinline__ int lx_lane() { int l; asm volatile("v_mbcnt_lo_u32_b32 %0, -1, 0\n\tv_mbcnt_hi_u32_b32 %0, -1, %0" : "=v"(l)); return l; }
__device__ __forceinline__ float lx_xor32(float v) { return __builtin_bit_cast(float, __builtin_amdgcn_ds_bpermute((lx_lane() ^ 32) << 2, __builtin_bit_cast(int, v))); }
__device__ __forceinline__ float lx_sum32(float v) { return v + lx_xor32(v); }
__device__ __forceinline__ float lx_max32(float v) { return __builtin_fmaxf(v, lx_xor32(v)); }
__device__ __forceinline__ float lx_wave_sum(float v) { v += lx_xor<1>(v); v += lx_xor<2>(v); v += lx_xor<4>(v); v += lx_xor<8>(v); v += lx_xor<16>(v); return lx_sum32(v); }
__device__ __forceinline__ float lx_wave_max(float v) { v = __builtin_fmaxf(v, lx_xor<1>(v)); v = __builtin_fmaxf(v, lx_xor<2>(v)); v = __builtin_fmaxf(v, lx_xor<4>(v)); v = __builtin_fmaxf(v, lx_xor<8>(v)); v = __builtin_fmaxf(v, lx_xor<16>(v)); return lx_max32(v); }
__device__ __forceinline__ int lx_tid(int wave) { return wave * 64 + lx_lane(); }
namespace pg8 {
#define PG8_LAS __attribute__((address_space(3)))
typedef unsigned short bf16_t;
typedef short bf16x8 __attribute__((ext_vector_type(8)));
typedef float f32x4 __attribute__((ext_vector_type(4)));
typedef unsigned u32x4 __attribute__((ext_vector_type(4)));
constexpr int BM = 256, BK = 64, HALF = 128, HTB = HALF * BK * 2  , STAGE_BYTES = 8 * HTB, NXCD = 8, WGM = 8;

__host__ __device__ __forceinline__ int lds_byte(int r, int c) { const int st = (r >> 4) * 2 + (c >> 5), rr = r & 15, cc = c & 31, ob = rr * 64 + cc * 2; return st * 1024 + (ob ^ (((ob >> 9) & 1) << 5)); }
__host__ __device__ __forceinline__ void stage_rc(int b, int& R, int& C) { const int st = b / 1024, sb = b % 1024, swz = sb ^ (((sb >> 9) & 1) << 5); R = (st >> 1) * 16 + swz / 64; C = (st & 1) * 32 + (swz % 64) / 2; }
__host__ __device__ __forceinline__ int perm32(int rho) { const int n = rho >> 4, i = rho & 15; return 8 * (i >> 2) + 4 * n + (i & 3); }

struct Unit { int pm, pn; };
struct Gemm { const bf16_t* A; const bf16_t* Bt; int M, N, K; };

struct StaticOrder {
    int nM, nN, nwg, G, c;
    __host__ __device__ void init(int M, int N, int G_, int c_) { nM = M / BM; nN = N / BM; nwg = nM * nN; G = G_; c = c_; }
    __host__ __device__ bool next(int i, Unit& u) const {
        const long L = (long)i * G + c; if (L >= nwg) return false;
        int wgid = (int)L; { const int q = nwg / NXCD, r = nwg % NXCD, xcd = wgid % NXCD, off = wgid / NXCD; wgid = (xcd < r ? xcd * (q + 1) : r * (q + 1) + (xcd - r) * q) + off; }
        const int nig = WGM * nN, gid = wgid / nig, fm = gid * WGM, gsz = (nM - fm) < WGM ? (nM - fm) : WGM;
        u.pm = fm + ((wgid % nig) % gsz); u.pn = (wgid % nig) / gsz; return true;
    }
    __device__ __forceinline__ void a_ready(const Unit&) const {}
    __device__ __forceinline__ void done(const Unit&) const {}
};

typedef float f32x2 __attribute__((ext_vector_type(2)));
typedef __bf16 bf16x2_t __attribute__((ext_vector_type(2)));
__device__ __forceinline__ unsigned cvtpk(float lo, float hi) { f32x2 v = {lo, hi}; bf16x2_t b = __builtin_convertvector(v, bf16x2_t); return __builtin_bit_cast(unsigned, b); }
constexpr int SEQ = 16384; constexpr int PROWS = SEQ + (PROJ_PAD ? SEQ / 16 : 0); constexpr size_t TSTRIDE = (size_t)PROWS * 64;
constexpr float EPSV = 1e-6f;
constexpr float QSCALE = 0.125f * 1.4426950408889634f;

constexpr float ROT_C[8][8] = {{1.000000000e+00f, 1.000000000e+00f, 1.000000000e+00f, 1.000000000e+00f, 1.000000000e+00f, 1.000000000e+00f, 1.000000000e+00f, 1.000000000e+00f}, {-9.576594803e-01f, -9.992462676e-01f, 8.243765167e-01f, 9.932003006e-01f, 9.997440110e-01f, 9.999903729e-01f, 9.999996380e-01f, 9.999999864e-01f}, {8.342233605e-01f, 9.969862065e-01f, 3.591932825e-01f, 9.728936743e-01f, 9.989761749e-01f, 9.999614917e-01f, 9.999985518e-01f, 9.999999455e-01f}, {-6.401443395e-01f, -9.932232238e-01f, -2.321555027e-01f, 9.393562789e-01f, 9.976968850e-01f, 9.999133569e-01f, 9.999967417e-01f, 9.999998775e-01f}, {-6.928958219e-01f, 9.521417467e-01f, 1.010103862e-01f, 5.950558964e-01f, 9.836606931e-01f, 9.993839260e-01f, 9.999768296e-01f, 9.999991287e-01f}, {8.711474010e-01f, -9.395588652e-01f, 6.464173313e-01f, 4.974463326e-01f, 9.793355680e-01f, 9.992203026e-01f, 9.999706750e-01f, 9.999988972e-01f}, {-9.756293128e-01f, 9.255596318e-01f, 9.647721496e-01f, 3.930717976e-01f, 9.745090446e-01f, 9.990374400e-01f, 9.999637963e-01f, 9.999986385e-01f}, {9.974939203e-01f, -9.101651497e-01f, 9.442536768e-01f, 2.833517226e-01f, 9.691835939e-01f, 9.988353416e-01f, 9.999561936e-01f, 9.999983526e-01f}};
constexpr float ROT_S[8][8] = {{0.000000000e+00f, 0.000000000e+00f, 0.000000000e+00f, 0.000000000e+00f, 0.000000000e+00f, 0.000000000e+00f, 0.000000000e+00f, 0.000000000e+00f}, {-2.879033167e-01f, 3.881876802e-02f, 5.660418348e-01f, 1.164180522e-01f, 2.262548431e-02f, 4.387956933e-03f, 8.509273312e-04f, 1.650141632e-04f}, {5.514266812e-01f, -7.757901811e-02f, 9.332631922e-01f, 2.312528888e-01f, 4.523938487e-02f, 8.775829378e-03f, 1.701854046e-03f, 3.300283219e-04f}, {-7.682546613e-01f, 1.162223206e-01f, 9.726786841e-01f, 3.429428252e-01f, 6.783012386e-02f, 1.316353285e-02f, 2.552779529e-03f, 4.950424716e-04f}, {7.210377105e-01f, -3.056568242e-01f, -9.948853712e-01f, 8.036843162e-01f, 1.800323329e-01f, 3.509655897e-02f, 6.807366895e-03f, 1.320112928e-03f}, {-4.910215939e-01f, 3.423874103e-01f, -7.629840324e-01f, 8.674947529e-01f, 2.022420461e-01f, 3.948147472e-02f, 7.658272045e-03f, 1.485126930e-03f}, {2.194252584e-01f, -3.786018594e-01f, -2.630868667e-01f, 9.195077824e-01f, 2.243482159e-01f, 4.386563028e-02f, 8.509171650e-03f, 1.650140891e-03f}, {7.075223608e-02f, 4.142455796e-01f, 3.292187630e-01f, 9.590160589e-01f, 2.463395243e-01f, 4.824894124e-02f, 9.360065094e-03f, 1.815154807e-03f}};
struct EpiInProj {
    static constexpr bool PERM = true, AFTER_DRAIN = false;
    unsigned char* wsb; const float* qg; const float* kg;
    static constexpr size_t OFF_ROPE = (size_t)1 << 20, OFF_SSQ = (size_t)2 << 20, OFF_P = (size_t)110 << 20;
    __device__ __forceinline__ void operator()(const f32x4 (&acc)[2][2][4][2], const Unit& u, int wr, int wc, int fr, int fq) const {
        bf16_t* const P = (bf16_t*)(wsb + OFF_P); const float* const ssq = (const float*)(wsb + OFF_SSQ); const float* const rope = (const float*)(wsb + OFF_ROPE);
        const int pn = u.pn;
        const int kind = (pn == 0) ? 0 : ((pn == 3 || pn >= 13) ? 1 : ((pn >= 4 && pn <= 6) ? 2 : ((pn >= 7 && pn <= 9) ? 3 : 4)));
        bf16_t* const tens = P + (size_t)(pn * 4 + wc) * TSTRIDE + 8 * fq;
        const int row0 = u.pm * BM + wr * 64 + fr;
        f32x4 sq[8];
#pragma unroll
        for (int j = 0; j < 8; ++j) sq[j] = *(const f32x4*)(ssq + (size_t)(row0 + (j >> 2) * HALF + (j & 3) * 16) * 4);
        f32x4 g[2][2], cb[2], sb[2];
#pragma unroll
        for (int bj = 0; bj < 2; ++bj)
#pragma unroll
            for (int n = 0; n < 2; ++n) g[bj][n] = (f32x4){1.f, 1.f, 1.f, 1.f};
#pragma unroll
        for (int n = 0; n < 2; ++n) { cb[n] = (f32x4){1.f, 1.f, 1.f, 1.f}; sb[n] = (f32x4){0.f, 0.f, 0.f, 0.f}; }
        if (kind == 2 || kind == 3) { const float* gp = (kind == 2) ? qg : kg;
#pragma unroll
            for (int bj = 0; bj < 2; ++bj)
#pragma unroll
                for (int n = 0; n < 2; ++n) g[bj][n] = *(const f32x4*)(gp + 32 * bj + 8 * fq + 4 * n);
#pragma unroll
            for (int n = 0; n < 2; ++n) { cb[n] = *(const f32x4*)(rope + (size_t)row0 * 16 + 4 * n); sb[n] = *(const f32x4*)(rope + (size_t)row0 * 16 + 8 + 4 * n); } }
        float rs[8];
#pragma unroll
        for (int j = 0; j < 8; ++j) rs[j] = __builtin_amdgcn_rsqf(((sq[j][0] + sq[j][1]) + (sq[j][2] + sq[j][3])) * (1.0f / 1024.0f) + EPSV);
#pragma unroll
        for (int ai = 0; ai < 2; ++ai)
#pragma unroll
            for (int m = 0; m < 4; ++m) {
                const int row = row0 + ai * HALF + m * 16;
                f32x4 v[2][2];
#pragma unroll
                for (int bj = 0; bj < 2; ++bj)
#pragma unroll
                    for (int n = 0; n < 2; ++n) v[bj][n] = acc[ai][bj][m][n] * rs[ai * 4 + m];
                if (kind == 0) {
#pragma unroll
                    for (int bj = 0; bj < 2; ++bj)
#pragma unroll
                        for (int n = 0; n < 2; ++n) v[bj][n] = v[bj][n] * QSCALE;
                } else if (kind == 1) {
#pragma unroll
                    for (int bj = 0; bj < 2; ++bj)
#pragma unroll
                        for (int n = 0; n < 2; ++n)
#pragma unroll
                            for (int e = 0; e < 4; ++e) { const float x = v[bj][n][e]; v[bj][n][e] = x * __builtin_amdgcn_rcpf(1.0f + __builtin_amdgcn_exp2f(-1.4426950408889634f * x)); }
                } else if (kind == 2 || kind == 3) {
                    float hs = 0.f;
#pragma unroll
                    for (int bj = 0; bj < 2; ++bj)
#pragma unroll
                        for (int n = 0; n < 2; ++n) { const f32x4 x = v[bj][n]; hs += (x[0] * x[0] + x[1] * x[1]) + (x[2] * x[2] + x[3] * x[3]); }
                    hs += lx_xor<16>(hs); hs = lx_sum32(hs);
                    const float hr = __builtin_amdgcn_rsqf(hs * (1.0f / 64.0f) + EPSV);
#pragma unroll
                    for (int bj = 0; bj < 2; ++bj)
#pragma unroll
                        for (int n = 0; n < 2; ++n) v[bj][n] = v[bj][n] * hr * g[bj][n];
#pragma unroll
                    for (int n = 0; n < 2; ++n)
#pragma unroll
                        for (int e = 0; e < 4; ++e) { const int i = 4 * n + e; const float cr = ROT_C[ai * 4 + m][i], sr = ROT_S[ai * 4 + m][i];
                            const float cc = cb[n][e] * cr - sb[n][e] * sr, ss2 = sb[n][e] * cr + cb[n][e] * sr;
                            const float own = v[0][n][e]; const float oth = lx_xor<16>(own);
                            const float r0 = own * cc - oth * ss2, r1 = own * cc + oth * ss2;
                            v[0][n][e] = (fq == 0) ? r0 : ((fq == 1) ? r1 : own); }
                    if (kind == 2) {
#pragma unroll
                        for (int bj = 0; bj < 2; ++bj)
#pragma unroll
                            for (int n = 0; n < 2; ++n) v[bj][n] = v[bj][n] * QSCALE;
                    }
                }
                bf16_t* rowp = tens + (size_t)(PROJ_PAD ? row + (row >> 4) : row) * 64;
#pragma unroll
                for (int bj = 0; bj < 2; ++bj) { u32x4 w; w.x = cvtpk(v[bj][0][0], v[bj][0][1]); w.y = cvtpk(v[bj][0][2], v[bj][0][3]); w.z = cvtpk(v[bj][1][0], v[bj][1][1]); w.w = cvtpk(v[bj][1][2], v[bj][1][3]);
                    *(u32x4*)(rowp + 32 * bj) = w; }
            }
    }
};

struct EpiOutProj {
    static constexpr bool PERM = true, AFTER_DRAIN = true;
    const float* xin; float* xout; bf16_t* xb; float* ssq; int last;
    __device__ __forceinline__ void fused(f32x4 (&acc)[2][2][4][2], const Unit& u, int wr, int wc, int fr, int fq, PG8_LAS unsigned char* lds, int wid, int lane) const {
        PG8_LAS float* Pw = (PG8_LAS float*)lds;
        const size_t off0 = (size_t)(u.pm * BM + wr * 64 + fr) * 1024 + u.pn * BM + wc * 32 + 8 * fq;
        f32x4 pre[2][2][2][2];
#define EOP_LOAD(buf, pr) do { _Pragma("unroll") for (int q_ = 0; q_ < 2; ++q_) { const int j_ = 2 * (pr) + q_; const size_t o_ = off0 + (size_t)((j_ >> 2) * HALF + (j_ & 3) * 16) * 1024; \
            _Pragma("unroll") for (int bj = 0; bj < 2; ++bj) { pre[buf][q_][bj][0] = *(const f32x4*)(xin + o_ + bj * HALF); pre[buf][q_][bj][1] = *(const f32x4*)(xin + o_ + bj * HALF + 4); } } } while (0)
        EOP_LOAD(0, 0); asm volatile("" ::: "memory"); EOP_LOAD(1, 1); asm volatile("" ::: "memory");
#pragma unroll
        for (int pr = 0; pr < 4; ++pr) {
#pragma unroll
            for (int q = 0; q < 2; ++q) { const int j = 2 * pr + q, ai = j >> 2, m = j & 3; const int rt = ai * HALF + wr * 64 + m * 16 + fr; const size_t off = off0 + (size_t)(ai * HALF + m * 16) * 1024;
                float s = 0.f;
#pragma unroll
                for (int bj = 0; bj < 2; ++bj) {
                    const f32x4 a0 = pre[pr & 1][q][bj][0] + acc[ai][bj][m][0], a1 = pre[pr & 1][q][bj][1] + acc[ai][bj][m][1];
                    *(f32x4*)(xout + off + bj * HALF) = a0; *(f32x4*)(xout + off + bj * HALF + 4) = a1;
                    if (!last) { u32x4 w; w.x = cvtpk(a0[0], a0[1]); w.y = cvtpk(a0[2], a0[3]); w.z = cvtpk(a1[0], a1[1]); w.w = cvtpk(a1[2], a1[3]);
                        *(u32x4*)(xb + off + bj * HALF) = w; }
                    s += ((a0[0] * a0[0] + a0[1] * a0[1]) + (a0[2] * a0[2] + a0[3] * a0[3])) + ((a1[0] * a1[0] + a1[1] * a1[1]) + (a1[2] * a1[2] + a1[3] * a1[3]));
                }
                s += lx_xor<16>(s); s = lx_sum32(s);
                if (fq == 0) Pw[rt * 4 + wc] = s; }
            asm volatile("" ::: "memory");
            if (pr + 2 < 4) { EOP_LOAD(pr & 1, pr + 2); asm volatile("" ::: "memory"); }
        }
#undef EOP_LOAD
        asm volatile("s_waitcnt lgkmcnt(0)" ::: "memory"); __builtin_amdgcn_s_barrier(); asm volatile("" ::: "memory");
        const int t = wid * 64 + lane;
        if (t < 256) { const float s = (Pw[t * 4 + 0] + Pw[t * 4 + 1]) + (Pw[t * 4 + 2] + Pw[t * 4 + 3]); ssq[(size_t)(u.pm * BM + t) * 4 + u.pn] = s; }
        asm volatile("s_waitcnt lgkmcnt(0)" ::: "memory"); __builtin_amdgcn_s_barrier(); asm volatile("" ::: "memory");
    }
};

template <class Epi, class Sched, bool ALIGN_EPI = false, bool SP2 = false>
__device__ __forceinline__ void gemm_phase(PG8_LAS unsigned char* lds, const Gemm g, const Sched& S, const Epi& E, int wave) {
    int wid = wave; asm volatile("" : "+s"(wid)); const int tid = lx_tid(wid);
    const int lane = tid & 63, wr = wid >> 2, wc = wid & 3, fr = lane & 15, fq = lane >> 4;
    const int K = g.K, nt = K / BK;
    unsigned voffA[2], voffB[2];
#pragma unroll
    for (int i = 0; i < 2; ++i) { int R, C; stage_rc(tid * 16 + i * 8192, R, C); const int Rb = Epi::PERM ? ((R & ~31) + perm32(R & 31)) : R;
        voffA[i] = (unsigned)(R * K + C) * 2u; voffB[i] = (unsigned)(Rb * K + C) * 2u; }
    const size_t kstep = (size_t)(BK * 2);
    const size_t hstep = (size_t)HALF * K * 2;
    const size_t tstep = 2 * hstep;
    const unsigned ldsw = (unsigned)wid * 1024u;
    const int aoff = lds_byte(wr * 64 + fr, fq * 8), boff = lds_byte(wc * 32 + fr, fq * 8);
#define PG8_SA(b, h) (((b) * 2 + (h)) * HTB)
#define PG8_SB(b, h) ((4 + (b) * 2 + (h)) * HTB)
#define PG8_STAGE(bufoff, gbase, voff) do { _Pragma("unroll") for (int _i = 0; _i < 2; ++_i) \
        __builtin_amdgcn_global_load_lds((const unsigned*)((const char*)(gbase) + (voff)[_i]), (PG8_LAS unsigned*)(lds + (bufoff) + ldsw + _i * 8192), 16, 0, 0); } while (0)
#define PG8_LDA(dst, b, h) do { _Pragma("unroll") for (int m = 0; m < 4; ++m) _Pragma("unroll") for (int k = 0; k < 2; ++k) dst[m][k] = *(const PG8_LAS bf16x8*)(lds + PG8_SA(b, h) + aoff + m * 2048 + k * 1024); } while (0)
#define PG8_LDB(dst, b, h) do { _Pragma("unroll") for (int n = 0; n < 2; ++n) _Pragma("unroll") for (int k = 0; k < 2; ++k) dst[n][k] = *(const PG8_LAS bf16x8*)(lds + PG8_SB(b, h) + boff + n * 2048 + k * 1024); } while (0)
#define PG8_MMA(ai, bj, At, Bt) do { __builtin_amdgcn_s_setprio(1); _Pragma("unroll") for (int m = 0; m < 4; ++m) _Pragma("unroll") for (int n = 0; n < 2; ++n) _Pragma("unroll") for (int k = 0; k < 2; ++k) \
        acc[ai][bj][m][n] = __builtin_amdgcn_mfma_f32_16x16x32_bf16(Bt[n][k], At[m][k], acc[ai][bj][m][n], 0, 0, 0); __builtin_amdgcn_s_setprio(0); } while (0)
#define PG8_WAIT_V(n) asm volatile("s_waitcnt vmcnt(" #n ")" ::: "memory")
#define PG8_WAIT_L(n) asm volatile("s_waitcnt lgkmcnt(" #n ")" ::: "memory")
#define PG8_BAR __builtin_amdgcn_s_barrier()
#define PG8_SCHED __builtin_amdgcn_sched_barrier(0)
    Unit cur, nxt; int ui = 0;
    if (!S.next(0, cur)) return;
    f32x4 acc[2][2][4][2];
#pragma unroll
    for (int a = 0; a < 2; ++a)
#pragma unroll
        for (int b = 0; b < 2; ++b)
#pragma unroll
            for (int m = 0; m < 4; ++m)
#pragma unroll
                for (int n = 0; n < 2; ++n) acc[a][b][m][n] = (f32x4){0.f, 0.f, 0.f, 0.f};
    bf16x8 At[4][2], B0[2][2], B1[2][2];
    const char* cA = (const char*)g.A + (size_t)cur.pm * tstep; const char* cB = (const char*)g.Bt + (size_t)cur.pn * tstep;
    S.a_ready(cur);
    if constexpr (SP2) {
        PG8_STAGE(PG8_SB(0, 0), cB, voffB); PG8_STAGE(PG8_SB(0, 1), cB + hstep, voffB); PG8_STAGE(PG8_SA(0, 0), cA, voffA); PG8_STAGE(PG8_SA(0, 1), cA + hstep, voffA);
        if (wr == 1) PG8_BAR;
        PG8_WAIT_V(2); PG8_BAR;
        PG8_STAGE(PG8_SB(1, 0), cB + kstep, voffB); PG8_STAGE(PG8_SA(1, 0), cA + kstep, voffA); PG8_STAGE(PG8_SB(1, 1), cB + hstep + kstep, voffB);
        PG8_WAIT_V(6); PG8_BAR;
    } else {
        PG8_STAGE(PG8_SB(0, 0), cB, voffB); PG8_STAGE(PG8_SA(0, 0), cA, voffA); PG8_STAGE(PG8_SB(0, 1), cB + hstep, voffB); PG8_STAGE(PG8_SA(0, 1), cA + hstep, voffA);
        if (wr == 1) PG8_BAR;
        PG8_WAIT_V(4); PG8_BAR;
        PG8_STAGE(PG8_SB(1, 0), cB + kstep, voffB); PG8_STAGE(PG8_SA(1, 0), cA + kstep, voffA); PG8_STAGE(PG8_SB(1, 1), cB + hstep + kstep, voffB);
        PG8_WAIT_V(6); PG8_BAR;
    }
    for (;;) {
        const bool has_next = S.next(ui + 1, nxt);
        const char* nA = has_next ? (const char*)g.A + (size_t)nxt.pm * tstep : cA; const char* nB = has_next ? (const char*)g.Bt + (size_t)nxt.pn * tstep : cB;
        for (int t = 0; t < nt; t += 2) {
            const bool last = (t == nt - 2);
            const char* a1 = cA + (size_t)(t + 1) * kstep;
            const char* a2 = last ? nA : cA + (size_t)(t + 2) * kstep; const char* b2 = last ? nB : cB + (size_t)(t + 2) * kstep;
            const char* a3 = a2 + kstep; const char* b3 = b2 + kstep;
            if (last && has_next) S.a_ready(nxt);
            if constexpr (SP2) {
            PG8_LDB(B0, 0, 0); PG8_LDB(B1, 0, 1); PG8_SCHED; PG8_LDA(At, 0, 0); PG8_STAGE(PG8_SA(1, 1), a1 + hstep, voffA);
            PG8_WAIT_V(8); PG8_WAIT_L(0); PG8_BAR; PG8_MMA(0, 0, At, B0); PG8_MMA(0, 1, At, B1); PG8_BAR; PG8_SCHED;
            PG8_LDA(At, 0, 1); PG8_STAGE(PG8_SB(0, 0), b2, voffB); PG8_STAGE(PG8_SB(0, 1), b2 + hstep, voffB); PG8_STAGE(PG8_SA(0, 0), a2, voffA);
            PG8_WAIT_V(8); PG8_WAIT_L(0); PG8_BAR; PG8_MMA(1, 0, At, B0); PG8_MMA(1, 1, At, B1); PG8_BAR; PG8_SCHED;
            PG8_LDB(B0, 1, 0); PG8_LDB(B1, 1, 1); PG8_SCHED; PG8_LDA(At, 1, 0); PG8_STAGE(PG8_SA(0, 1), a2 + hstep, voffA);
            PG8_WAIT_V(8); PG8_WAIT_L(0); PG8_BAR; PG8_MMA(0, 0, At, B0); PG8_MMA(0, 1, At, B1); PG8_BAR; PG8_SCHED;
            PG8_LDA(At, 1, 1); PG8_STAGE(PG8_SB(1, 0), b3, voffB); PG8_STAGE(PG8_SB(1, 1), b3 + hstep, voffB); PG8_STAGE(PG8_SA(1, 0), a3, voffA);
            PG8_WAIT_V(8); PG8_WAIT_L(0); PG8_BAR; PG8_MMA(1, 0, At, B0); PG8_MMA(1, 1, At, B1); PG8_BAR; PG8_SCHED;
            } else {
            PG8_LDB(B0, 0, 0); PG8_SCHED; PG8_LDA(At, 0, 0); PG8_STAGE(PG8_SA(1, 1), a1 + hstep, voffA);
            PG8_WAIT_L(8); PG8_BAR; PG8_WAIT_L(0); PG8_MMA(0, 0, At, B0); PG8_BAR; PG8_SCHED;
            PG8_LDB(B1, 0, 1); PG8_STAGE(PG8_SB(0, 0), b2, voffB);
            PG8_BAR; PG8_WAIT_L(0); PG8_MMA(0, 1, At, B1); PG8_BAR;
            PG8_LDA(At, 0, 1); PG8_STAGE(PG8_SA(0, 0), a2, voffA);
            PG8_BAR; PG8_WAIT_L(0); PG8_MMA(1, 0, At, B0); PG8_BAR; PG8_SCHED;
            PG8_STAGE(PG8_SB(0, 1), b2 + hstep, voffB);
            PG8_WAIT_V(6); PG8_BAR; PG8_MMA(1, 1, At, B1); PG8_BAR;
            PG8_LDB(B0, 1, 0); PG8_SCHED; PG8_LDA(At, 1, 0); PG8_STAGE(PG8_SA(0, 1), a2 + hstep, voffA);
            PG8_WAIT_L(8); PG8_BAR; PG8_WAIT_L(0); PG8_MMA(0, 0, At, B0); PG8_BAR; PG8_SCHED;
            PG8_LDB(B1, 1, 1); PG8_STAGE(PG8_SB(1, 0), b3, voffB);
            PG8_BAR; PG8_WAIT_L(0); PG8_MMA(0, 1, At, B1); PG8_BAR;
            PG8_LDA(At, 1, 1); PG8_STAGE(PG8_SA(1, 0), a3, voffA);
            PG8_BAR; PG8_WAIT_L(0); PG8_MMA(1, 0, At, B0); PG8_BAR; PG8_SCHED;
            PG8_STAGE(PG8_SB(1, 1), b3 + hstep, voffB);
            PG8_WAIT_V(6); PG8_BAR; PG8_MMA(1, 1, At, B1); PG8_BAR;
            }
        }
        if constexpr (ALIGN_EPI) { if (wr == 0) PG8_BAR; }
        if constexpr (!Epi::AFTER_DRAIN) { E(acc, cur, wr, wc, fr, fq);
            S.done(cur); }
        if (!has_next) break;
#pragma unroll
        for (int a = 0; a < 2; ++a)
#pragma unroll
            for (int b = 0; b < 2; ++b)
#pragma unroll
                for (int m = 0; m < 4; ++m)
#pragma unroll
                    for (int n = 0; n < 2; ++n) acc[a][b][m][n] = (f32x4){0.f, 0.f, 0.f, 0.f};
        cur = nxt; cA = nA; cB = nB; ++ui;
        if constexpr (ALIGN_EPI) { if (wr == 1) PG8_BAR; }
    }
    PG8_WAIT_V(0);
    if constexpr (!ALIGN_EPI) { if (wr == 0) PG8_BAR; }
    PG8_BAR;
    if constexpr (Epi::AFTER_DRAIN) { E.fused(acc, cur, wr, wc, fr, fq, lds, wid, lane); S.done(cur); }
#undef PG8_SA
#undef PG8_SB
#undef PG8_STAGE
#undef PG8_LDA
#undef PG8_LDB
#undef PG8_MMA
#undef PG8_WAIT_V
#undef PG8_WAIT_L
#undef PG8_BAR
#undef PG8_SCHED
}
}
namespace att {
#define ATT_LAS __attribute__((address_space(3)))
using bf16x8 = __attribute__((ext_vector_type(8))) short;
using s16x4 = __attribute__((ext_vector_type(4))) short;
using f32x16 = __attribute__((ext_vector_type(16))) float;
using u32x4 = __attribute__((ext_vector_type(4))) unsigned;
typedef unsigned short bf16_t;
typedef ATT_LAS const char* lds_cptr;
typedef ATT_LAS char* lds_ptr;
typedef short v4i16_t __attribute__((ext_vector_type(4)));
typedef float f32x2_t __attribute__((ext_vector_type(2))); typedef __bf16 bf16x2_t __attribute__((ext_vector_type(2)));
constexpr int SEQ = 16384;
constexpr int PROWS = SEQ + (PROJ_PAD ? SEQ / 16 : 0); constexpr size_t TSTRIDE = (size_t)PROWS * 64;
constexpr int T_QA = 0, T_KA = 4, T_VA = 8, T_GA = 12, T_QD = 16, T_KD = 28, T_VD = 40, T_GD = 52;
__device__ __forceinline__ int prow(int t) { return PROJ_PAD ? t + (t >> 4) : t; }
constexpr int SLOTB = 8192, NSLOT = 6;
constexpr int LDS_K = 0, LDS_K2 = NSLOT * SLOTB, LDS_V = 2 * NSLOT * SLOTB, LDS_WS = 3 * NSLOT * SLOTB, LDS_FLAG = LDS_WS + 8 * 64 * 4, LDS_END = LDS_FLAG + 128;
constexpr int LDS_OST = LDS_K2;
#define ATT_BAR_L() asm volatile("s_waitcnt lgkmcnt(0)\n\ts_barrier" ::: "memory")
constexpr float SB_DEAD = 152.0f;
__device__ __forceinline__ int crow(int r, int hi) { return (r & 3) + 8 * (r >> 2) + 4 * hi; }
__device__ __forceinline__ unsigned cvtpk_s(float lo, float hi) { f32x2_t v = {lo, hi}; bf16x2_t b = __builtin_convertvector(v, bf16x2_t); return __builtin_bit_cast(unsigned, b); }
__device__ __forceinline__ float bf2f(unsigned short b) { return __uint_as_float((unsigned)b << 16); }
__device__ __forceinline__ void glds16(const void* gsrc, unsigned lds_dst) { unsigned keep;
    asm volatile("s_mov_b32 %0, m0\n\ts_mov_b32 m0, %2\n\ts_nop 0\n\tglobal_load_lds_dwordx4 %1, off\n\ts_mov_b32 m0, %0" : "=&s"(keep) : "v"(gsrc), "s"(lds_dst) : "memory"); }
__device__ __forceinline__ void glds16s(unsigned voff, const void* sbase, unsigned lds_dst) { unsigned keep;
    const unsigned long long a_ = (unsigned long long)sbase;
    const unsigned long long b_ = (unsigned long long)(unsigned)__builtin_amdgcn_readfirstlane((int)(unsigned)a_) | ((unsigned long long)(unsigned)__builtin_amdgcn_readfirstlane((int)(unsigned)(a_ >> 32)) << 32);
    asm volatile("s_nop 4\n\ts_mov_b32 %0, m0\n\ts_mov_b32 m0, %3\n\ts_nop 0\n\tglobal_load_lds_dwordx4 %1, %2\n\ts_mov_b32 m0, %0" : "=&s"(keep) : "v"(voff), "s"(b_), "s"(lds_dst) : "memory"); }
#define ATT_WAIT_BAR(N) asm volatile("s_waitcnt vmcnt(" #N ") lgkmcnt(0)\n\ts_barrier" ::: "memory")
__device__ __forceinline__ s16x4 vtr(lds_cptr p) { return __builtin_bit_cast(s16x4, __builtin_amdgcn_ds_read_tr16_b64_v4i16((ATT_LAS v4i16_t*)p)); }

__device__ __forceinline__ void qkt(f32x16& p0, f32x16& p1, lds_cptr ks, const int (&koff)[4], const bf16x8* qr, const f32x16& cinit) {
#pragma unroll
    for (int d0 = 0; d0 < 4; ++d0) {
        const bf16x8 b0 = *(const ATT_LAS bf16x8*)(ks + koff[d0]);
        const bf16x8 b1 = *(const ATT_LAS bf16x8*)(ks + koff[d0] + 4096);
        if (d0 == 0) { p0 = __builtin_amdgcn_mfma_f32_32x32x16_bf16(b0, qr[0], cinit, 0, 0, 0); p1 = __builtin_amdgcn_mfma_f32_32x32x16_bf16(b1, qr[0], cinit, 0, 0, 0); }
        else { p0 = __builtin_amdgcn_mfma_f32_32x32x16_bf16(b0, qr[d0], p0, 0, 0, 0); p1 = __builtin_amdgcn_mfma_f32_32x32x16_bf16(b1, qr[d0], p1, 0, 0, 0); }
    }
}
__device__ __forceinline__ void pv(f32x16* o, lds_cptr vp, bf16x8 pa0, bf16x8 pa1, bf16x8 pa2, bf16x8 pa3) {
#pragma unroll
    for (int d0 = 0; d0 < 2; ++d0) { s16x4 lo[4], hi[4];
#pragma unroll
        for (int ks = 0; ks < 4; ++ks) { lo[ks] = vtr(vp + d0 * 4096 + ks * 1024); hi[ks] = vtr(vp + d0 * 4096 + ks * 1024 + 512); }
#define ATT_PK(k) (bf16x8){lo[k][0], lo[k][1], lo[k][2], lo[k][3], hi[k][0], hi[k][1], hi[k][2], hi[k][3]}
        o[d0] = __builtin_amdgcn_mfma_f32_32x32x16_bf16(ATT_PK(0), pa0, o[d0], 0, 0, 0);
        o[d0] = __builtin_amdgcn_mfma_f32_32x32x16_bf16(ATT_PK(1), pa1, o[d0], 0, 0, 0);
        o[d0] = __builtin_amdgcn_mfma_f32_32x32x16_bf16(ATT_PK(2), pa2, o[d0], 0, 0, 0);
        o[d0] = __builtin_amdgcn_mfma_f32_32x32x16_bf16(ATT_PK(3), pa3, o[d0], 0, 0, 0);
#undef ATT_PK
    }
}
__device__ __forceinline__ void ot_rows(const f32x16* o, lds_ptr stg, int q, int hi, int lane, u32x4* sv) {
#pragma unroll
    for (int d0 = 0; d0 < 2; ++d0)
#pragma unroll
        for (int pr = 0; pr < 2; ++pr) { const int g = 2 * pr;
            const unsigned ax = cvtpk_s(o[d0][4 * g], o[d0][4 * g + 1]), ay = cvtpk_s(o[d0][4 * g + 2], o[d0][4 * g + 3]), bx = cvtpk_s(o[d0][4 * g + 4], o[d0][4 * g + 5]), by = cvtpk_s(o[d0][4 * g + 6], o[d0][4 * g + 7]);
            const auto rx = __builtin_amdgcn_permlane32_swap(ax, bx, false, false); const auto ry = __builtin_amdgcn_permlane32_swap(ay, by, false, false);
            *(ATT_LAS u32x4*)(stg + q * 128 + (((4 * d0 + 2 * pr + hi) ^ (q & 7)) << 4)) = (u32x4){rx[0], ry[0], rx[1], ry[1]}; }
    asm volatile("s_waitcnt lgkmcnt(0)" ::: "memory");
#pragma unroll
    for (int i = 0; i < 4; ++i) { const int rw = 8 * i + (lane >> 3); sv[i] = *(const ATT_LAS u32x4*)(stg + rw * 128 + (((lane & 7) ^ (rw & 7)) << 4)); }
}
__device__ __forceinline__ bf16x8 pack8(const float* a) { u32x4 w; w.x = cvtpk_s(a[0], a[1]); w.y = cvtpk_s(a[2], a[3]); w.z = cvtpk_s(a[4], a[5]); w.w = cvtpk_s(a[6], a[7]); return __builtin_bit_cast(bf16x8, w); }

template <bool MASK> __device__ __forceinline__ void sb_tile(const f32x16& p0, const f32x16& p1, float& Rsum, int qrel, int hi, bf16x8& pa0, bf16x8& pa1, bf16x8& pa2, bf16x8& pa3) {
    float run = Rsum; unsigned pw[16];
#pragma unroll
    for (int g = 7; g >= 0; --g) {
        float z[4], sp[4];
#pragma unroll
        for (int e = 0; e < 4; ++e) { const int idx = 4 * g + e; z[e] = (idx < 16) ? p0[idx] : p1[idx - 16];
            sp[e] = __builtin_fmaxf(z[e], 0.f) + __builtin_amdgcn_logf(1.0f + __builtin_amdgcn_exp2f(-__builtin_fabsf(z[e])));
            if (MASK) { if (8 * g + 4 * hi + e >= qrel) sp[e] = 0.f; } }
        const float e2 = sp[3], e1 = sp[3] + sp[2], e0 = e1 + sp[1], T = e0 + sp[0];
        const auto rr = __builtin_amdgcn_permlane32_swap(__float_as_uint(T), __float_as_uint(T), false, false);
        const float tev = __uint_as_float(rr[0]), tod = __uint_as_float(rr[1]);
        const float off = run + (hi ? 0.f : tod);
        run += tev + tod;
        float a[4];
        a[0] = __builtin_amdgcn_exp2f((z[0] - sp[0]) - (off + e0)); a[1] = __builtin_amdgcn_exp2f((z[1] - sp[1]) - (off + e1));
        a[2] = __builtin_amdgcn_exp2f((z[2] - sp[2]) - (off + e2)); a[3] = __builtin_amdgcn_exp2f((z[3] - sp[3]) - off);
        if (MASK) {
#pragma unroll
            for (int e = 0; e < 4; ++e) if (8 * g + 4 * hi + e >= qrel) a[e] = 0.f; }
        pw[2 * g] = cvtpk_s(a[0], a[1]); pw[2 * g + 1] = cvtpk_s(a[2], a[3]);
    }
    Rsum = run;
    pa0 = __builtin_bit_cast(bf16x8, (u32x4){pw[0], pw[1], pw[2], pw[3]}); pa1 = __builtin_bit_cast(bf16x8, (u32x4){pw[4], pw[5], pw[6], pw[7]});
    pa2 = __builtin_bit_cast(bf16x8, (u32x4){pw[8], pw[9], pw[10], pw[11]}); pa3 = __builtin_bit_cast(bf16x8, (u32x4){pw[12], pw[13], pw[14], pw[15]});
}

struct SbArgs { const bf16_t* proj; bf16_t* mix; };
template <bool EARLY> __device__ __forceinline__ void sb_unit(int h, int qb, const SbArgs& A, lds_ptr shm, int wave) {
    int wid = wave; asm volatile("" : "+s"(wid)); const int tid = lx_tid(wid);
    const int lane = tid & 63, r32 = lane & 31, hi = lane >> 5;
    const int q0 = qb * 256;
    const bf16_t* Qh = A.proj + (size_t)(T_QA + h) * TSTRIDE; const bf16_t* Kh = A.proj + (size_t)(T_KA + h) * TSTRIDE; const bf16_t* Vh = A.proj + (size_t)(T_VA + h) * TSTRIDE;
    const unsigned lds0 = (unsigned)(size_t)shm;
    volatile ATT_LAS unsigned* flags = (volatile ATT_LAS unsigned*)(shm + LDS_FLAG);
    const unsigned kdst = lds0 + LDS_K + wid * 1024, vdst = lds0 + LDS_V + wid * 1024;
    const lds_cptr ks0 = (lds_cptr)shm + LDS_K; int koff[4];
#pragma unroll
    for (int d0 = 0; d0 < 4; ++d0) koff[d0] = r32 * 128 + (((2 * d0 + hi) ^ ((r32 >> 1) & 7)) << 4);
    const lds_cptr vp0 = (lds_cptr)shm + LDS_V + ((lane >> 4) & 1) * 32 + (lane & 3) * 8 + (4 * hi + ((lane & 15) >> 2)) * 64;
#define SB_DMA(jt, slot) do { const int jt_ = (jt) < 0 ? 0 : (jt); const int l_ = lx_lane(); const int kkey_ = 8 * wid + (l_ >> 3), vkey_ = 16 * (wid & 3) + (l_ >> 2); \
        const unsigned voffK_ = (unsigned)((prow(kkey_) * 64 + ((l_ & 7) ^ ((kkey_ >> 1) & 7)) * 8) * 2), voffV_ = (unsigned)((prow(vkey_) * 64 + (wid >> 2) * 32 + (l_ & 3) * 8) * 2); \
        glds16s(voffK_, (const char*)Kh + (size_t)jt_ * ((PROJ_PAD ? 68 : 64) * 128), (unsigned)__builtin_amdgcn_readfirstlane(kdst + (slot))); \
        glds16s(voffV_, (const char*)Vh + (size_t)jt_ * ((PROJ_PAD ? 68 : 64) * 128), (unsigned)__builtin_amdgcn_readfirstlane(vdst + (slot))); } while (0)
    const int jtop = 4 * qb + 3, jd = 4 * qb + (wid >> 1), qrel = 32 * (wid & 1) + r32;
    if (lane == 0) { flags[wid] = 0u; flags[8 + wid] = 0u; }
    bf16x8 qr[4];
    { const bf16_t* Qp = Qh + (size_t)prow(q0 + wid * 32 + r32) * 64;
#pragma unroll
      for (int d0 = 0; d0 < 4; ++d0) qr[d0] = *(const bf16x8*)(Qp + d0 * 16 + hi * 8); }
    const lds_ptr qst = shm + LDS_OST + wid * 4096 + lane * 16;
#pragma unroll
    for (int d0 = 0; d0 < 4; ++d0) *(ATT_LAS bf16x8*)(qst + d0 * 1024) = qr[d0];
    asm volatile("" ::: "memory");
#pragma unroll
    for (int i = 0; i < 6; ++i) SB_DMA(jtop - i, ((jtop - i + 6000) % 6) * SLOTB);
    f32x16 o[2]; o[0] = f32x16{}; o[1] = f32x16{}; const f32x16 zero = f32x16{};
    float Rsum = 0.f; bool dead = false;
    for (int s = 0;; ++s) {
        const int jt = jd - s;
        if (s == 0) ATT_WAIT_BAR(4); else ATT_WAIT_BAR(2);
        if (s > 0) { const int fb = ((s - 1) & 1) * 8; unsigned all = 1u;
#pragma unroll
            for (int w = 0; w < 8; ++w) all &= flags[fb + w];
            if (all) break; }
        if (s > 0) SB_DMA(jtop - s - 5, ((jtop - s + 1 + 6000) % 6) * SLOTB);
        if (jt >= 0 && !dead) {
            const int slot = ((jt + 6000) % 6) * SLOTB;
            f32x16 p0, p1; bf16x8 pa0, pa1, pa2, pa3;
            { bf16x8 qf[4];
#pragma unroll
              for (int d0 = 0; d0 < 4; ++d0) qf[d0] = *(const ATT_LAS bf16x8*)(qst + d0 * 1024);
              qkt(p0, p1, ks0 + slot, koff, qf, zero); }
            __builtin_amdgcn_sched_barrier(0);
            if (s == 0) sb_tile<true>(p0, p1, Rsum, qrel, hi, pa0, pa1, pa2, pa3); else sb_tile<false>(p0, p1, Rsum, qrel, hi, pa0, pa1, pa2, pa3);
            __builtin_amdgcn_sched_barrier(0);
            pv(o, vp0 + slot, pa0, pa1, pa2, pa3);
            if (EARLY) dead = __all(Rsum > SB_DEAD);
        }
        const bool fin = dead || (jt <= 0);
        if (lane == 0) flags[(s & 1) * 8 + wid] = fin ? 1u : 0u;
    }
#undef SB_DMA
    asm volatile("s_waitcnt vmcnt(0)" ::: "memory");
    { const int l2 = lx_lane();
      u32x4 sv[4]; ot_rows(o, shm + LDS_OST + wid * 4096, l2 & 31, l2 >> 5, l2, sv);
      const bf16_t* Gh = A.proj + (size_t)(T_GA + h) * TSTRIDE; bf16_t* Mw = A.mix + (size_t)(q0 + wid * 32) * 1024 + h * 64;
#pragma unroll
      for (int i = 0; i < 4; ++i) { const int row = i * 8 + (l2 >> 3), chn = l2 & 7; const u32x4 gv = *(const u32x4*)(Gh + (size_t)prow(q0 + wid * 32 + row) * 64 + chn * 8);
          u32x4 w;
#pragma unroll
          for (int k = 0; k < 4; ++k) { const float lo = __uint_as_float(sv[i][k] << 16) * __uint_as_float(gv[k] << 16), hi2 = __uint_as_float(sv[i][k] & 0xffff0000u) * __uint_as_float(gv[k] & 0xffff0000u); w[k] = cvtpk_s(lo, hi2); }
          *(u32x4*)(Mw + (size_t)row * 1024 + chn * 8) = w; } }
    ATT_BAR_L();
}

struct DilArgs { const bf16_t* proj; bf16_t* o1; bf16_t* mix; float* lp; unsigned* gcnt; const float* qg; const float* kg; };
template <int DUMMY = 0> __device__ __forceinline__ void dil_phase(int v, int G, const DilArgs& A, lds_ptr shm, int wave) {
    int wid = wave; asm volatile("" : "+s"(wid)); const int tid = lx_tid(wid);
    const int lane = tid & 63, r32 = lane & 31, hi = lane >> 5;
    const unsigned lds0 = (unsigned)(size_t)shm;
    ATT_LAS float* wsf = (ATT_LAS float*)(shm + LDS_WS) + wid * 64;
    const unsigned kdst0 = lds0 + LDS_K + wid * 1024, vdst = lds0 + LDS_V + wid * 1024;
    const lds_cptr ks00 = (lds_cptr)shm + LDS_K; int koff[4];
#pragma unroll
    for (int d0 = 0; d0 < 4; ++d0) koff[d0] = r32 * 128 + (((2 * d0 + hi) ^ ((r32 >> 1) & 7)) << 4);
    const lds_cptr vp0 = (lds_cptr)shm + LDS_V + ((lane >> 4) & 1) * 32 + (lane & 3) * 8 + (4 * hi + ((lane & 15) >> 2)) * 64;
    const int kkey = 8 * wid + (lane >> 3), kch = ((lane & 7) ^ ((kkey >> 1) & 7)) * 8, vkey = 16 * (wid & 3) + (lane >> 2), vch = (wid >> 2) * 32 + (lane & 3) * 8;
    float gq = __builtin_fabsf(A.qg[lane]), gk = __builtin_fabsf(A.kg[lane]);
    gq = lx_wave_max(gq); gk = lx_wave_max(gk);
    const float Mb = 64.0f * 0.125f * 1.4426950408889634f * 1.02f * gq * gk;
    f32x16 negm;
#pragma unroll
    for (int r = 0; r < 16; ++r) negm[r] = -Mb;
    const __amdgpu_buffer_rsrc_t o1_rsrc = __builtin_amdgcn_make_buffer_rsrc((void*)A.o1, 0, SEQ * 768 * 2, 0x00020000);
    const __amdgpu_buffer_rsrc_t mix_rsrc = __builtin_amdgcn_make_buffer_rsrc((void*)A.mix, 0, SEQ * 1024 * 2, 0x00020000);
#define DIL_DECODE(k, H, P, C, BLK) const int q_##H = 3 * (v >> 5) + (k) / 3, H = q_##H >> 1, P = (k) % 3, C = (v & 31) >> (5 - 2 * P), BLK = (q_##H & 1) * (32 >> (2 * P)) + ((v & 31) & ((32 >> (2 * P)) - 1))
#define DIL_ISSUE_K(H, P, C, BLK, KB) do { const int rsh_ = 2 * P; const unsigned kdst = kdst0 + (KB) * (LDS_K2 - LDS_K); const unsigned vo_ = (unsigned)((prow(C + (kkey << rsh_)) * 64 + kch) * 2); \
        const char* kb_ = (const char*)(A.proj + (size_t)(T_KD + H) * TSTRIDE) + (long)((BLK * 256 - 128) << rsh_) * (PROJ_PAD ? 136 : 128); \
        _Pragma("unroll") for (int j = 0; j < 6; ++j) glds16s(vo_, kb_ + (long)((64 * j) << rsh_) * (PROJ_PAD ? 136 : 128), (unsigned)__builtin_amdgcn_readfirstlane(kdst + j * SLOTB)); } while (0)
#define DIL_ISSUE_V(H, P, C, BLK) do { const int rsh_ = 2 * P; const unsigned vo_ = (unsigned)((prow(C + (vkey << rsh_)) * 64 + vch) * 2); \
        const char* vb_ = (const char*)(A.proj + (size_t)(T_VD + H) * TSTRIDE) + (long)((BLK * 256 - 128) << rsh_) * (PROJ_PAD ? 136 : 128); \
        _Pragma("unroll") for (int j = 0; j < 6; ++j) glds16s(vo_, vb_ + (long)((64 * j) << rsh_) * (PROJ_PAD ? 136 : 128), (unsigned)__builtin_amdgcn_readfirstlane(vdst + j * SLOTB)); } while (0)
#define DIL_LOADQ(QR, H, P, C, BLK) do { const bf16_t* Qp_ = A.proj + (size_t)(T_QD + H) * TSTRIDE + (size_t)prow(C + ((BLK * 256 + wid * 32 + r32) << (2 * P))) * 64; \
        _Pragma("unroll") for (int d0 = 0; d0 < 4; ++d0) QR[d0] = *(const bf16x8*)(Qp_ + d0 * 16 + hi * 8); } while (0)
    if (G != 256) return;
    bf16x8 qr[4];
    { DIL_DECODE(0, h0, p0_, c0, b0); DIL_ISSUE_K(h0, p0_, c0, b0, 0); DIL_LOADQ(qr, h0, p0_, c0, b0); DIL_ISSUE_V(h0, p0_, c0, b0); }
    for (int k = 0; k < 9; ++k) {
        DIL_DECODE(k, h, p, c, blk);
        const int rsh = 2 * p, u0 = blk * 256;
        if (k == 0) asm volatile("s_waitcnt vmcnt(6) lgkmcnt(0)\n\ts_barrier" ::: "memory"); else asm volatile("s_waitcnt vmcnt(11) lgkmcnt(0)\n\ts_barrier" ::: "memory");
        const int kb = k & 1; const lds_cptr ks0 = ks00 + kb * (LDS_K2 - LDS_K);
        if (k + 1 < 9) { DIL_DECODE(k + 1, hn, pn, cn, bn); DIL_ISSUE_K(hn, pn, cn, bn, kb ^ 1); }
        unsigned pw[5][8]; float l_reg = 0.f;
#pragma unroll
        for (int hh = 0; hh < 5; ++hh) {
            const int ht = wid + hh;
#pragma unroll
            for (int e = 0; e < 8; ++e) pw[hh][e] = 0u;
            if (blk == 0 && ht < 4) continue;
            const lds_cptr ks = ks0 + (ht >> 1) * SLOTB + (ht & 1) * 4096;
            f32x16 s;
#pragma unroll
            for (int d0 = 0; d0 < 4; ++d0) { const bf16x8 b = *(const ATT_LAS bf16x8*)(ks + koff[d0]); s = __builtin_amdgcn_mfma_f32_32x32x16_bf16(b, qr[d0], d0 == 0 ? negm : s, 0, 0, 0); }
#pragma unroll
            for (int g = 0; g < 4; ++g) { float a[4];
#pragma unroll
                for (int e = 0; e < 4; ++e) { float vv = __builtin_amdgcn_exp2f(s[4 * g + e]);
                    const int dd = 8 * g + 4 * hi + e - r32;
                    if (hh == 0) { if (dd < 0) vv = 0.f; } else if (hh == 4) { if (dd > 0) vv = 0.f; }
                    a[e] = vv; l_reg += vv; }
                pw[hh][2 * g] = cvtpk_s(a[0], a[1]); pw[hh][2 * g + 1] = cvtpk_s(a[2], a[3]); }
        }
        l_reg = lx_sum32(l_reg);
        unsigned* const gc = A.gcnt + (3 * (v >> 5) + k / 3) * 64;
        if (p == 2 && wid == 0) {
            unsigned spins = 0u;
            while (__hip_atomic_load(gc, __ATOMIC_RELAXED, __HIP_MEMORY_SCOPE_AGENT) < 32u) { __builtin_amdgcn_s_sleep(2); if (++spins > (1u << 22)) break; }
            __builtin_amdgcn_fence(__ATOMIC_ACQUIRE, "agent"); asm volatile("s_waitcnt vmcnt(0)" ::: "memory"); }
        if (k == 8) asm volatile("s_waitcnt vmcnt(0) lgkmcnt(0)\n\ts_barrier" ::: "memory");
        else if (k % 3 == 1) asm volatile("s_waitcnt vmcnt(11) lgkmcnt(0)\n\ts_barrier" ::: "memory"); else asm volatile("s_waitcnt vmcnt(6) lgkmcnt(0)\n\ts_barrier" ::: "memory");
        u32x4 a0[4], a1[4], gvv[4]; float lsum = 0.f;
        if (p == 2) { const bf16_t* Gh = A.proj + (size_t)(T_GD + h) * TSTRIDE;
#pragma unroll
            for (int i = 0; i < 4; ++i) { const int t = c + ((u0 + wid * 32 + i * 8 + (lane >> 3)) << rsh);
                a0[i] = *(const u32x4*)(A.o1 + (size_t)t * 768 + h * 64 + (lane & 7) * 8); a1[i] = *(const u32x4*)(A.mix + (size_t)t * 1024 + 256 + h * 64 + (lane & 7) * 8);
                gvv[i] = *(const u32x4*)(Gh + (size_t)prow(t) * 64 + (lane & 7) * 8); }
            const int tq0 = c + ((u0 + wid * 32 + r32) << rsh); lsum = A.lp[((size_t)0 * SEQ + tq0) * 12 + h] + A.lp[((size_t)1 * SEQ + tq0) * 12 + h]; }
        if (k + 1 < 9) { DIL_DECODE(k + 1, hn, pn, cn, bn); DIL_LOADQ(qr, hn, pn, cn, bn); }
        f32x16 o[2];
        o[0] = f32x16{}; o[1] = f32x16{};
#pragma unroll
        for (int hh = 0; hh < 5; ++hh) {
            const int ht = wid + hh;
            if (blk == 0 && ht < 4) continue;
            const lds_cptr vp = vp0 + (ht >> 1) * SLOTB + (ht & 1) * 2048;
            const bf16x8 pa0 = __builtin_bit_cast(bf16x8, (u32x4){pw[hh][0], pw[hh][1], pw[hh][2], pw[hh][3]}), pa1 = __builtin_bit_cast(bf16x8, (u32x4){pw[hh][4], pw[hh][5], pw[hh][6], pw[hh][7]});
#pragma unroll
            for (int d0 = 0; d0 < 2; ++d0) { const s16x4 l0 = vtr(vp + d0 * 4096), h0_ = vtr(vp + d0 * 4096 + 512), l1 = vtr(vp + d0 * 4096 + 1024), h1_ = vtr(vp + d0 * 4096 + 1536);
                o[d0] = __builtin_amdgcn_mfma_f32_32x32x16_bf16((bf16x8){l0[0], l0[1], l0[2], l0[3], h0_[0], h0_[1], h0_[2], h0_[3]}, pa0, o[d0], 0, 0, 0);
                o[d0] = __builtin_amdgcn_mfma_f32_32x32x16_bf16((bf16x8){l1[0], l1[1], l1[2], l1[3], h1_[0], h1_[1], h1_[2], h1_[3]}, pa1, o[d0], 0, 0, 0); }
        }
        ATT_BAR_L();
        if (p == 0 && k + 1 < 9) { DIL_DECODE(k + 1, hn, pn, cn, bn); DIL_ISSUE_V(hn, pn, cn, bn); }
        { const int tq = c + ((u0 + wid * 32 + r32) << rsh);
          if (p == 2 && hi == 0) wsf[r32] = __builtin_amdgcn_rcpf(lsum + l_reg);
          u32x4 sv[4]; ot_rows(o, shm + LDS_K + kb * (LDS_K2 - LDS_K) + wid * 4096, r32, hi, lane, sv);
          asm volatile("" ::: "memory");
          if (p != 2) {
#pragma unroll
              for (int i = 0; i < 4; ++i) { const int t = c + ((u0 + wid * 32 + i * 8 + (lane >> 3)) << rsh);
                  if (p == 0) __builtin_amdgcn_raw_buffer_store_b128(sv[i], o1_rsrc, (unsigned)((t * 768 + h * 64 + (lane & 7) * 8) * 2), 0, 16);
                  else __builtin_amdgcn_raw_buffer_store_b128(sv[i], mix_rsrc, (unsigned)((t * 1024 + 256 + h * 64 + (lane & 7) * 8) * 2), 0, 16); }
              if (hi == 0) __hip_atomic_store((unsigned*)(A.lp + ((size_t)p * SEQ + tq) * 12 + h), __float_as_uint(l_reg), __ATOMIC_RELAXED, __HIP_MEMORY_SCOPE_AGENT);
              asm volatile("" ::: "memory");
              if (p == 1) {
                  asm volatile("s_waitcnt vmcnt(0) lgkmcnt(0)\n\ts_barrier" ::: "memory");
                  if (tid == 0) __hip_atomic_fetch_add(gc, 1u, __ATOMIC_RELAXED, __HIP_MEMORY_SCOPE_AGENT);
                  if (k + 1 < 9) { DIL_DECODE(k + 1, hn, pn, cn, bn); DIL_ISSUE_V(hn, pn, cn, bn); }
              }
          } else {
              float inv[4];
#pragma unroll
              for (int i = 0; i < 4; ++i) inv[i] = wsf[i * 8 + (lane >> 3)];
#pragma unroll
              for (int i = 0; i < 4; ++i) { u32x4 w;
#pragma unroll
                  for (int e = 0; e < 4; ++e) {
                      const float lo = (__uint_as_float(a0[i][e] << 16) + __uint_as_float(a1[i][e] << 16) + __uint_as_float(sv[i][e] << 16)) * inv[i] * __uint_as_float(gvv[i][e] << 16);
                      const float hi2 = (__uint_as_float(a0[i][e] & 0xffff0000u) + __uint_as_float(a1[i][e] & 0xffff0000u) + __uint_as_float(sv[i][e] & 0xffff0000u)) * inv[i] * __uint_as_float(gvv[i][e] & 0xffff0000u);
                      w[e] = cvtpk_s(lo, hi2); }
                  sv[i] = w; }
              asm volatile("" ::: "memory");
#pragma unroll
              for (int i = 0; i < 4; ++i) { const int t = c + ((u0 + wid * 32 + i * 8 + (lane >> 3)) << rsh); *(u32x4*)(A.mix + (size_t)t * 1024 + 256 + h * 64 + (lane & 7) * 8) = sv[i]; }
              if (hi == 0) A.lp[((size_t)2 * SEQ + tq) * 12 + h] = l_reg;
              asm volatile("" ::: "memory");
              if (k + 1 < 9) { DIL_DECODE(k + 1, hn, pn, cn, bn); DIL_ISSUE_V(hn, pn, cn, bn); }
          } }
    }
#undef DIL_DECODE
#undef DIL_ISSUE_K
#undef DIL_ISSUE_V
#undef DIL_LOADQ
    ATT_BAR_L();
}
#undef ATT_WAIT_BAR
#undef ATT_BAR_L
}
constexpr int NWAVES = 8;
constexpr int N_LAUNCHES = MK_N_LAUNCHES;
constexpr int DEPTH = 4, SEQ = 16384, DM = 1024, NIN = 4096;
constexpr int N_PHASES = 1 + 3 * DEPTH;
constexpr size_t MiB = 1u << 20;
constexpr size_t WS_CTL = 0, CTL_ZERO_BYTES = 128 * 1024;
constexpr size_t WS_ROPE = 1 * MiB;
constexpr size_t WS_SSQ = 2 * MiB;
constexpr size_t WS_LP = 3 * MiB;
constexpr size_t WS_W = 6 * MiB, W_STRIDE = 10 * MiB, W_OUT_OFF = 8 * MiB;
constexpr size_t WS_XB = 46 * MiB;
constexpr size_t WS_MIX = 78 * MiB;
constexpr size_t WS_PROJ = 110 * MiB;
constexpr size_t WS_END = 246 * MiB;
constexpr int CW_BAR = 4096;
static_assert((16384 + 4 * 8 * 3 * 64) * 4 <= 128 * 1024, "control words inside the memset region");
constexpr int CW_GRP = 16384;
constexpr int RING_OFF = 0, RING_BYTES = 131072;
constexpr int LDSCTL_OFF = 151552, MISC_OFF = LDSCTL_OFF + 320;
constexpr int LDS_BYTES = 153600;
static_assert(att::LDS_END <= LDSCTL_OFF && RING_BYTES <= LDSCTL_OFF, "phase scratch below the control words");

#define GAS __attribute__((address_space(1)))
#define LAS __attribute__((address_space(3)))
typedef unsigned short bf16;
typedef unsigned v4u __attribute__((ext_vector_type(4)));
typedef float f32x4 __attribute__((ext_vector_type(4)));
typedef GAS unsigned gu32;
#define RLX_AGENT __ATOMIC_RELAXED, __HIP_MEMORY_SCOPE_AGENT
#define LDS_WAIT() asm volatile("s_waitcnt lgkmcnt(0)" ::: "memory")
#define VM_WAIT() asm volatile("s_waitcnt vmcnt(0)" ::: "memory")
__device__ __forceinline__ unsigned f2bf(float f) { unsigned u = __builtin_bit_cast(unsigned, f); return (u + 0x7fffu + ((u >> 16) & 1u)) >> 16; }
__device__ __forceinline__ unsigned pk2(float lo, float hi) { return f2bf(lo) | (f2bf(hi) << 16); }
#define XB_TMO      128
#define XB_XCNT(j)  (256  + 64 * (j))
#define XB_XSUB(j)  (1280 + 64 * (j))
#define XB_XGEN(j)  (2304 + 64 * (j))
#define XB_TOP      3328
#define XB_TOPGEN   3392
#define XCD_BAR_WORDS 3456
#define XB_SPIN_CAP (1u << 18)

__device__ __forceinline__ unsigned xb_ld(unsigned* p)              { return __hip_atomic_load(p, __ATOMIC_RELAXED, __HIP_MEMORY_SCOPE_AGENT); }
__device__ __forceinline__ unsigned xb_add(unsigned* p, unsigned v) { return __hip_atomic_fetch_add(p, v, __ATOMIC_RELAXED, __HIP_MEMORY_SCOPE_AGENT); }
__device__ __forceinline__ unsigned xb_xcc_id() { return (unsigned)__builtin_amdgcn_s_getreg((3 << 11) | 20) & 0xFu; }
#define XB_SPIN(cond, bar) do { unsigned _sp = 0; while (cond) { __builtin_amdgcn_s_sleep(1); \
    if ((++_sp & 255u) == 0u) { if (xb_ld(&(bar)[XB_TMO])) break; if (_sp > XB_SPIN_CAP) { atomicAdd(&(bar)[XB_TMO], 1u); break; } } } } while (0)

struct XcdBarrier {
    unsigned* bar; unsigned x;
    volatile LAS unsigned* st;
};

__device__ __forceinline__ XcdBarrier xcd_barrier_post(unsigned* bar, volatile LAS unsigned* st, bool leader) {
    XcdBarrier b; b.bar = bar; b.x = xb_xcc_id(); b.st = st;
    if (leader) (void)xb_add(&bar[XB_XCNT(b.x)], 1u);
    return b;
}
__device__ __forceinline__ void xcd_barrier_complete(unsigned* bar, unsigned x, unsigned& nloc, unsigned& nx) {
    const unsigned G = gridDim.x * gridDim.y * gridDim.z;
    unsigned sum, cnt, mine, sp = 0u;
    for (;;) {
        sum = 0u; cnt = 0u; mine = 0u;
#pragma unroll
        for (unsigned j = 0; j < 16; ++j) { const unsigned c = xb_ld(&bar[XB_XCNT(j)]); sum += c; cnt += (c > 0u) ? 1u : 0u; mine = (j == x) ? c : mine; }
        if (sum == G) break;
        __builtin_amdgcn_s_sleep(1);
        if ((++sp & 255u) == 0u) { if (xb_ld(&bar[XB_TMO])) break; if (sp > XB_SPIN_CAP) { atomicAdd(&bar[XB_TMO], 1u); break; } }
    }
    nloc = mine > 0u ? mine : 1u; nx = cnt > 0u ? cnt : 1u;
}

__device__ __forceinline__ void xcd_barrier(const XcdBarrier& b, bool leader) {
    asm volatile("s_waitcnt vmcnt(0)" ::: "memory");
    __syncthreads();
    if (leader) {
        unsigned* bar = b.bar;
        __builtin_amdgcn_s_waitcnt(0);
        unsigned nloc = b.st[0], nx = b.st[1];
        if (nloc == 0u) { xcd_barrier_complete(bar, b.x, nloc, nx); b.st[0] = nloc; b.st[1] = nx; }
        const unsigned old = xb_add(&bar[XB_XSUB(b.x)], 1u);
        const unsigned gen = old / nloc;
        if (old + 1u == (gen + 1u) * nloc) {
            __builtin_amdgcn_fence(__ATOMIC_RELEASE, "agent");
            asm volatile("s_waitcnt vmcnt(0)" ::: "memory");
            const unsigned og = xb_add(&bar[XB_TOP], 1u);
            const unsigned tg = og / nx;
            if (og + 1u == (tg + 1u) * nx) xb_add(&bar[XB_TOPGEN], 1u);
            else XB_SPIN(xb_ld(&bar[XB_TOPGEN]) == tg, bar);
            __builtin_amdgcn_fence(__ATOMIC_ACQUIRE, "agent");
            xb_add(&bar[XB_XGEN(b.x)], 1u);
            asm volatile("s_waitcnt vmcnt(0)" ::: "memory");
        } else {
            XB_SPIN(xb_ld(&bar[XB_XGEN(b.x)]) == gen, bar);
            __builtin_amdgcn_fence(__ATOMIC_ACQUIRE, "agent");
            asm volatile("s_waitcnt vmcnt(0)" ::: "memory");
        }
    }
    __syncthreads();
}
__device__ __forceinline__ float wave_sum(float v) {
    return lx_wave_sum(v);
}
template <bool PERMN> __device__ __forceinline__ void transpose_item(const float* W, int K, int N, bf16* WT, const float* gk, LAS float* scr, int item, int lane) {
    const int nblk = N / 32, kb = item / nblk, nb = item % nblk, k0 = 64 * kb, n0 = 32 * nb;
    float wv[32];
#pragma unroll
    for (int i = 0; i < 32; ++i) wv[i] = W[(size_t)(k0 + 2 * i + (lane >> 5)) * N + n0 + (lane & 31)];
    if (gk) {
#pragma unroll
        for (int i = 0; i < 32; ++i) wv[i] *= gk[k0 + 2 * i + (lane >> 5)]; }
#pragma unroll
    for (int i = 0; i < 32; ++i) scr[(2 * i + (lane >> 5)) * 33 + (lane & 31)] = wv[i];
    LDS_WAIT(); asm volatile("" ::: "memory");
    const int c = lane & 7;
#pragma unroll
    for (int j = 0; j < 4; ++j) { const int n = (lane >> 3) + 8 * j; const LAS float* s = scr + (8 * c) * 33 + n;
        v4u o; o.x = pk2(s[0 * 33], s[1 * 33]); o.y = pk2(s[2 * 33], s[3 * 33]); o.z = pk2(s[4 * 33], s[5 * 33]); o.w = pk2(s[6 * 33], s[7 * 33]);
        const int col = n0 + n; const int pos = PERMN ? ((col & ~255) + 128 * ((col >> 5) & 1) + 32 * ((col >> 6) & 3) + (col & 31)) : col;
        *(GAS v4u*)(WT + (size_t)pos * K + k0 + 8 * c) = o; }
    LDS_WAIT(); asm volatile("" ::: "memory");
}
struct KArgs { const float* x; const float* norm_g; const float* w_in; const float* q_norm_g; const float* k_norm_g; const float* w_out; float* out; unsigned char* ws; int ph_lo, ph_hi; };

__device__ __forceinline__ void convert_weights(const KArgs& a, int l, LAS unsigned char* lds, int vcu, int G, int wave0) {
    const int wave = wave0; const int tid = lx_tid(wave); const int lane = tid & 63; const int gw = vcu * NWAVES + wave, NGW = G * NWAVES;
    LAS float* scr = (LAS float*)(lds + RING_OFF + wave * 16384);
    bf16* WinT = (bf16*)(a.ws + WS_W + (size_t)l * W_STRIDE); bf16* WoutT = (bf16*)(a.ws + WS_W + (size_t)l * W_STRIDE + W_OUT_OFF);
    constexpr int I_IN = (DM / 64) * (NIN / 32), I_OUT = (DM / 64) * (DM / 32);
    for (int it = gw; it < I_IN + I_OUT; it += NGW) {
        if (it < I_IN) transpose_item<true>(a.w_in + (size_t)l * DM * NIN, DM, NIN, WinT, a.norm_g + l * DM, scr, it, lane);
        else transpose_item<false>(a.w_out + (size_t)l * DM * DM, DM, DM, WoutT, nullptr, scr, it - I_IN, lane);
    }
}
__device__ __forceinline__ void sincos_acc(float angf, float& c, float& s) {
    const double ang = (double)angf; const double kq = __builtin_rint(ang * 0.63661977236758134308);
    const double r = __builtin_fma(-kq, 1.5707963267948966192, ang) - kq * 6.123233995736766036e-17; const double r2 = r * r;
    double sp = -1.0 / 1307674368000.0; sp = sp * r2 + 1.0 / 6227020800.0; sp = sp * r2 - 1.0 / 39916800.0; sp = sp * r2 + 1.0 / 362880.0; sp = sp * r2 - 1.0 / 5040.0; sp = sp * r2 + 1.0 / 120.0; sp = sp * r2 - 1.0 / 6.0; sp = sp * r2 * r + r;
    double cp = 1.0 / 87178291200.0; cp = cp * r2 - 1.0 / 479001600.0; cp = cp * r2 + 1.0 / 3628800.0; cp = cp * r2 - 1.0 / 40320.0; cp = cp * r2 + 1.0 / 720.0; cp = cp * r2 - 1.0 / 24.0; cp = cp * r2 + 0.5; cp = 1.0 - cp * r2;
    const int q = ((int)kq) & 3;
    const double sv = (q == 0) ? sp : (q == 1) ? cp : (q == 2) ? -sp : -cp, cv = (q == 0) ? cp : (q == 1) ? -sp : (q == 2) ? -cp : sp;
    c = (float)cv; s = (float)sv;
}
__device__ __forceinline__ float inv_freq(int i) {
    return i == 0 ? 1.0f : i == 1 ? 0.193922758102417f : i == 2 ? 0.03760603070259094f : i == 3 ? 0.00729266507551074f : i == 4 ? 0.001414213445968926f : i == 5 ? 0.00027424818836152554f : i == 6 ? 5.318296462064609e-05f : 1.0313385246263351e-05f;
}

__global__ void __launch_bounds__(NWAVES * 64, 2) hsdg_fwd(KArgs args) {
    extern __shared__ __attribute__((aligned(16))) unsigned char lds_raw[];
    LAS unsigned char* lds = (LAS unsigned char*)lds_raw;
    volatile LAS unsigned* MISC = (volatile LAS unsigned*)(lds + MISC_OFF);
    const int wave0 = __builtin_amdgcn_readfirstlane((int)threadIdx.x >> 6); const int tid0 = lx_tid(wave0);
    const int G = gridDim.x; const int bx = blockIdx.x; const int vcu = (G % 8 == 0) ? (bx % 8) * (G / 8) + bx / 8 : bx;
    unsigned char* ws = args.ws;
    gu32* ctl = (gu32*)(ws + WS_CTL);
    for (int u = tid0; u < (LDS_BYTES - LDSCTL_OFF) / 4; u += NWAVES * 64) ((LAS unsigned*)(lds + LDSCTL_OFF))[u] = 0u;
    __syncthreads();
    XcdBarrier bar; bar.bar = (unsigned*)(ctl + CW_BAR); bar.x = 0; bar.st = nullptr;
    if (N_LAUNCHES == 1) bar = xcd_barrier_post((unsigned*)(ctl + CW_BAR), MISC + 8, tid0 == 0);
#define GRID_BAR() do { if (N_LAUNCHES == 1) xcd_barrier(bar, lx_tid(wave0) == 0); } while (0)
    const int lo = args.ph_lo, hi = args.ph_hi;
#define IN(k) (lo <= (k) && (k) < hi)
#define BOTH(k) (IN(k) && IN((k) + 1))
#define PHASE_PTRS() unsigned char* wsp = ws; asm volatile("" : "+s"(wsp)); float* rope = (float*)(wsp + WS_ROPE); float* ssq = (float*)(wsp + WS_SSQ); float* lp = (float*)(wsp + WS_LP); \
        bf16* XB = (bf16*)(wsp + WS_XB); bf16* MIX = (bf16*)(wsp + WS_MIX); bf16* PROJ = (bf16*)(wsp + WS_PROJ); (void)rope; (void)ssq; (void)lp; (void)XB; (void)MIX; (void)PROJ

    if (IN(0)) {
        PHASE_PTRS(); for (int l = 0; l < DEPTH; ++l) convert_weights(args, l, lds, vcu, G, wave0);
        const int wave = wave0; const int tid = lx_tid(wave); const int lane = tid & 63; const int gw = vcu * NWAVES + wave, NGW = G * NWAVES;
        for (int m = gw; m < SEQ; m += 4 * NGW) {
            f32x4 v[4][4]; float s2[4];
#pragma unroll
            for (int q = 0; q < 4; ++q) { const int mm = m + q * NGW; const GAS f32x4* xr = (const GAS f32x4*)(args.x + (size_t)(mm < SEQ ? mm : m) * DM) + lane;
#pragma unroll
                for (int j = 0; j < 4; ++j) v[q][j] = xr[64 * j]; }
#pragma unroll
            for (int q = 0; q < 4; ++q) { float a = 0.f;
#pragma unroll
                for (int j = 0; j < 4; ++j) a += (v[q][j].x * v[q][j].x + v[q][j].y * v[q][j].y) + (v[q][j].z * v[q][j].z + v[q][j].w * v[q][j].w);
                s2[q] = wave_sum(a); }
#pragma unroll
            for (int q = 0; q < 4; ++q) { const int mm = m + q * NGW; if (mm < SEQ) {
                GAS unsigned long long* o8 = (GAS unsigned long long*)(XB + (size_t)mm * DM) + lane;
#pragma unroll
                for (int j = 0; j < 4; ++j) o8[64 * j] = (unsigned long long)pk2(v[q][j].x, v[q][j].y) | ((unsigned long long)pk2(v[q][j].z, v[q][j].w) << 32);
                if (lane < 4) ssq[(size_t)mm * 4 + lane] = (lane == 0) ? s2[q] : 0.f; } }
        }
        for (int i = bx * (NWAVES * 64) + tid; i < SEQ * 8; i += G * NWAVES * 64) { const int pos = i >> 3, k = i & 7; float c, s; sincos_acc((float)pos * inv_freq(k), c, s); rope[pos * 16 + k] = c; rope[pos * 16 + 8 + k] = s; }
        if (BOTH(0)) GRID_BAR();
    }
    for (int l = 0; l < DEPTH; ++l) {
        const int pA = 1 + 3 * l, pB = pA + 1, pC = pA + 2;
        if (IN(pA)) {
            PHASE_PTRS(); bf16* WinT = (bf16*)(wsp + WS_W + (size_t)l * W_STRIDE); const float* qg = args.q_norm_g + l * 64; const float* kg = args.k_norm_g + l * 64;
            pg8::Gemm g{XB, WinT, SEQ, NIN, DM}; pg8::StaticOrder S; S.init(SEQ, NIN, G, bx);
            { static_assert(pg8::EpiInProj::OFF_ROPE == WS_ROPE && pg8::EpiInProj::OFF_SSQ == WS_SSQ && pg8::EpiInProj::OFF_P == WS_PROJ, "workspace offsets"); pg8::EpiInProj E{wsp, qg, kg};
            pg8::gemm_phase<pg8::EpiInProj, pg8::StaticOrder, true, true>(lds + RING_OFF, g, S, E, wave0); }
            if (BOTH(pA)) GRID_BAR();
        }
        if (IN(pB)) {
            PHASE_PTRS(); const float* qg = args.q_norm_g + l * 64; const float* kg = args.k_norm_g + l * 64; gu32* ctlp = (gu32*)(wsp + WS_CTL);
            const att::SbArgs SA{PROJ, MIX};
            const att::DilArgs DA{PROJ, XB, MIX, lp, (unsigned*)(ctlp + CW_GRP + l * 8 * 3 * 64), qg, kg};
            for (int u = vcu; u < 256; u += G) att::sb_unit<SB_EARLY_EXIT != 0>(u >> 6, u & 63, SA, (att::lds_ptr)(lds + RING_OFF), wave0);
            att::dil_phase<0>(vcu, G, DA, (att::lds_ptr)(lds + RING_OFF), wave0);
            if (BOTH(pB)) GRID_BAR();
        }
        if (IN(pC)) {
            PHASE_PTRS(); bf16* WoutT = (bf16*)(wsp + WS_W + (size_t)l * W_STRIDE + W_OUT_OFF);
            pg8::Gemm g{MIX, WoutT, SEQ, DM, DM}; pg8::StaticOrder S; S.init(SEQ, DM, G, bx);
            pg8::EpiOutProj E{l == 0 ? args.x : args.out, args.out, XB, ssq, l == DEPTH - 1 ? 1 : 0};
            pg8::gemm_phase<pg8::EpiOutProj, pg8::StaticOrder, false, true>(lds + RING_OFF, g, S, E, wave0);
            if (pC + 1 < N_PHASES && BOTH(pC)) GRID_BAR();
        }
    }
#undef IN
#undef BOTH
#undef GRID_BAR
}

extern "C" void kernel_launch(void* const* d_in, const int* in_sizes, int n_in, void* d_out, int out_size, void* d_ws, size_t ws_size, hipStream_t stream) {
    static int grid = 0;
    if (grid == 0) {
        if (n_in != 6 || in_sizes[0] != SEQ * DM || out_size != SEQ * DM || ws_size < WS_END) { fprintf(stderr, "kernel_launch: unexpected shapes / workspace (n_in %d, in0 %d, out %d, ws %zu, need %zu)\n", n_in, n_in > 0 ? in_sizes[0] : -1, out_size, ws_size, (size_t)WS_END); grid = -1; return; }
        int dev = 0, cus = 0, per_cu = 0;
        if (hipGetDevice(&dev) != hipSuccess || hipDeviceGetAttribute(&cus, hipDeviceAttributeMultiprocessorCount, dev) != hipSuccess) { fprintf(stderr, "kernel_launch: device query failed\n"); grid = -1; return; }
        if (hipFuncSetAttribute((const void*)hsdg_fwd, hipFuncAttributeMaxDynamicSharedMemorySize, LDS_BYTES) != hipSuccess) { fprintf(stderr, "kernel_launch: hipFuncSetAttribute failed\n"); grid = -1; return; }
        if (hipOccupancyMaxActiveBlocksPerMultiprocessor(&per_cu, (const void*)hsdg_fwd, NWAVES * 64, LDS_BYTES) != hipSuccess || per_cu < 1) fprintf(stderr, "kernel_launch: note: occupancy query reports %d workgroups per CU\n", per_cu);
        (void)hipGetLastError();
        grid = cus;
        if (grid != 256) fprintf(stderr, "kernel_launch: %d CUs; the out-proj phase assumes 256 workgroups\n", grid);
    }
    if (grid < 0) return;
    if (hipMemsetAsync((char*)d_ws + WS_CTL, 0, CTL_ZERO_BYTES, stream) != hipSuccess) { fprintf(stderr, "kernel_launch: hipMemsetAsync failed\n"); return; }
    KArgs a{};
    a.x = (const float*)d_in[0]; a.norm_g = (const float*)d_in[1]; a.w_in = (const float*)d_in[2]; a.q_norm_g = (const float*)d_in[3]; a.k_norm_g = (const float*)d_in[4]; a.w_out = (const float*)d_in[5];
    a.out = (float*)d_out; a.ws = (unsigned char*)d_ws;
    if (N_LAUNCHES == 1) { a.ph_lo = 0; a.ph_hi = N_PHASES; hipLaunchKernelGGL(hsdg_fwd, dim3(grid), dim3(NWAVES * 64), LDS_BYTES, stream, a); }
    else for (int ph = 0; ph < N_PHASES; ++ph) { a.ph_lo = ph; a.ph_hi = ph + 1; hipLaunchKernelGGL(hsdg_fwd, dim3(grid), dim3(NWAVES * 64), LDS_BYTES, stream, a); }
    const hipError_t le = hipPeekAtLastError();
    if (le != hipSuccess) fprintf(stderr, "kernel_launch: launch failed: %s\n", hipGetErrorName(le));
}
```

```cpp
#include <hip/hip_runtime.h>
#include <cstdio>
#include <cstdint>
#ifndef MK_N_LAUNCHES
#define MK_N_LAUNCHES 1
#endif
#ifndef PROBE_A
#define PROBE_A 0
#endif
#ifndef PROJ_PAD
#define PROJ_PAD 0
#endif
#ifndef SB_EARLY_EXIT
#define SB_EARLY_EXIT 1
#endif
template <int X> __device__ __forceinline__ float lx_xor(float v) { return __builtin_bit_cast(float, __builtin_amdgcn_ds_swizzle(__builtin_bit_cast(int, v), (X << 10) | 0x1f)); }
__device__ __forceinline__ int lx_lane() { int l; asm volatile("v_mbcnt_lo_u32_b32 %0, -1, 0\n\tv_mbcnt_hi_u32_b32 %0, -1, %0" : "=v"(l)); return l; }
__device__ __forceinline__ float lx_xor32(float v) { return __builtin_bit_cast(float, __builtin_amdgcn_ds_bpermute((lx_lane() ^ 32) << 2, __builtin_bit_cast(int, v))); }
__device__ __forceinline__ float lx_sum32(float v) { return v + lx_xor32(v); }
__device__ __forceinline__ float lx_max32(float v) { return __builtin_fmaxf(v, lx_xor32(v)); }
__device__ __forceinline__ float lx_wave_sum(float v) { v += lx_xor<1>(v); v += lx_xor<2>(v); v += lx_xor<4>(v); v += lx_xor<8>(v); v += lx_xor<16>(v); return lx_sum32(v); }
__device__ __forceinline__ float lx_wave_max(float v) { v = __builtin_fmaxf(v, lx_xor<1>(v)); v = __builtin_fmaxf(v, lx_xor<2>(v)); v = __builtin_fmaxf(v, lx_xor<4>(v)); v = __builtin_fmaxf(v, lx_xor<8>(v)); v = __builtin_fmaxf(v, lx_xor<16>(v)); return lx_max32(v); }
__device__ __forceinline__ int lx_tid(int wave) { return wave * 64 + lx_lane(); }
__device__ __forceinline__ unsigned xs_lo(float x, unsigned hi_shl16) { const unsigned u = (__builtin_bit_cast(unsigned, x) - hi_shl16 + 0x8080u) >> 8; return u < 255u ? u : 255u; }
__device__ __forceinline__ float xs_join(unsigned hi_shl16, unsigned lo8) { return __builtin_bit_cast(float, hi_shl16 + (lo8 << 8) - 0x8000u); }
namespace pg8 {
#define PG8_LAS __attribute__((address_space(3)))
typedef unsigned short bf16_t;
typedef short bf16x8 __attribute__((ext_vector_type(8)));
typedef float f32x4 __attribute__((ext_vector_type(4)));
typedef unsigned u32x4 __attribute__((ext_vector_type(4)));
constexpr int BM = 256, BK = 64, HALF = 128, HTB = HALF * BK * 2  , STAGE_BYTES = 8 * HTB, NXCD = 8, WGM = 8;

__host__ __device__ __forceinline__ int lds_byte(int r, int c) { const int st = (r >> 4) * 2 + (c >> 5), rr = r & 15, cc = c & 31, ob = rr * 64 + cc * 2; return st * 1024 + (ob ^ (((ob >> 9) & 1) << 5)); }
__host__ __device__ __forceinline__ void stage_rc(int b, int& R, int& C) { const int st = b / 1024, sb = b % 1024, swz = sb ^ (((sb >> 9) & 1) << 5); R = (st >> 1) * 16 + swz / 64; C = (st & 1) * 32 + (swz % 64) / 2; }
__host__ __device__ __forceinline__ int perm32(int rho) { const int n = rho >> 4, i = rho & 15; return 8 * (i >> 2) + 4 * n + (i & 3); }

struct Unit { int pm, pn; };
struct Gemm { const bf16_t* A; const bf16_t* Bt; int M, N, K; };

struct StaticOrder {
    int nM, nN, nwg, G, c;
    __host__ __device__ void init(int M, int N, int G_, int c_) { nM = M / BM; nN = N / BM; nwg = nM * nN; G = G_; c = c_; }
    __host__ __device__ bool next(int i, Unit& u) const {
        const long L = (long)i * G + c; if (L >= nwg) return false;
        int wgid = (int)L; { const int q = nwg / NXCD, r = nwg % NXCD, xcd = wgid % NXCD, off = wgid / NXCD; wgid = (xcd < r ? xcd * (q + 1) : r * (q + 1) + (xcd - r) * q) + off; }
        const int nig = WGM * nN, gid = wgid / nig, fm = gid * WGM, gsz = (nM - fm) < WGM ? (nM - fm) : WGM;
        u.pm = fm + ((wgid % nig) % gsz); u.pn = (wgid % nig) / gsz; return true;
    }
    __device__ __forceinline__ void a_ready(const Unit&) const {}
    __device__ __forceinline__ void done(const Unit&) const {}
};

typedef float f32x2 __attribute__((ext_vector_type(2)));
typedef __bf16 bf16x2_t __attribute__((ext_vector_type(2)));
__device__ __forceinline__ unsigned cvtpk(float lo, float hi) { f32x2 v = {lo, hi}; bf16x2_t b = __builtin_convertvector(v, bf16x2_t); return __builtin_bit_cast(unsigned, b); }
constexpr int SEQ = 16384; constexpr int PROWS = SEQ + (PROJ_PAD ? SEQ / 16 : 0); constexpr size_t TSTRIDE = (size_t)PROWS * 64;
constexpr float EPSV = 1e-6f;
constexpr float QSCALE = 0.125f * 1.4426950408889634f;

constexpr float ROT_C[8][8] = {{1.000000000e+00f, 1.000000000e+00f, 1.000000000e+00f, 1.000000000e+00f, 1.000000000e+00f, 1.000000000e+00f, 1.000000000e+00f, 1.000000000e+00f}, {-9.576594803e-01f, -9.992462676e-01f, 8.243765167e-01f, 9.932003006e-01f, 9.997440110e-01f, 9.999903729e-01f, 9.999996380e-01f, 9.999999864e-01f}, {8.342233605e-01f, 9.969862065e-01f, 3.591932825e-01f, 9.728936743e-01f, 9.989761749e-01f, 9.999614917e-01f, 9.999985518e-01f, 9.999999455e-01f}, {-6.401443395e-01f, -9.932232238e-01f, -2.321555027e-01f, 9.393562789e-01f, 9.976968850e-01f, 9.999133569e-01f, 9.999967417e-01f, 9.999998775e-01f}, {-6.928958219e-01f, 9.521417467e-01f, 1.010103862e-01f, 5.950558964e-01f, 9.836606931e-01f, 9.993839260e-01f, 9.999768296e-01f, 9.999991287e-01f}, {8.711474010e-01f, -9.395588652e-01f, 6.464173313e-01f, 4.974463326e-01f, 9.793355680e-01f, 9.992203026e-01f, 9.999706750e-01f, 9.999988972e-01f}, {-9.756293128e-01f, 9.255596318e-01f, 9.647721496e-01f, 3.930717976e-01f, 9.745090446e-01f, 9.990374400e-01f, 9.999637963e-01f, 9.999986385e-01f}, {9.974939203e-01f, -9.101651497e-01f, 9.442536768e-01f, 2.833517226e-01f, 9.691835939e-01f, 9.988353416e-01f, 9.999561936e-01f, 9.999983526e-01f}};
constexpr float ROT_S[8][8] = {{0.000000000e+00f, 0.000000000e+00f, 0.000000000e+00f, 0.000000000e+00f, 0.000000000e+00f, 0.000000000e+00f, 0.000000000e+00f, 0.000000000e+00f}, {-2.879033167e-01f, 3.881876802e-02f, 5.660418348e-01f, 1.164180522e-01f, 2.262548431e-02f, 4.387956933e-03f, 8.509273312e-04f, 1.650141632e-04f}, {5.514266812e-01f, -7.757901811e-02f, 9.332631922e-01f, 2.312528888e-01f, 4.523938487e-02f, 8.775829378e-03f, 1.701854046e-03f, 3.300283219e-04f}, {-7.682546613e-01f, 1.162223206e-01f, 9.726786841e-01f, 3.429428252e-01f, 6.783012386e-02f, 1.316353285e-02f, 2.552779529e-03f, 4.950424716e-04f}, {7.210377105e-01f, -3.056568242e-01f, -9.948853712e-01f, 8.036843162e-01f, 1.800323329e-01f, 3.509655897e-02f, 6.807366895e-03f, 1.320112928e-03f}, {-4.910215939e-01f, 3.423874103e-01f, -7.629840324e-01f, 8.674947529e-01f, 2.022420461e-01f, 3.948147472e-02f, 7.658272045e-03f, 1.485126930e-03f}, {2.194252584e-01f, -3.786018594e-01f, -2.630868667e-01f, 9.195077824e-01f, 2.243482159e-01f, 4.386563028e-02f, 8.509171650e-03f, 1.650140891e-03f}, {7.075223608e-02f, 4.142455796e-01f, 3.292187630e-01f, 9.590160589e-01f, 2.463395243e-01f, 4.824894124e-02f, 9.360065094e-03f, 1.815154807e-03f}};
struct EpiInProj {
    static constexpr bool PERM = true, AFTER_DRAIN = false;
    unsigned char* wsb; const float* qg; const float* kg; int cheap;
    static constexpr size_t OFF_ROPE = (size_t)1 << 20, OFF_SSQ = (size_t)2 << 20, OFF_P = (size_t)110 << 20;
    __device__ __forceinline__ void operator()(const f32x4 (&acc)[2][2][4][2], const Unit& u, int wr, int wc, int fr, int fq) const {
        bf16_t* const P = (bf16_t*)(wsb + OFF_P); const float* const ssq = (const float*)(wsb + OFF_SSQ); const float* const rope = (const float*)(wsb + OFF_ROPE);
        const int pn = u.pn;
        const int kind = cheap ? 4 : (pn == 0) ? 0 : ((pn == 3 || pn >= 13) ? 1 : ((pn >= 4 && pn <= 6) ? 2 : ((pn >= 7 && pn <= 9) ? 3 : 4)));
        bf16_t* const tens = P + (size_t)(pn * 4 + wc) * TSTRIDE + 8 * fq;
        const int row0 = u.pm * BM + wr * 64 + fr;
        f32x4 sq[8];
#pragma unroll
        for (int j = 0; j < 8; ++j) sq[j] = *(const f32x4*)(ssq + (size_t)(row0 + (j >> 2) * HALF + (j & 3) * 16) * 4);
        f32x4 g[2][2], cb[2], sb[2];
#pragma unroll
        for (int bj = 0; bj < 2; ++bj)
#pragma unroll
            for (int n = 0; n < 2; ++n) g[bj][n] = (f32x4){1.f, 1.f, 1.f, 1.f};
#pragma unroll
        for (int n = 0; n < 2; ++n) { cb[n] = (f32x4){1.f, 1.f, 1.f, 1.f}; sb[n] = (f32x4){0.f, 0.f, 0.f, 0.f}; }
        if (kind == 2 || kind == 3) { const float* gp = (kind == 2) ? qg : kg;
#pragma unroll
            for (int bj = 0; bj < 2; ++bj)
#pragma unroll
                for (int n = 0; n < 2; ++n) g[bj][n] = *(const f32x4*)(gp + 32 * bj + 8 * fq + 4 * n);
#pragma unroll
            for (int n = 0; n < 2; ++n) { cb[n] = *(const f32x4*)(rope + (size_t)row0 * 16 + 4 * n); sb[n] = *(const f32x4*)(rope + (size_t)row0 * 16 + 8 + 4 * n); } }
        float rs[8];
#pragma unroll
        for (int j = 0; j < 8; ++j) rs[j] = __builtin_amdgcn_rsqf(((sq[j][0] + sq[j][1]) + (sq[j][2] + sq[j][3])) * (1.0f / 1024.0f) + EPSV);
#pragma unroll
        for (int ai = 0; ai < 2; ++ai)
#pragma unroll
            for (int m = 0; m < 4; ++m) {
                const int row = row0 + ai * HALF + m * 16;
                f32x4 v[2][2];
#pragma unroll
                for (int bj = 0; bj < 2; ++bj)
#pragma unroll
                    for (int n = 0; n < 2; ++n) v[bj][n] = acc[ai][bj][m][n] * rs[ai * 4 + m];
                if (kind == 0) {
#pragma unroll
                    for (int bj = 0; bj < 2; ++bj)
#pragma unroll
                        for (int n = 0; n < 2; ++n) v[bj][n] = v[bj][n] * QSCALE;
                } else if (kind == 1) {
#pragma unroll
                    for (int bj = 0; bj < 2; ++bj)
#pragma unroll
                        for (int n = 0; n < 2; ++n)
#pragma unroll
                            for (int e = 0; e < 4; ++e) { const float x = v[bj][n][e]; v[bj][n][e] = x * __builtin_amdgcn_rcpf(1.0f + __builtin_amdgcn_exp2f(-1.4426950408889634f * x)); }
                } else if (kind == 2 || kind == 3) {
                    float hs = 0.f;
#pragma unroll
                    for (int bj = 0; bj < 2; ++bj)
#pragma unroll
                        for (int n = 0; n < 2; ++n) { const f32x4 x = v[bj][n]; hs += (x[0] * x[0] + x[1] * x[1]) + (x[2] * x[2] + x[3] * x[3]); }
                    hs += lx_xor<16>(hs); hs = lx_sum32(hs);
                    const float hr = __builtin_amdgcn_rsqf(hs * (1.0f / 64.0f) + EPSV);
#pragma unroll
                    for (int bj = 0; bj < 2; ++bj)
#pragma unroll
                        for (int n = 0; n < 2; ++n) v[bj][n] = v[bj][n] * hr * g[bj][n];
#pragma unroll
                    for (int n = 0; n < 2; ++n)
#pragma unroll
                        for (int e = 0; e < 4; ++e) { const int i = 4 * n + e; const float cr = ROT_C[ai * 4 + m][i], sr = ROT_S[ai * 4 + m][i];
                            const float cc = cb[n][e] * cr - sb[n][e] * sr, ss2 = sb[n][e] * cr + cb[n][e] * sr;
                            const float own = v[0][n][e]; const float oth = lx_xor<16>(own);
                            const float r0 = own * cc - oth * ss2, r1 = own * cc + oth * ss2;
                            v[0][n][e] = (fq == 0) ? r0 : ((fq == 1) ? r1 : own); }
                    if (kind == 2) {
#pragma unroll
                        for (int bj = 0; bj < 2; ++bj)
#pragma unroll
                            for (int n = 0; n < 2; ++n) v[bj][n] = v[bj][n] * QSCALE;
                    }
                }
                bf16_t* rowp = tens + (size_t)(PROJ_PAD ? row + (row >> 4) : row) * 64;
#pragma unroll
                for (int bj = 0; bj < 2; ++bj) { u32x4 w; w.x = cvtpk(v[bj][0][0], v[bj][0][1]); w.y = cvtpk(v[bj][0][2], v[bj][0][3]); w.z = cvtpk(v[bj][1][0], v[bj][1][1]); w.w = cvtpk(v[bj][1][2], v[bj][1][3]);
                    *(u32x4*)(rowp + 32 * bj) = w; }
            }
    }
};

typedef unsigned u32x2 __attribute__((ext_vector_type(2)));
struct EpiOutProj {
    static constexpr bool PERM = true, AFTER_DRAIN = true;
    bf16_t* xh; unsigned char* xl; float* xout; float* ssq; int last;
    __device__ __forceinline__ void fused(f32x4 (&acc)[2][2][4][2], const Unit& u, int wr, int wc, int fr, int fq, PG8_LAS unsigned char* lds, int wid, int lane) const {
        PG8_LAS float* Pw = (PG8_LAS float*)lds;
        const size_t off0 = (size_t)(u.pm * BM + wr * 64 + fr) * 1024 + u.pn * BM + wc * 32 + 8 * fq;
        u32x4 ph[2][2][2]; u32x2 pl[2][2][2];
#define EOP_LOAD(buf, pr) do { _Pragma("unroll") for (int q_ = 0; q_ < 2; ++q_) { const int j_ = 2 * (pr) + q_; const size_t o_ = off0 + (size_t)((j_ >> 2) * HALF + (j_ & 3) * 16) * 1024; \
            _Pragma("unroll") for (int bj = 0; bj < 2; ++bj) { ph[buf][q_][bj] = *(const u32x4*)(xh + o_ + bj * HALF); pl[buf][q_][bj] = *(const u32x2*)(xl + o_ + bj * HALF); } } } while (0)
        EOP_LOAD(0, 0); asm volatile("" ::: "memory"); EOP_LOAD(1, 1); asm volatile("" ::: "memory");
#pragma unroll
        for (int pr = 0; pr < 4; ++pr) {
#pragma unroll
            for (int q = 0; q < 2; ++q) { const int j = 2 * pr + q, ai = j >> 2, m = j & 3; const int rt = ai * HALF + wr * 64 + m * 16 + fr; const size_t off = off0 + (size_t)(ai * HALF + m * 16) * 1024;
                float s = 0.f;
#pragma unroll
                for (int bj = 0; bj < 2; ++bj) {
                    const u32x4 h = ph[pr & 1][q][bj]; const u32x2 lo = pl[pr & 1][q][bj];
                    float a[8];
#pragma unroll
                    for (int e = 0; e < 8; ++e) { const unsigned hw = h[e >> 1], hs = (e & 1) ? (hw & 0xffff0000u) : (hw << 16), l8 = (lo[e >> 2] >> (8 * (e & 3))) & 0xffu;
                        a[e] = xs_join(hs, l8) + acc[ai][bj][m][e >> 2][e & 3]; }
                    if (last) { *(f32x4*)(xout + off + bj * HALF) = (f32x4){a[0], a[1], a[2], a[3]}; *(f32x4*)(xout + off + bj * HALF + 4) = (f32x4){a[4], a[5], a[6], a[7]}; }
                    else { u32x4 w; w.x = cvtpk(a[0], a[1]); w.y = cvtpk(a[2], a[3]); w.z = cvtpk(a[4], a[5]); w.w = cvtpk(a[6], a[7]);
                        unsigned l[8];
#pragma unroll
                        for (int e = 0; e < 8; ++e) { const unsigned hw = w[e >> 1]; l[e] = xs_lo(a[e], (e & 1) ? (hw & 0xffff0000u) : (hw << 16)); }
                        u32x2 lw; lw.x = l[0] | (l[1] << 8) | (l[2] << 16) | (l[3] << 24); lw.y = l[4] | (l[5] << 8) | (l[6] << 16) | (l[7] << 24);
                        *(u32x4*)(xh + off + bj * HALF) = w; *(u32x2*)(xl + off + bj * HALF) = lw; }
                    s += ((a[0] * a[0] + a[1] * a[1]) + (a[2] * a[2] + a[3] * a[3])) + ((a[4] * a[4] + a[5] * a[5]) + (a[6] * a[6] + a[7] * a[7]));
                }
                s += lx_xor<16>(s); s = lx_sum32(s);
                if (fq == 0) Pw[rt * 4 + wc] = s; }
            asm volatile("" ::: "memory");
            if (pr + 2 < 4) { EOP_LOAD(pr & 1, pr + 2); asm volatile("" ::: "memory"); }
        }
#undef EOP_LOAD
        asm volatile("s_waitcnt lgkmcnt(0)" ::: "memory"); __builtin_amdgcn_s_barrier(); asm volatile("" ::: "memory");
        const int t = wid * 64 + lane;
        if (t < 256) { const float s = (Pw[t * 4 + 0] + Pw[t * 4 + 1]) + (Pw[t * 4 + 2] + Pw[t * 4 + 3]); ssq[(size_t)(u.pm * BM + t) * 4 + u.pn] = s; }
        asm volatile("s_waitcnt lgkmcnt(0)" ::: "memory"); __builtin_amdgcn_s_barrier(); asm volatile("" ::: "memory");
    }
};

template <class Epi, class Sched, bool ALIGN_EPI = false, bool SP2 = false>
__device__ __forceinline__ void gemm_phase(PG8_LAS unsigned char* lds, const Gemm g, const Sched& S, const Epi& E, int wave) {
    int wid = wave; asm volatile("" : "+s"(wid)); const int tid = lx_tid(wid);
    const int lane = tid & 63, wr = wid >> 2, wc = wid & 3, fr = lane & 15, fq = lane >> 4;
    const int K = g.K, nt = K / BK;
    unsigned voffA[2], voffB[2];
#pragma unroll
    for (int i = 0; i < 2; ++i) { int R, C; stage_rc(tid * 16 + i * 8192, R, C); const int Rb = Epi::PERM ? ((R & ~31) + perm32(R & 31)) : R;
        voffA[i] = (unsigned)(R * K + C) * 2u; voffB[i] = (unsigned)(Rb * K + C) * 2u; }
    const size_t kstep = (size_t)(BK * 2);
    const size_t hstep = (size_t)HALF * K * 2;
    const size_t tstep = 2 * hstep;
    const unsigned ldsw = (unsigned)wid * 1024u;
    const int aoff = lds_byte(wr * 64 + fr, fq * 8), boff = lds_byte(wc * 32 + fr, fq * 8);
#define PG8_SA(b, h) (((b) * 2 + (h)) * HTB)
#define PG8_SB(b, h) ((4 + (b) * 2 + (h)) * HTB)
#define PG8_STAGE(bufoff, gbase, voff) do { _Pragma("unroll") for (int _i = 0; _i < 2; ++_i) \
        __builtin_amdgcn_global_load_lds((const unsigned*)((const char*)(gbase) + (voff)[_i]), (PG8_LAS unsigned*)(lds + (bufoff) + ldsw + _i * 8192), 16, 0, 0); } while (0)
#define PG8_LDA(dst, b, h) do { _Pragma("unroll") for (int m = 0; m < 4; ++m) _Pragma("unroll") for (int k = 0; k < 2; ++k) dst[m][k] = *(const PG8_LAS bf16x8*)(lds + PG8_SA(b, h) + aoff + m * 2048 + k * 1024); } while (0)
#define PG8_LDB(dst, b, h) do { _Pragma("unroll") for (int n = 0; n < 2; ++n) _Pragma("unroll") for (int k = 0; k < 2; ++k) dst[n][k] = *(const PG8_LAS bf16x8*)(lds + PG8_SB(b, h) + boff + n * 2048 + k * 1024); } while (0)
#define PG8_MMA(ai, bj, At, Bt) do { __builtin_amdgcn_s_setprio(1); _Pragma("unroll") for (int m = 0; m < 4; ++m) _Pragma("unroll") for (int n = 0; n < 2; ++n) _Pragma("unroll") for (int k = 0; k < 2; ++k) \
        acc[ai][bj][m][n] = __builtin_amdgcn_mfma_f32_16x16x32_bf16(Bt[n][k], At[m][k], acc[ai][bj][m][n], 0, 0, 0); __builtin_amdgcn_s_setprio(0); } while (0)
#define PG8_WAIT_V(n) asm volatile("s_waitcnt vmcnt(" #n ")" ::: "memory")
#define PG8_WAIT_L(n) asm volatile("s_waitcnt lgkmcnt(" #n ")" ::: "memory")
#define PG8_BAR __builtin_amdgcn_s_barrier()
#define PG8_SCHED __builtin_amdgcn_sched_barrier(0)
    Unit cur, nxt; int ui = 0;
    if (!S.next(0, cur)) return;
    f32x4 acc[2][2][4][2];
#pragma unroll
    for (int a = 0; a < 2; ++a)
#pragma unroll
        for (int b = 0; b < 2; ++b)
#pragma unroll
            for (int m = 0; m < 4; ++m)
#pragma unroll
                for (int n = 0; n < 2; ++n) acc[a][b][m][n] = (f32x4){0.f, 0.f, 0.f, 0.f};
    bf16x8 At[4][2], B0[2][2], B1[2][2];
    const char* cA = (const char*)g.A + (size_t)cur.pm * tstep; const char* cB = (const char*)g.Bt + (size_t)cur.pn * tstep;
    S.a_ready(cur);
    if constexpr (SP2) {
        PG8_STAGE(PG8_SB(0, 0), cB, voffB); PG8_STAGE(PG8_SB(0, 1), cB + hstep, voffB); PG8_STAGE(PG8_SA(0, 0), cA, voffA); PG8_STAGE(PG8_SA(0, 1), cA + hstep, voffA);
        if (wr == 1) PG8_BAR;
        PG8_WAIT_V(2); PG8_BAR;
        PG8_STAGE(PG8_SB(1, 0), cB + kstep, voffB); PG8_STAGE(PG8_SA(1, 0), cA + kstep, voffA); PG8_STAGE(PG8_SB(1, 1), cB + hstep + kstep, voffB);
        PG8_WAIT_V(6); PG8_BAR;
    } else {
        PG8_STAGE(PG8_SB(0, 0), cB, voffB); PG8_STAGE(PG8_SA(0, 0), cA, voffA); PG8_STAGE(PG8_SB(0, 1), cB + hstep, voffB); PG8_STAGE(PG8_SA(0, 1), cA + hstep, voffA);
        if (wr == 1) PG8_BAR;
        PG8_WAIT_V(4); PG8_BAR;
        PG8_STAGE(PG8_SB(1, 0), cB + kstep, voffB); PG8_STAGE(PG8_SA(1, 0), cA + kstep, voffA); PG8_STAGE(PG8_SB(1, 1), cB + hstep + kstep, voffB);
        PG8_WAIT_V(6); PG8_BAR;
    }
    for (;;) {
        const bool has_next = S.next(ui + 1, nxt);
        const char* nA = has_next ? (const char*)g.A + (size_t)nxt.pm * tstep : cA; const char* nB = has_next ? (const char*)g.Bt + (size_t)nxt.pn * tstep : cB;
        for (int t = 0; t < nt; t += 2) {
            const bool last = (t == nt - 2);
            const char* a1 = cA + (size_t)(t + 1) * kstep;
            const char* a2 = last ? nA : cA + (size_t)(t + 2) * kstep; const char* b2 = last ? nB : cB + (size_t)(t + 2) * kstep;
            const char* a3 = a2 + kstep; const char* b3 = b2 + kstep;
            if (last && has_next) S.a_ready(nxt);
            if constexpr (SP2) {
            PG8_LDB(B0, 0, 0); PG8_LDB(B1, 0, 1); PG8_SCHED; PG8_LDA(At, 0, 0); PG8_STAGE(PG8_SA(1, 1), a1 + hstep, voffA);
            PG8_WAIT_V(8); PG8_WAIT_L(0); PG8_BAR; PG8_MMA(0, 0, At, B0); PG8_MMA(0, 1, At, B1); PG8_BAR; PG8_SCHED;
            PG8_LDA(At, 0, 1); PG8_STAGE(PG8_SB(0, 0), b2, voffB); PG8_STAGE(PG8_SB(0, 1), b2 + hstep, voffB); PG8_STAGE(PG8_SA(0, 0), a2, voffA);
            PG8_WAIT_V(8); PG8_WAIT_L(0); PG8_BAR; PG8_MMA(1, 0, At, B0); PG8_MMA(1, 1, At, B1); PG8_BAR; PG8_SCHED;
            PG8_LDB(B0, 1, 0); PG8_LDB(B1, 1, 1); PG8_SCHED; PG8_LDA(At, 1, 0); PG8_STAGE(PG8_SA(0, 1), a2 + hstep, voffA);
            PG8_WAIT_V(8); PG8_WAIT_L(0); PG8_BAR; PG8_MMA(0, 0, At, B0); PG8_MMA(0, 1, At, B1); PG8_BAR; PG8_SCHED;
            PG8_LDA(At, 1, 1); PG8_STAGE(PG8_SB(1, 0), b3, voffB); PG8_STAGE(PG8_SB(1, 1), b3 + hstep, voffB); PG8_STAGE(PG8_SA(1, 0), a3, voffA);
            PG8_WAIT_V(8); PG8_WAIT_L(0); PG8_BAR; PG8_MMA(1, 0, At, B0); PG8_MMA(1, 1, At, B1); PG8_BAR; PG8_SCHED;
            } else {
            PG8_LDB(B0, 0, 0); PG8_SCHED; PG8_LDA(At, 0, 0); PG8_STAGE(PG8_SA(1, 1), a1 + hstep, voffA);
            PG8_WAIT_L(8); PG8_BAR; PG8_WAIT_L(0); PG8_MMA(0, 0, At, B0); PG8_BAR; PG8_SCHED;
            PG8_LDB(B1, 0, 1); PG8_STAGE(PG8_SB(0, 0), b2, voffB);
            PG8_BAR; PG8_WAIT_L(0); PG8_MMA(0, 1, At, B1); PG8_BAR;
            PG8_LDA(At, 0, 1); PG8_STAGE(PG8_SA(0, 0), a2, voffA);
            PG8_BAR; PG8_WAIT_L(0); PG8_MMA(1, 0, At, B0); PG8_BAR; PG8_SCHED;
            PG8_STAGE(PG8_SB(0, 1), b2 + hstep, voffB);
            PG8_WAIT_V(6); PG8_BAR; PG8_MMA(1, 1, At, B1); PG8_BAR;
            PG8_LDB(B0, 1, 0); PG8_SCHED; PG8_LDA(At, 1, 0); PG8_STAGE(PG8_SA(0, 1), a2 + hstep, voffA);
            PG8_WAIT_L(8); PG8_BAR; PG8_WAIT_L(0); PG8_MMA(0, 0, At, B0); PG8_BAR; PG8_SCHED;
            PG8_LDB(B1, 1, 1); PG8_STAGE(PG8_SB(1, 0), b3, voffB);
            PG8_BAR; PG8_WAIT_L(0); PG8_MMA(0, 1, At, B1); PG8_BAR;
            PG8_LDA(At, 1, 1); PG8_STAGE(PG8_SA(1, 0), a3, voffA);
            PG8_BAR; PG8_WAIT_L(0); PG8_MMA(1, 0, At, B0); PG8_BAR; PG8_SCHED;
            PG8_STAGE(PG8_SB(1, 1), b3 + hstep, voffB);
            PG8_WAIT_V(6); PG8_BAR; PG8_MMA(1, 1, At, B1); PG8_BAR;
            }
        }
        if constexpr (ALIGN_EPI) { if (wr == 0) PG8_BAR; }
        if constexpr (!Epi::AFTER_DRAIN) { E(acc, cur, wr, wc, fr, fq);
            S.done(cur); }
        if (!has_next) break;
#pragma unroll
        for (int a = 0; a < 2; ++a)
#pragma unroll
            for (int b = 0; b < 2; ++b)
#pragma unroll
                for (int m = 0; m < 4; ++m)
#pragma unroll
                    for (int n = 0; n < 2; ++n) acc[a][b][m][n] = (f32x4){0.f, 0.f, 0.f, 0.f};
        cur = nxt; cA = nA; cB = nB; ++ui;
        if constexpr (ALIGN_EPI) { if (wr == 1) PG8_BAR; }
    }
    PG8_WAIT_V(0);
    if constexpr (!ALIGN_EPI) { if (wr == 0) PG8_BAR; }
    PG8_BAR;
    if constexpr (Epi::AFTER_DRAIN) { E.fused(acc, cur, wr, wc, fr, fq, lds, wid, lane); S.done(cur); }
#undef PG8_SA
#undef PG8_SB
#undef PG8_STAGE
#undef PG8_LDA
#undef PG8_LDB
#undef PG8_MMA
#undef PG8_WAIT_V
#undef PG8_WAIT_L
#undef PG8_BAR
#undef PG8_SCHED
}
}
namespace att {
#define ATT_LAS __attribute__((address_space(3)))
using bf16x8 = __attribute__((ext_vector_type(8))) short;
using s16x4 = __attribute__((ext_vector_type(4))) short;
using f32x16 = __attribute__((ext_vector_type(16))) float;
using u32x4 = __attribute__((ext_vector_type(4))) unsigned;
typedef unsigned short bf16_t;
typedef ATT_LAS const char* lds_cptr;
typedef ATT_LAS char* lds_ptr;
typedef short v4i16_t __attribute__((ext_vector_type(4)));
typedef float f32x2_t __attribute__((ext_vector_type(2))); typedef __bf16 bf16x2_t __attribute__((ext_vector_type(2)));
constexpr int SEQ = 16384;
constexpr int PROWS = SEQ + (PROJ_PAD ? SEQ / 16 : 0); constexpr size_t TSTRIDE = (size_t)PROWS * 64;
constexpr int T_QA = 0, T_KA = 4, T_VA = 8, T_GA = 12, T_QD = 16, T_KD = 28, T_VD = 40, T_GD = 52;
__device__ __forceinline__ int prow(int t) { return PROJ_PAD ? t + (t >> 4) : t; }
constexpr int SLOTB = 8192, NSLOT = 6;
constexpr int LDS_K = 0, LDS_K2 = NSLOT * SLOTB, LDS_V = 2 * NSLOT * SLOTB, LDS_WS = 3 * NSLOT * SLOTB, LDS_FLAG = LDS_WS + 8 * 64 * 4, LDS_END = LDS_FLAG + 128;
constexpr int LDS_OST = LDS_K2;
#define ATT_BAR_L() asm volatile("s_waitcnt lgkmcnt(0)\n\ts_barrier" ::: "memory")
constexpr float SB_DEAD = 152.0f;
__device__ __forceinline__ int crow(int r, int hi) { return (r & 3) + 8 * (r >> 2) + 4 * hi; }
__device__ __forceinline__ unsigned cvtpk_s(float lo, float hi) { f32x2_t v = {lo, hi}; bf16x2_t b = __builtin_convertvector(v, bf16x2_t); return __builtin_bit_cast(unsigned, b); }
__device__ __forceinline__ float bf2f(unsigned short b) { return __uint_as_float((unsigned)b << 16); }
__device__ __forceinline__ void glds16(const void* gsrc, unsigned lds_dst) { unsigned keep;
    asm volatile("s_mov_b32 %0, m0\n\ts_mov_b32 m0, %2\n\ts_nop 0\n\tglobal_load_lds_dwordx4 %1, off\n\ts_mov_b32 m0, %0" : "=&s"(keep) : "v"(gsrc), "s"(lds_dst) : "memory"); }
__device__ __forceinline__ void glds16s(unsigned voff, const void* sbase, unsigned lds_dst) { unsigned keep;
    const unsigned long long a_ = (unsigned long long)sbase;
    const unsigned long long b_ = (unsigned long long)(unsigned)__builtin_amdgcn_readfirstlane((int)(unsigned)a_) | ((unsigned long long)(unsigned)__builtin_amdgcn_readfirstlane((int)(unsigned)(a_ >> 32)) << 32);
    asm volatile("s_nop 4\n\ts_mov_b32 %0, m0\n\ts_mov_b32 m0, %3\n\ts_nop 0\n\tglobal_load_lds_dwordx4 %1, %2\n\ts_mov_b32 m0, %0" : "=&s"(keep) : "v"(voff), "s"(b_), "s"(lds_dst) : "memory"); }
#define ATT_WAIT_BAR(N) asm volatile("s_waitcnt vmcnt(" #N ") lgkmcnt(0)\n\ts_barrier" ::: "memory")
__device__ __forceinline__ s16x4 vtr(lds_cptr p) { return __builtin_bit_cast(s16x4, __builtin_amdgcn_ds_read_tr16_b64_v4i16((ATT_LAS v4i16_t*)p)); }

__device__ __forceinline__ void qkt(f32x16& p0, f32x16& p1, lds_cptr ks, const int (&koff)[4], const bf16x8* qr, const f32x16& cinit) {
#pragma unroll
    for (int d0 = 0; d0 < 4; ++d0) {
        const bf16x8 b0 = *(const ATT_LAS bf16x8*)(ks + koff[d0]);
        const bf16x8 b1 = *(const ATT_LAS bf16x8*)(ks + koff[d0] + 4096);
        if (d0 == 0) { p0 = __builtin_amdgcn_mfma_f32_32x32x16_bf16(b0, qr[0], cinit, 0, 0, 0); p1 = __builtin_amdgcn_mfma_f32_32x32x16_bf16(b1, qr[0], cinit, 0, 0, 0); }
        else { p0 = __builtin_amdgcn_mfma_f32_32x32x16_bf16(b0, qr[d0], p0, 0, 0, 0); p1 = __builtin_amdgcn_mfma_f32_32x32x16_bf16(b1, qr[d0], p1, 0, 0, 0); }
    }
}
__device__ __forceinline__ void pv(f32x16* o, lds_cptr vp, bf16x8 pa0, bf16x8 pa1, bf16x8 pa2, bf16x8 pa3) {
#pragma unroll
    for (int d0 = 0; d0 < 2; ++d0) { s16x4 lo[4], hi[4];
#pragma unroll
        for (int ks = 0; ks < 4; ++ks) { lo[ks] = vtr(vp + d0 * 4096 + ks * 1024); hi[ks] = vtr(vp + d0 * 4096 + ks * 1024 + 512); }
#define ATT_PK(k) (bf16x8){lo[k][0], lo[k][1], lo[k][2], lo[k][3], hi[k][0], hi[k][1], hi[k][2], hi[k][3]}
        o[d0] = __builtin_amdgcn_mfma_f32_32x32x16_bf16(ATT_PK(0), pa0, o[d0], 0, 0, 0);
        o[d0] = __builtin_amdgcn_mfma_f32_32x32x16_bf16(ATT_PK(1), pa1, o[d0], 0, 0, 0);
        o[d0] = __builtin_amdgcn_mfma_f32_32x32x16_bf16(ATT_PK(2), pa2, o[d0], 0, 0, 0);
        o[d0] = __builtin_amdgcn_mfma_f32_32x32x16_bf16(ATT_PK(3), pa3, o[d0], 0, 0, 0);
#undef ATT_PK
    }
}
__device__ __forceinline__ void ot_rows(const f32x16* o, lds_ptr stg, int q, int hi, int lane, u32x4* sv) {
#pragma unroll
    for (int d0 = 0; d0 < 2; ++d0)
#pragma unroll
        for (int pr = 0; pr < 2; ++pr) { const int g = 2 * pr;
            const unsigned ax = cvtpk_s(o[d0][4 * g], o[d0][4 * g + 1]), ay = cvtpk_s(o[d0][4 * g + 2], o[d0][4 * g + 3]), bx = cvtpk_s(o[d0][4 * g + 4], o[d0][4 * g + 5]), by = cvtpk_s(o[d0][4 * g + 6], o[d0][4 * g + 7]);
            const auto rx = __builtin_amdgcn_permlane32_swap(ax, bx, false, false); const auto ry = __builtin_amdgcn_permlane32_swap(ay, by, false, false);
            *(ATT_LAS u32x4*)(stg + q * 128 + (((4 * d0 + 2 * pr + hi) ^ (q & 7)) << 4)) = (u32x4){rx[0], ry[0], rx[1], ry[1]}; }
    asm volatile("s_waitcnt lgkmcnt(0)" ::: "memory");
#pragma unroll
    for (int i = 0; i < 4; ++i) { const int rw = 8 * i + (lane >> 3); sv[i] = *(const ATT_LAS u32x4*)(stg + rw * 128 + (((lane & 7) ^ (rw & 7)) << 4)); }
}
__device__ __forceinline__ bf16x8 pack8(const float* a) { u32x4 w; w.x = cvtpk_s(a[0], a[1]); w.y = cvtpk_s(a[2], a[3]); w.z = cvtpk_s(a[4], a[5]); w.w = cvtpk_s(a[6], a[7]); return __builtin_bit_cast(bf16x8, w); }

template <bool MASK> __device__ __forceinline__ void sb_tile(const f32x16& p0, const f32x16& p1, float& Rsum, int qrel, int hi, bf16x8& pa0, bf16x8& pa1, bf16x8& pa2, bf16x8& pa3) {
    float run = Rsum; unsigned pw[16];
#pragma unroll
    for (int g = 7; g >= 0; --g) {
        float z[4], sp[4];
#pragma unroll
        for (int e = 0; e < 4; ++e) { const int idx = 4 * g + e; z[e] = (idx < 16) ? p0[idx] : p1[idx - 16];
            sp[e] = __builtin_fmaxf(z[e], 0.f) + __builtin_amdgcn_logf(1.0f + __builtin_amdgcn_exp2f(-__builtin_fabsf(z[e])));
            if (MASK) { if (8 * g + 4 * hi + e >= qrel) sp[e] = 0.f; } }
        const float e2 = sp[3], e1 = sp[3] + sp[2], e0 = e1 + sp[1], T = e0 + sp[0];
        const auto rr = __builtin_amdgcn_permlane32_swap(__float_as_uint(T), __float_as_uint(T), false, false);
        const float tev = __uint_as_float(rr[0]), tod = __uint_as_float(rr[1]);
        const float off = run + (hi ? 0.f : tod);
        run += tev + tod;
        float a[4];
        a[0] = __builtin_amdgcn_exp2f((z[0] - sp[0]) - (off + e0)); a[1] = __builtin_amdgcn_exp2f((z[1] - sp[1]) - (off + e1));
        a[2] = __builtin_amdgcn_exp2f((z[2] - sp[2]) - (off + e2)); a[3] = __builtin_amdgcn_exp2f((z[3] - sp[3]) - off);
        if (MASK) {
#pragma unroll
            for (int e = 0; e < 4; ++e) if (8 * g + 4 * hi + e >= qrel) a[e] = 0.f; }
        pw[2 * g] = cvtpk_s(a[0], a[1]); pw[2 * g + 1] = cvtpk_s(a[2], a[3]);
    }
    Rsum = run;
    pa0 = __builtin_bit_cast(bf16x8, (u32x4){pw[0], pw[1], pw[2], pw[3]}); pa1 = __builtin_bit_cast(bf16x8, (u32x4){pw[4], pw[5], pw[6], pw[7]});
    pa2 = __builtin_bit_cast(bf16x8, (u32x4){pw[8], pw[9], pw[10], pw[11]}); pa3 = __builtin_bit_cast(bf16x8, (u32x4){pw[12], pw[13], pw[14], pw[15]});
}

struct SbArgs { const bf16_t* proj; bf16_t* mix; };
template <bool EARLY> __device__ __forceinline__ void sb_unit(int h, int qb, const SbArgs& A, lds_ptr shm, int wave) {
    int wid = wave; asm volatile("" : "+s"(wid)); const int tid = lx_tid(wid);
    const int lane = tid & 63, r32 = lane & 31, hi = lane >> 5;
    const int q0 = qb * 256;
    const bf16_t* Qh = A.proj + (size_t)(T_QA + h) * TSTRIDE; const bf16_t* Kh = A.proj + (size_t)(T_KA + h) * TSTRIDE; const bf16_t* Vh = A.proj + (size_t)(T_VA + h) * TSTRIDE;
    const unsigned lds0 = (unsigned)(size_t)shm;
    volatile ATT_LAS unsigned* flags = (volatile ATT_LAS unsigned*)(shm + LDS_FLAG);
    const unsigned kdst = lds0 + LDS_K + wid * 1024, vdst = lds0 + LDS_V + wid * 1024;
    const lds_cptr ks0 = (lds_cptr)shm + LDS_K; int koff[4];
#pragma unroll
    for (int d0 = 0; d0 < 4; ++d0) koff[d0] = r32 * 128 + (((2 * d0 + hi) ^ ((r32 >> 1) & 7)) << 4);
    const lds_cptr vp0 = (lds_cptr)shm + LDS_V + ((lane >> 4) & 1) * 32 + (lane & 3) * 8 + (4 * hi + ((lane & 15) >> 2)) * 64;
#define SB_DMA(jt, slot) do { const int jt_ = (jt) < 0 ? 0 : (jt); const int l_ = lx_lane(); const int kkey_ = 8 * wid + (l_ >> 3), vkey_ = 16 * (wid & 3) + (l_ >> 2); \
        const unsigned voffK_ = (unsigned)((prow(kkey_) * 64 + ((l_ & 7) ^ ((kkey_ >> 1) & 7)) * 8) * 2), voffV_ = (unsigned)((prow(vkey_) * 64 + (wid >> 2) * 32 + (l_ & 3) * 8) * 2); \
        glds16s(voffK_, (const char*)Kh + (size_t)jt_ * ((PROJ_PAD ? 68 : 64) * 128), (unsigned)__builtin_amdgcn_readfirstlane(kdst + (slot))); \
        glds16s(voffV_, (const char*)Vh + (size_t)jt_ * ((PROJ_PAD ? 68 : 64) * 128), (unsigned)__builtin_amdgcn_readfirstlane(vdst + (slot))); } while (0)
    const int jtop = 4 * qb + 3, jd = 4 * qb + (wid >> 1), qrel = 32 * (wid & 1) + r32;
    if (lane == 0) { flags[wid] = 0u; flags[8 + wid] = 0u; }
    bf16x8 qr[4];
    { const bf16_t* Qp = Qh + (size_t)prow(q0 + wid * 32 + r32) * 64;
#pragma unroll
      for (int d0 = 0; d0 < 4; ++d0) qr[d0] = *(const bf16x8*)(Qp + d0 * 16 + hi * 8); }
    const lds_ptr qst = shm + LDS_OST + wid * 4096 + lane * 16;
#pragma unroll
    for (int d0 = 0; d0 < 4; ++d0) *(ATT_LAS bf16x8*)(qst + d0 * 1024) = qr[d0];
    asm volatile("" ::: "memory");
#pragma unroll
    for (int i = 0; i < 6; ++i) SB_DMA(jtop - i, ((jtop - i + 6000) % 6) * SLOTB);
    f32x16 o[2]; o[0] = f32x16{}; o[1] = f32x16{}; const f32x16 zero = f32x16{};
    float Rsum = 0.f; bool dead = false;
    for (int s = 0;; ++s) {
        const int jt = jd - s;
        if (s == 0) ATT_WAIT_BAR(4); else ATT_WAIT_BAR(2);
        if (s > 0) { const int fb = ((s - 1) & 1) * 8; unsigned all = 1u;
#pragma unroll
            for (int w = 0; w < 8; ++w) all &= flags[fb + w];
            if (all) break; }
        if (s > 0) SB_DMA(jtop - s - 5, ((jtop - s + 1 + 6000) % 6) * SLOTB);
        if (jt >= 0 && !dead) {
            const int slot = ((jt + 6000) % 6) * SLOTB;
            f32x16 p0, p1; bf16x8 pa0, pa1, pa2, pa3;
            { bf16x8 qf[4];
#pragma unroll
              for (int d0 = 0; d0 < 4; ++d0) qf[d0] = *(const ATT_LAS bf16x8*)(qst + d0 * 1024);
              qkt(p0, p1, ks0 + slot, koff, qf, zero); }
            __builtin_amdgcn_sched_barrier(0);
            if (s == 0) sb_tile<true>(p0, p1, Rsum, qrel, hi, pa0, pa1, pa2, pa3); else sb_tile<false>(p0, p1, Rsum, qrel, hi, pa0, pa1, pa2, pa3);
            __builtin_amdgcn_sched_barrier(0);
            pv(o, vp0 + slot, pa0, pa1, pa2, pa3);
            if (EARLY) dead = __all(Rsum > SB_DEAD);
        }
        const bool fin = dead || (jt <= 0);
        if (lane == 0) flags[(s & 1) * 8 + wid] = fin ? 1u : 0u;
    }
#undef SB_DMA
    asm volatile("s_waitcnt vmcnt(0)" ::: "memory");
    { const int l2 = lx_lane();
      u32x4 sv[4]; ot_rows(o, shm + LDS_OST + wid * 4096, l2 & 31, l2 >> 5, l2, sv);
      const bf16_t* Gh = A.proj + (size_t)(T_GA + h) * TSTRIDE; bf16_t* Mw = A.mix + (size_t)(q0 + wid * 32) * 1024 + h * 64;
#pragma unroll
      for (int i = 0; i < 4; ++i) { const int row = i * 8 + (l2 >> 3), chn = l2 & 7; const u32x4 gv = *(const u32x4*)(Gh + (size_t)prow(q0 + wid * 32 + row) * 64 + chn * 8);
          u32x4 w;
#pragma unroll
          for (int k = 0; k < 4; ++k) { const float lo = __uint_as_float(sv[i][k] << 16) * __uint_as_float(gv[k] << 16), hi2 = __uint_as_float(sv[i][k] & 0xffff0000u) * __uint_as_float(gv[k] & 0xffff0000u); w[k] = cvtpk_s(lo, hi2); }
          *(u32x4*)(Mw + (size_t)row * 1024 + chn * 8) = w; } }
    ATT_BAR_L();
}

struct DilArgs { const bf16_t* proj; bf16_t* o1; bf16_t* mix; float* lp; unsigned* gcnt; const float* qg; const float* kg; };
template <int DUMMY = 0> __device__ __forceinline__ void dil_phase(int v, int G, const DilArgs& A, lds_ptr shm, int wave) {
    int wid = wave; asm volatile("" : "+s"(wid)); const int tid = lx_tid(wid);
    const int lane = tid & 63, r32 = lane & 31, hi = lane >> 5;
    const unsigned lds0 = (unsigned)(size_t)shm;
    ATT_LAS float* wsf = (ATT_LAS float*)(shm + LDS_WS) + wid * 64;
    const unsigned kdst0 = lds0 + LDS_K + wid * 1024, vdst = lds0 + LDS_V + wid * 1024;
    const lds_cptr ks00 = (lds_cptr)shm + LDS_K; int koff[4];
#pragma unroll
    for (int d0 = 0; d0 < 4; ++d0) koff[d0] = r32 * 128 + (((2 * d0 + hi) ^ ((r32 >> 1) & 7)) << 4);
    const lds_cptr vp0 = (lds_cptr)shm + LDS_V + ((lane >> 4) & 1) * 32 + (lane & 3) * 8 + (4 * hi + ((lane & 15) >> 2)) * 64;
    const int kkey = 8 * wid + (lane >> 3), kch = ((lane & 7) ^ ((kkey >> 1) & 7)) * 8, vkey = 16 * (wid & 3) + (lane >> 2), vch = (wid >> 2) * 32 + (lane & 3) * 8;
    float gq = __builtin_fabsf(A.qg[lane]), gk = __builtin_fabsf(A.kg[lane]);
    gq = lx_wave_max(gq); gk = lx_wave_max(gk);
    const float Mb = 64.0f * 0.125f * 1.4426950408889634f * 1.02f * gq * gk;
    f32x16 negm;
#pragma unroll
    for (int r = 0; r < 16; ++r) negm[r] = -Mb;
    const __amdgpu_buffer_rsrc_t o1_rsrc = __builtin_amdgcn_make_buffer_rsrc((void*)A.o1, 0, SEQ * 768 * 2, 0x00020000);
    const __amdgpu_buffer_rsrc_t mix_rsrc = __builtin_amdgcn_make_buffer_rsrc((void*)A.mix, 0, SEQ * 1024 * 2, 0x00020000);
#define DIL_DECODE(k, H, P, C, BLK) const int q_##H = 3 * (v >> 5) + (k) / 3, H = q_##H >> 1, P = (k) % 3, C = (v & 31) >> (5 - 2 * P), BLK = (q_##H & 1) * (32 >> (2 * P)) + ((v & 31) & ((32 >> (2 * P)) - 1))
#define DIL_ISSUE_K(H, P, C, BLK, KB) do { const int rsh_ = 2 * P; const unsigned kdst = kdst0 + (KB) * (LDS_K2 - LDS_K); const unsigned vo_ = (unsigned)((prow(C + (kkey << rsh_)) * 64 + kch) * 2); \
        const char* kb_ = (const char*)(A.proj + (size_t)(T_KD + H) * TSTRIDE) + (long)((BLK * 256 - 128) << rsh_) * (PROJ_PAD ? 136 : 128); \
        _Pragma("unroll") for (int j = 0; j < 6; ++j) glds16s(vo_, kb_ + (long)((64 * j) << rsh_) * (PROJ_PAD ? 136 : 128), (unsigned)__builtin_amdgcn_readfirstlane(kdst + j * SLOTB)); } while (0)
#define DIL_ISSUE_V(H, P, C, BLK) do { const int rsh_ = 2 * P; const unsigned vo_ = (unsigned)((prow(C + (vkey << rsh_)) * 64 + vch) * 2); \
        const char* vb_ = (const char*)(A.proj + (size_t)(T_VD + H) * TSTRIDE) + (long)((BLK * 256 - 128) << rsh_) * (PROJ_PAD ? 136 : 128); \
        _Pragma("unroll") for (int j = 0; j < 6; ++j) glds16s(vo_, vb_ + (long)((64 * j) << rsh_) * (PROJ_PAD ? 136 : 128), (unsigned)__builtin_amdgcn_readfirstlane(vdst + j * SLOTB)); } while (0)
#define DIL_LOADQ(QR, H, P, C, BLK) do { const bf16_t* Qp_ = A.proj + (size_t)(T_QD + H) * TSTRIDE + (size_t)prow(C + ((BLK * 256 + wid * 32 + r32) << (2 * P))) * 64; \
        _Pragma("unroll") for (int d0 = 0; d0 < 4; ++d0) QR[d0] = *(const bf16x8*)(Qp_ + d0 * 16 + hi * 8); } while (0)
    if (G != 256) return;
    bf16x8 qr[4];
    { DIL_DECODE(0, h0, p0_, c0, b0); DIL_ISSUE_K(h0, p0_, c0, b0, 0); DIL_LOADQ(qr, h0, p0_, c0, b0); DIL_ISSUE_V(h0, p0_, c0, b0); }
    for (int k = 0; k < 9; ++k) {
        DIL_DECODE(k, h, p, c, blk);
        const int rsh = 2 * p, u0 = blk * 256;
        if (k == 0) asm volatile("s_waitcnt vmcnt(6) lgkmcnt(0)\n\ts_barrier" ::: "memory"); else asm volatile("s_waitcnt vmcnt(11) lgkmcnt(0)\n\ts_barrier" ::: "memory");
        const int kb = k & 1; const lds_cptr ks0 = ks00 + kb * (LDS_K2 - LDS_K);
        if (k + 1 < 9) { DIL_DECODE(k + 1, hn, pn, cn, bn); DIL_ISSUE_K(hn, pn, cn, bn, kb ^ 1); }
        unsigned pw[5][8]; float l_reg = 0.f;
#pragma unroll
        for (int hh = 0; hh < 5; ++hh) {
            const int ht = wid + hh;
#pragma unroll
            for (int e = 0; e < 8; ++e) pw[hh][e] = 0u;
            if (blk == 0 && ht < 4) continue;
            const lds_cptr ks = ks0 + (ht >> 1) * SLOTB + (ht & 1) * 4096;
            f32x16 s;
#pragma unroll
            for (int d0 = 0; d0 < 4; ++d0) { const bf16x8 b = *(const ATT_LAS bf16x8*)(ks + koff[d0]); s = __builtin_amdgcn_mfma_f32_32x32x16_bf16(b, qr[d0], d0 == 0 ? negm : s, 0, 0, 0); }
#pragma unroll
            for (int g = 0; g < 4; ++g) { float a[4];
#pragma unroll
                for (int e = 0; e < 4; ++e) { float vv = __builtin_amdgcn_exp2f(s[4 * g + e]);
                    const int dd = 8 * g + 4 * hi + e - r32;
                    if (hh == 0) { if (dd < 0) vv = 0.f; } else if (hh == 4) { if (dd > 0) vv = 0.f; }
                    a[e] = vv; l_reg += vv; }
                pw[hh][2 * g] = cvtpk_s(a[0], a[1]); pw[hh][2 * g + 1] = cvtpk_s(a[2], a[3]); }
        }
        l_reg = lx_sum32(l_reg);
        unsigned* const gc = A.gcnt + (3 * (v >> 5) + k / 3) * 64;
        if (p == 2 && wid == 0) {
            unsigned spins = 0u;
            while (__hip_atomic_load(gc, __ATOMIC_RELAXED, __HIP_MEMORY_SCOPE_AGENT) < 32u) { __builtin_amdgcn_s_sleep(2); if (++spins > (1u << 22)) break; }
            __builtin_amdgcn_fence(__ATOMIC_ACQUIRE, "agent"); asm volatile("s_waitcnt vmcnt(0)" ::: "memory"); }
        if (k == 8) asm volatile("s_waitcnt vmcnt(0) lgkmcnt(0)\n\ts_barrier" ::: "memory");
        else if (k % 3 == 1) asm volatile("s_waitcnt vmcnt(11) lgkmcnt(0)\n\ts_barrier" ::: "memory"); else asm volatile("s_waitcnt vmcnt(6) lgkmcnt(0)\n\ts_barrier" ::: "memory");
        u32x4 a0[4], a1[4], gvv[4]; float lsum = 0.f;
        if (p == 2) { const bf16_t* Gh = A.proj + (size_t)(T_GD + h) * TSTRIDE;
#pragma unroll
            for (int i = 0; i < 4; ++i) { const int t = c + ((u0 + wid * 32 + i * 8 + (lane >> 3)) << rsh);
                a0[i] = *(const u32x4*)(A.o1 + (size_t)t * 768 + h * 64 + (lane & 7) * 8); a1[i] = *(const u32x4*)(A.mix + (size_t)t * 1024 + 256 + h * 64 + (lane & 7) * 8);
                gvv[i] = *(const u32x4*)(Gh + (size_t)prow(t) * 64 + (lane & 7) * 8); }
            const int tq0 = c + ((u0 + wid * 32 + r32) << rsh); lsum = A.lp[((size_t)0 * SEQ + tq0) * 12 + h] + A.lp[((size_t)1 * SEQ + tq0) * 12 + h]; }
        if (k + 1 < 9) { DIL_DECODE(k + 1, hn, pn, cn, bn); DIL_LOADQ(qr, hn, pn, cn, bn); }
        f32x16 o[2];
        o[0] = f32x16{}; o[1] = f32x16{};
#pragma unroll
        for (int hh = 0; hh < 5; ++hh) {
            const int ht = wid + hh;
            if (blk == 0 && ht < 4) continue;
            const lds_cptr vp = vp0 + (ht >> 1) * SLOTB + (ht & 1) * 2048;
            const bf16x8 pa0 = __builtin_bit_cast(bf16x8, (u32x4){pw[hh][0], pw[hh][1], pw[hh][2], pw[hh][3]}), pa1 = __builtin_bit_cast(bf16x8, (u32x4){pw[hh][4], pw[hh][5], pw[hh][6], pw[hh][7]});
#pragma unroll
            for (int d0 = 0; d0 < 2; ++d0) { const s16x4 l0 = vtr(vp + d0 * 4096), h0_ = vtr(vp + d0 * 4096 + 512), l1 = vtr(vp + d0 * 4096 + 1024), h1_ = vtr(vp + d0 * 4096 + 1536);
                o[d0] = __builtin_amdgcn_mfma_f32_32x32x16_bf16((bf16x8){l0[0], l0[1], l0[2], l0[3], h0_[0], h0_[1], h0_[2], h0_[3]}, pa0, o[d0], 0, 0, 0);
                o[d0] = __builtin_amdgcn_mfma_f32_32x32x16_bf16((bf16x8){l1[0], l1[1], l1[2], l1[3], h1_[0], h1_[1], h1_[2], h1_[3]}, pa1, o[d0], 0, 0, 0); }
        }
        ATT_BAR_L();
        if (p == 0 && k + 1 < 9) { DIL_DECODE(k + 1, hn, pn, cn, bn); DIL_ISSUE_V(hn, pn, cn, bn); }
        { const int tq = c + ((u0 + wid * 32 + r32) << rsh);
          if (p == 2 && hi == 0) wsf[r32] = __builtin_amdgcn_rcpf(lsum + l_reg);
          u32x4 sv[4]; ot_rows(o, shm + LDS_K + kb * (LDS_K2 - LDS_K) + wid * 4096, r32, hi, lane, sv);
          asm volatile("" ::: "memory");
          if (p != 2) {
#pragma unroll
              for (int i = 0; i < 4; ++i) { const int t = c + ((u0 + wid * 32 + i * 8 + (lane >> 3)) << rsh);
                  if (p == 0) __builtin_amdgcn_raw_buffer_store_b128(sv[i], o1_rsrc, (unsigned)((t * 768 + h * 64 + (lane & 7) * 8) * 2), 0, 16);
                  else __builtin_amdgcn_raw_buffer_store_b128(sv[i], mix_rsrc, (unsigned)((t * 1024 + 256 + h * 64 + (lane & 7) * 8) * 2), 0, 16); }
              if (hi == 0) __hip_atomic_store((unsigned*)(A.lp + ((size_t)p * SEQ + tq) * 12 + h), __float_as_uint(l_reg), __ATOMIC_RELAXED, __HIP_MEMORY_SCOPE_AGENT);
              asm volatile("" ::: "memory");
              if (p == 1) {
                  asm volatile("s_waitcnt vmcnt(0) lgkmcnt(0)\n\ts_barrier" ::: "memory");
                  if (tid == 0) __hip_atomic_fetch_add(gc, 1u, __ATOMIC_RELAXED, __HIP_MEMORY_SCOPE_AGENT);
                  if (k + 1 < 9) { DIL_DECODE(k + 1, hn, pn, cn, bn); DIL_ISSUE_V(hn, pn, cn, bn); }
              }
          } else {
              float inv[4];
#pragma unroll
              for (int i = 0; i < 4; ++i) inv[i] = wsf[i * 8 + (lane >> 3)];
#pragma unroll
              for (int i = 0; i < 4; ++i) { u32x4 w;
#pragma unroll
                  for (int e = 0; e < 4; ++e) {
                      const float lo = (__uint_as_float(a0[i][e] << 16) + __uint_as_float(a1[i][e] << 16) + __uint_as_float(sv[i][e] << 16)) * inv[i] * __uint_as_float(gvv[i][e] << 16);
                      const float hi2 = (__uint_as_float(a0[i][e] & 0xffff0000u) + __uint_as_float(a1[i][e] & 0xffff0000u) + __uint_as_float(sv[i][e] & 0xffff0000u)) * inv[i] * __uint_as_float(gvv[i][e] & 0xffff0000u);
                      w[e] = cvtpk_s(lo, hi2); }
                  sv[i] = w; }
              asm volatile("" ::: "memory");
#pragma unroll
              for (int i = 0; i < 4; ++i) { const int t = c + ((u0 + wid * 32 + i * 8 + (lane >> 3)) << rsh); *(u32x4*)(A.mix + (size_t)t * 1024 + 256 + h * 64 + (lane & 7) * 8) = sv[i]; }
              if (hi == 0) A.lp[((size_t)2 * SEQ + tq) * 12 + h] = l_reg;
              asm volatile("" ::: "memory");
              if (k + 1 < 9) { DIL_DECODE(k + 1, hn, pn, cn, bn); DIL_ISSUE_V(hn, pn, cn, bn); }
          } }
    }
#undef DIL_DECODE
#undef DIL_ISSUE_K
#undef DIL_ISSUE_V
#undef DIL_LOADQ
    ATT_BAR_L();
}
#undef ATT_WAIT_BAR
#undef ATT_BAR_L
}
constexpr int NWAVES = 8;
constexpr int N_LAUNCHES = MK_N_LAUNCHES;
constexpr int DEPTH = 4, SEQ = 16384, DM = 1024, NIN = 4096;
constexpr int N_PHASES = 1 + 3 * DEPTH;
constexpr size_t MiB = 1u << 20;
constexpr size_t WS_CTL = 0, CTL_ZERO_BYTES = 128 * 1024;
constexpr size_t WS_ROPE = 1 * MiB;
constexpr size_t WS_SSQ = 2 * MiB;
constexpr size_t WS_LP = 3 * MiB;
constexpr size_t WS_W = 6 * MiB, W_STRIDE = 10 * MiB, W_OUT_OFF = 8 * MiB;
constexpr size_t WS_XB = 46 * MiB;
constexpr size_t WS_MIX = 78 * MiB;
constexpr size_t WS_PROJ = 110 * MiB;
constexpr size_t WS_XL = 238 * MiB;
constexpr size_t WS_END = 254 * MiB;
static_assert(PROJ_PAD == 0, "workspace map assumes unpadded head tensors");
constexpr int CW_BAR = 4096;
static_assert((16384 + 4 * 8 * 3 * 64) * 4 <= 128 * 1024, "control words inside the memset region");
constexpr int CW_GRP = 16384;
constexpr int RING_OFF = 0, RING_BYTES = 131072;
constexpr int LDSCTL_OFF = 151552, MISC_OFF = LDSCTL_OFF + 320;
constexpr int LDS_BYTES = 153600;
static_assert(att::LDS_END <= LDSCTL_OFF && RING_BYTES <= LDSCTL_OFF, "phase scratch below the control words");

#define GAS __attribute__((address_space(1)))
#define LAS __attribute__((address_space(3)))
typedef unsigned short bf16;
typedef unsigned v4u __attribute__((ext_vector_type(4)));
typedef float f32x4 __attribute__((ext_vector_type(4)));
typedef GAS unsigned gu32;
#define RLX_AGENT __ATOMIC_RELAXED, __HIP_MEMORY_SCOPE_AGENT
#define LDS_WAIT() asm volatile("s_waitcnt lgkmcnt(0)" ::: "memory")
#define VM_WAIT() asm volatile("s_waitcnt vmcnt(0)" ::: "memory")
__device__ __forceinline__ unsigned f2bf(float f) { unsigned u = __builtin_bit_cast(unsigned, f); return (u + 0x7fffu + ((u >> 16) & 1u)) >> 16; }
__device__ __forceinline__ unsigned pk2(float lo, float hi) { return f2bf(lo) | (f2bf(hi) << 16); }
#define XB_TMO      128
#define XB_XCNT(j)  (256  + 64 * (j))
#define XB_XSUB(j)  (1280 + 64 * (j))
#define XB_XGEN(j)  (2304 + 64 * (j))
#define XB_TOP      3328
#define XB_TOPGEN   3392
#define XCD_BAR_WORDS 3456
#define XB_SPIN_CAP (1u << 18)

__device__ __forceinline__ unsigned xb_ld(unsigned* p)              { return __hip_atomic_load(p, __ATOMIC_RELAXED, __HIP_MEMORY_SCOPE_AGENT); }
__device__ __forceinline__ unsigned xb_add(unsigned* p, unsigned v) { return __hip_atomic_fetch_add(p, v, __ATOMIC_RELAXED, __HIP_MEMORY_SCOPE_AGENT); }
__device__ __forceinline__ unsigned xb_xcc_id() { return (unsigned)__builtin_amdgcn_s_getreg((3 << 11) | 20) & 0xFu; }
#define XB_SPIN(cond, bar) do { unsigned _sp = 0; while (cond) { __builtin_amdgcn_s_sleep(1); \
    if ((++_sp & 255u) == 0u) { if (xb_ld(&(bar)[XB_TMO])) break; if (_sp > XB_SPIN_CAP) { atomicAdd(&(bar)[XB_TMO], 1u); break; } } } } while (0)

struct XcdBarrier {
    unsigned* bar; unsigned x;
    volatile LAS unsigned* st;
};

__device__ __forceinline__ XcdBarrier xcd_barrier_post(unsigned* bar, volatile LAS unsigned* st, bool leader) {
    XcdBarrier b; b.bar = bar; b.x = xb_xcc_id(); b.st = st;
    if (leader) (void)xb_add(&bar[XB_XCNT(b.x)], 1u);
    return b;
}
__device__ __forceinline__ void xcd_barrier_complete(unsigned* bar, unsigned x, unsigned& nloc, unsigned& nx) {
    const unsigned G = gridDim.x * gridDim.y * gridDim.z;
    unsigned sum, cnt, mine, sp = 0u;
    for (;;) {
        sum = 0u; cnt = 0u; mine = 0u;
#pragma unroll
        for (unsigned j = 0; j < 16; ++j) { const unsigned c = xb_ld(&bar[XB_XCNT(j)]); sum += c; cnt += (c > 0u) ? 1u : 0u; mine = (j == x) ? c : mine; }
        if (sum == G) break;
        __builtin_amdgcn_s_sleep(1);
        if ((++sp & 255u) == 0u) { if (xb_ld(&bar[XB_TMO])) break; if (sp > XB_SPIN_CAP) { atomicAdd(&bar[XB_TMO], 1u); break; } }
    }
    nloc = mine > 0u ? mine : 1u; nx = cnt > 0u ? cnt : 1u;
}

__device__ __forceinline__ void xcd_barrier(const XcdBarrier& b, bool leader) {
    asm volatile("s_waitcnt vmcnt(0)" ::: "memory");
    __syncthreads();
    if (leader) {
        unsigned* bar = b.bar;
        __builtin_amdgcn_s_waitcnt(0);
        unsigned nloc = b.st[0], nx = b.st[1];
        if (nloc == 0u) { xcd_barrier_complete(bar, b.x, nloc, nx); b.st[0] = nloc; b.st[1] = nx; }
        const unsigned old = xb_add(&bar[XB_XSUB(b.x)], 1u);
        const unsigned gen = old / nloc;
        if (old + 1u == (gen + 1u) * nloc) {
            __builtin_amdgcn_fence(__ATOMIC_RELEASE, "agent");
            asm volatile("s_waitcnt vmcnt(0)" ::: "memory");
            const unsigned og = xb_add(&bar[XB_TOP], 1u);
            const unsigned tg = og / nx;
            if (og + 1u == (tg + 1u) * nx) xb_add(&bar[XB_TOPGEN], 1u);
            else XB_SPIN(xb_ld(&bar[XB_TOPGEN]) == tg, bar);
            __builtin_amdgcn_fence(__ATOMIC_ACQUIRE, "agent");
            xb_add(&bar[XB_XGEN(b.x)], 1u);
            asm volatile("s_waitcnt vmcnt(0)" ::: "memory");
        } else {
            XB_SPIN(xb_ld(&bar[XB_XGEN(b.x)]) == gen, bar);
            __builtin_amdgcn_fence(__ATOMIC_ACQUIRE, "agent");
            asm volatile("s_waitcnt vmcnt(0)" ::: "memory");
        }
    }
    __syncthreads();
}
__device__ __forceinline__ float wave_sum(float v) {
    return lx_wave_sum(v);
}
template <bool PERMN> __device__ __forceinline__ void transpose_item(const float* W, int K, int N, bf16* WT, const float* gk, LAS float* scr, int item, int lane) {
    const int nblk = N / 32, kb = item / nblk, nb = item % nblk, k0 = 64 * kb, n0 = 32 * nb;
    float wv[32];
#pragma unroll
    for (int i = 0; i < 32; ++i) wv[i] = W[(size_t)(k0 + 2 * i + (lane >> 5)) * N + n0 + (lane & 31)];
    if (gk) {
#pragma unroll
        for (int i = 0; i < 32; ++i) wv[i] *= gk[k0 + 2 * i + (lane >> 5)]; }
#pragma unroll
    for (int i = 0; i < 32; ++i) scr[(2 * i + (lane >> 5)) * 33 + (lane & 31)] = wv[i];
    LDS_WAIT(); asm volatile("" ::: "memory");
    const int c = lane & 7;
#pragma unroll
    for (int j = 0; j < 4; ++j) { const int n = (lane >> 3) + 8 * j; const LAS float* s = scr + (8 * c) * 33 + n;
        v4u o; o.x = pk2(s[0 * 33], s[1 * 33]); o.y = pk2(s[2 * 33], s[3 * 33]); o.z = pk2(s[4 * 33], s[5 * 33]); o.w = pk2(s[6 * 33], s[7 * 33]);
        const int col = n0 + n; const int pos = PERMN ? ((col & ~255) + 128 * ((col >> 5) & 1) + 32 * ((col >> 6) & 3) + (col & 31)) : col;
        *(GAS v4u*)(WT + (size_t)pos * K + k0 + 8 * c) = o; }
    LDS_WAIT(); asm volatile("" ::: "memory");
}
struct KArgs { const float* x; const float* norm_g; const float* w_in; const float* q_norm_g; const float* k_norm_g; const float* w_out; float* out; unsigned char* ws; int ph_lo, ph_hi; };

__device__ __forceinline__ void convert_weights(const KArgs& a, int l, LAS unsigned char* lds, int vcu, int G, int wave0) {
    const int wave = wave0; const int tid = lx_tid(wave); const int lane = tid & 63; const int gw = vcu * NWAVES + wave, NGW = G * NWAVES;
    LAS float* scr = (LAS float*)(lds + RING_OFF + wave * 16384);
    bf16* WinT = (bf16*)(a.ws + WS_W + (size_t)l * W_STRIDE); bf16* WoutT = (bf16*)(a.ws + WS_W + (size_t)l * W_STRIDE + W_OUT_OFF);
    constexpr int I_IN = (DM / 64) * (NIN / 32), I_OUT = (DM / 64) * (DM / 32);
    for (int it = gw; it < I_IN + I_OUT; it += NGW) {
        if (it < I_IN) transpose_item<true>(a.w_in + (size_t)l * DM * NIN, DM, NIN, WinT, a.norm_g + l * DM, scr, it, lane);
        else transpose_item<false>(a.w_out + (size_t)l * DM * DM, DM, DM, WoutT, nullptr, scr, it - I_IN, lane);
    }
}
__device__ __forceinline__ void sincos_acc(float angf, float& c, float& s) {
    const double ang = (double)angf; const double kq = __builtin_rint(ang * 0.63661977236758134308);
    const double r = __builtin_fma(-kq, 1.5707963267948966192, ang) - kq * 6.123233995736766036e-17; const double r2 = r * r;
    double sp = -1.0 / 1307674368000.0; sp = sp * r2 + 1.0 / 6227020800.0; sp = sp * r2 - 1.0 / 39916800.0; sp = sp * r2 + 1.0 / 362880.0; sp = sp * r2 - 1.0 / 5040.0; sp = sp * r2 + 1.0 / 120.0; sp = sp * r2 - 1.0 / 6.0; sp = sp * r2 * r + r;
    double cp = 1.0 / 87178291200.0; cp = cp * r2 - 1.0 / 479001600.0; cp = cp * r2 + 1.0 / 3628800.0; cp = cp * r2 - 1.0 / 40320.0; cp = cp * r2 + 1.0 / 720.0; cp = cp * r2 - 1.0 / 24.0; cp = cp * r2 + 0.5; cp = 1.0 - cp * r2;
    const int q = ((int)kq) & 3;
    const double sv = (q == 0) ? sp : (q == 1) ? cp : (q == 2) ? -sp : -cp, cv = (q == 0) ? cp : (q == 1) ? -sp : (q == 2) ? -cp : sp;
    c = (float)cv; s = (float)sv;
}
__device__ __forceinline__ float inv_freq(int i) {
    return i == 0 ? 1.0f : i == 1 ? 0.193922758102417f : i == 2 ? 0.03760603070259094f : i == 3 ? 0.00729266507551074f : i == 4 ? 0.001414213445968926f : i == 5 ? 0.00027424818836152554f : i == 6 ? 5.318296462064609e-05f : 1.0313385246263351e-05f;
}

__global__ void __launch_bounds__(NWAVES * 64, 2) hsdg_fwd(KArgs args) {
    extern __shared__ __attribute__((aligned(16))) unsigned char lds_raw[];
    LAS unsigned char* lds = (LAS unsigned char*)lds_raw;
    volatile LAS unsigned* MISC = (volatile LAS unsigned*)(lds + MISC_OFF);
    const int wave0 = __builtin_amdgcn_readfirstlane((int)threadIdx.x >> 6); const int tid0 = lx_tid(wave0);
    const int G = gridDim.x; const int bx = blockIdx.x; const int vcu = (G % 8 == 0) ? (bx % 8) * (G / 8) + bx / 8 : bx;
    unsigned char* ws = args.ws;
    gu32* ctl = (gu32*)(ws + WS_CTL);
    for (int u = tid0; u < (LDS_BYTES - LDSCTL_OFF) / 4; u += NWAVES * 64) ((LAS unsigned*)(lds + LDSCTL_OFF))[u] = 0u;
    __syncthreads();
    XcdBarrier bar; bar.bar = (unsigned*)(ctl + CW_BAR); bar.x = 0; bar.st = nullptr;
    if (N_LAUNCHES == 1) bar = xcd_barrier_post((unsigned*)(ctl + CW_BAR), MISC + 8, tid0 == 0);
#define GRID_BAR() do { if (N_LAUNCHES == 1) xcd_barrier(bar, lx_tid(wave0) == 0); } while (0)
    const int lo = args.ph_lo, hi = args.ph_hi;
#define IN(k) (lo <= (k) && (k) < hi)
#define BOTH(k) (IN(k) && IN((k) + 1))
#define PHASE_PTRS() unsigned char* wsp = ws; asm volatile("" : "+s"(wsp)); float* rope = (float*)(wsp + WS_ROPE); float* ssq = (float*)(wsp + WS_SSQ); float* lp = (float*)(wsp + WS_LP); \
        bf16* XB = (bf16*)(wsp + WS_XB); unsigned char* XL = wsp + WS_XL; (void)XL; bf16* MIX = (bf16*)(wsp + WS_MIX); bf16* PROJ = (bf16*)(wsp + WS_PROJ); (void)rope; (void)ssq; (void)lp; (void)XB; (void)MIX; (void)PROJ

    if (IN(0)) {
        PHASE_PTRS(); for (int l = 0; l < DEPTH; ++l) convert_weights(args, l, lds, vcu, G, wave0);
        const int wave = wave0; const int tid = lx_tid(wave); const int lane = tid & 63; const int gw = vcu * NWAVES + wave, NGW = G * NWAVES;
        for (int m = gw; m < SEQ; m += 4 * NGW) {
            f32x4 v[4][4]; float s2[4];
#pragma unroll
            for (int q = 0; q < 4; ++q) { const int mm = m + q * NGW; const GAS f32x4* xr = (const GAS f32x4*)(args.x + (size_t)(mm < SEQ ? mm : m) * DM) + lane;
#pragma unroll
                for (int j = 0; j < 4; ++j) v[q][j] = xr[64 * j]; }
#pragma unroll
            for (int q = 0; q < 4; ++q) { float a = 0.f;
#pragma unroll
                for (int j = 0; j < 4; ++j) a += (v[q][j].x * v[q][j].x + v[q][j].y * v[q][j].y) + (v[q][j].z * v[q][j].z + v[q][j].w * v[q][j].w);
                s2[q] = wave_sum(a); }
#pragma unroll
            for (int q = 0; q < 4; ++q) { const int mm = m + q * NGW; if (mm < SEQ) {
                GAS unsigned long long* o8 = (GAS unsigned long long*)(XB + (size_t)mm * DM) + lane;
#pragma unroll
                for (int j = 0; j < 4; ++j) { const unsigned h0 = pk2(v[q][j].x, v[q][j].y), h1 = pk2(v[q][j].z, v[q][j].w); o8[64 * j] = (unsigned long long)h0 | ((unsigned long long)h1 << 32);
                    ((GAS unsigned*)(XL + (size_t)mm * DM))[lane + 64 * j] = xs_lo(v[q][j].x, h0 << 16) | (xs_lo(v[q][j].y, h0 & 0xffff0000u) << 8) | (xs_lo(v[q][j].z, h1 << 16) << 16) | (xs_lo(v[q][j].w, h1 & 0xffff0000u) << 24); }
                if (lane < 4) ssq[(size_t)mm * 4 + lane] = (lane == 0) ? s2[q] : 0.f; } }
        }
        for (int i = bx * (NWAVES * 64) + tid; i < SEQ * 8; i += G * NWAVES * 64) { const int pos = i >> 3, k = i & 7; float c, s; sincos_acc((float)pos * inv_freq(k), c, s); rope[pos * 16 + k] = c; rope[pos * 16 + 8 + k] = s; }
        if (BOTH(0)) GRID_BAR();
    }
    for (int l = 0; l < DEPTH; ++l) {
        const int pA = 1 + 3 * l, pB = pA + 1, pC = pA + 2;
        if (IN(pA)) {
            PHASE_PTRS(); bf16* WinT = (bf16*)(wsp + WS_W + (size_t)l * W_STRIDE); const float* qg = args.q_norm_g + l * 64; const float* kg = args.k_norm_g + l * 64;
            pg8::Gemm g{XB, WinT, SEQ, NIN, DM}; pg8::StaticOrder S; S.init(SEQ, NIN, G, bx);
            { static_assert(pg8::EpiInProj::OFF_ROPE == WS_ROPE && pg8::EpiInProj::OFF_SSQ == WS_SSQ && pg8::EpiInProj::OFF_P == WS_PROJ, "workspace offsets"); pg8::EpiInProj E{wsp, qg, kg, 0};
#if PROBE_A
            const int nrep = (l == 0) ? 2 : 1;
            for (int rep = 0; rep < nrep; ++rep) { E.cheap = __builtin_amdgcn_readfirstlane((rep + 1 < nrep) ? (PROBE_A == 1) : 0);
            pg8::gemm_phase<pg8::EpiInProj, pg8::StaticOrder, true, true>(lds + RING_OFF, g, S, E, wave0); if (rep + 1 < nrep) GRID_BAR(); } }
#else
            pg8::gemm_phase<pg8::EpiInProj, pg8::StaticOrder, true, true>(lds + RING_OFF, g, S, E, wave0); }
#endif
            if (BOTH(pA)) GRID_BAR();
        }
        if (IN(pB)) {
            PHASE_PTRS(); const float* qg = args.q_norm_g + l * 64; const float* kg = args.k_norm_g + l * 64; gu32* ctlp = (gu32*)(wsp + WS_CTL);
            const att::SbArgs SA{PROJ, MIX};
            const att::DilArgs DA{PROJ, (bf16*)args.out, MIX, lp, (unsigned*)(ctlp + CW_GRP + l * 8 * 3 * 64), qg, kg};
            for (int u = vcu; u < 256; u += G) att::sb_unit<SB_EARLY_EXIT != 0>(u >> 6, u & 63, SA, (att::lds_ptr)(lds + RING_OFF), wave0);
            att::dil_phase<0>(vcu, G, DA, (att::lds_ptr)(lds + RING_OFF), wave0);
            if (BOTH(pB)) GRID_BAR();
        }
        if (IN(pC)) {
            PHASE_PTRS(); bf16* WoutT = (bf16*)(wsp + WS_W + (size_t)l * W_STRIDE + W_OUT_OFF);
            pg8::Gemm g{MIX, WoutT, SEQ, DM, DM}; pg8::StaticOrder S; S.init(SEQ, DM, G, bx);
            pg8::EpiOutProj E{XB, XL, args.out, ssq, l == DEPTH - 1 ? 1 : 0};
            pg8::gemm_phase<pg8::EpiOutProj, pg8::StaticOrder, false, true>(lds + RING_OFF, g, S, E, wave0);
            if (pC + 1 < N_PHASES && BOTH(pC)) GRID_BAR();
        }
    }
#undef IN
#undef BOTH
#undef GRID_BAR
}

extern "C" void kernel_launch(void* const* d_in, const int* in_sizes, int n_in, void* d_out, int out_size, void* d_ws, size_t ws_size, hipStream_t stream) {
    static int grid = 0;
    if (grid == 0) {
        if (n_in != 6 || in_sizes[0] != SEQ * DM || out_size != SEQ * DM || ws_size < WS_END) { fprintf(stderr, "kernel_launch: unexpected shapes / workspace (n_in %d, in0 %d, out %d, ws %zu, need %zu)\n", n_in, n_in > 0 ? in_sizes[0] : -1, out_size, ws_size, (size_t)WS_END); grid = -1; return; }
        int dev = 0, cus = 0, per_cu = 0;
        if (hipGetDevice(&dev) != hipSuccess || hipDeviceGetAttribute(&cus, hipDeviceAttributeMultiprocessorCount, dev) != hipSuccess) { fprintf(stderr, "kernel_launch: device query failed\n"); grid = -1; return; }
        if (hipFuncSetAttribute((const void*)hsdg_fwd, hipFuncAttributeMaxDynamicSharedMemorySize, LDS_BYTES) != hipSuccess) { fprintf(stderr, "kernel_launch: hipFuncSetAttribute failed\n"); grid = -1; return; }
        if (hipOccupancyMaxActiveBlocksPerMultiprocessor(&per_cu, (const void*)hsdg_fwd, NWAVES * 64, LDS_BYTES) != hipSuccess || per_cu < 1) fprintf(stderr, "kernel_launch: note: occupancy query reports %d workgroups per CU\n", per_cu);
        (void)hipGetLastError();
        grid = cus;
        if (grid != 256) fprintf(stderr, "kernel_launch: %d CUs; the out-proj phase assumes 256 workgroups\n", grid);
    }
    if (grid < 0) return;
    if (hipMemsetAsync((char*)d_ws + WS_CTL, 0, CTL_ZERO_BYTES, stream) != hipSuccess) { fprintf(stderr, "kernel_launch: hipMemsetAsync failed\n"); return; }
    KArgs a{};
    a.x = (const float*)d_in[0]; a.norm_g = (const float*)d_in[1]; a.w_in = (const float*)d_in[2]; a.q_norm_g = (const float*)d_in[3]; a.k_norm_g = (const float*)d_in[4]; a.w_out = (const float*)d_in[5];
    a.out = (float*)d_out; a.ws = (unsigned char*)d_ws;
    if (N_LAUNCHES == 1) { a.ph_lo = 0; a.ph_hi = N_PHASES; hipLaunchKernelGGL(hsdg_fwd, dim3(grid), dim3(NWAVES * 64), LDS_BYTES, stream, a); }
    else for (int ph = 0; ph < N_PHASES; ++ph) { a.ph_lo = ph; a.ph_hi = ph + 1; hipLaunchKernelGGL(hsdg_fwd, dim3(grid), dim3(NWAVES * 64), LDS_BYTES, stream, a); }
    const hipError_t le = hipPeekAtLastError();
    if (le != hipSuccess) fprintf(stderr, "kernel_launch: launch failed: %s\n", hipGetErrorName(le));
}
```

```cpp
#include <hip/hip_runtime.h>
#include <cstdio>
#include <cstdint>
#ifndef MK_N_LAUNCHES
#define MK_N_LAUNCHES 1
#endif
#ifndef PROJ_PAD
#define PROJ_PAD 0
#endif
#ifndef SB_EARLY_EXIT
#define SB_EARLY_EXIT 1
#endif
template <int X> __device__ __forceinline__ float lx_xor(float v) { return __builtin_bit_cast(float, __builtin_amdgcn_ds_swizzle(__builtin_bit_cast(int, v), (X << 10) | 0x1f)); }
__device__ __forceinline__ int lx_lane() { int l; asm volatile("v_mbcnt_lo_u32_b32 %0, -1, 0\n\tv_mbcnt_hi_u32_b32 %0, -1, %0" : "=v"(l)); return l; }
__device__ __forceinline__ float lx_xor32(float v) { return __builtin_bit_cast(float, __builtin_amdgcn_ds_bpermute((lx_lane() ^ 32) << 2, __builtin_bit_cast(int, v))); }
__device__ __forceinline__ float lx_sum32(float v) { return v + lx_xor32(v); }
__device__ __forceinline__ float lx_max32(float v) { return __builtin_fmaxf(v, lx_xor32(v)); }
__device__ __forceinline__ float lx_wave_sum(float v) { v += lx_xor<1>(v); v += lx_xor<2>(v); v += lx_xor<4>(v); v += lx_xor<8>(v); v += lx_xor<16>(v); return lx_sum32(v); }
__device__ __forceinline__ float lx_wave_max(float v) { v = __builtin_fmaxf(v, lx_xor<1>(v)); v = __builtin_fmaxf(v, lx_xor<2>(v)); v = __builtin_fmaxf(v, lx_xor<4>(v)); v = __builtin_fmaxf(v, lx_xor<8>(v)); v = __builtin_fmaxf(v, lx_xor<16>(v)); return lx_max32(v); }
__device__ __forceinline__ int lx_tid(int wave) { return wave * 64 + lx_lane(); }
__device__ __forceinline__ unsigned xs_lo(float x, unsigned hi_shl16) { const unsigned u = (__builtin_bit_cast(unsigned, x) - hi_shl16 + 0x8080u) >> 8; return u < 255u ? u : 255u; }
__device__ __forceinline__ float xs_join(unsigned hi_shl16, unsigned lo8) { return __builtin_bit_cast(float, hi_shl16 + (lo8 << 8) - 0x8000u); }
namespace pg8 {
#define PG8_LAS __attribute__((address_space(3)))
typedef unsigned short bf16_t;
typedef short bf16x8 __attribute__((ext_vector_type(8)));
typedef float f32x4 __attribute__((ext_vector_type(4)));
typedef unsigned u32x4 __attribute__((ext_vector_type(4)));
constexpr int BM = 256, BK = 64, HALF = 128, HTB = HALF * BK * 2  , STAGE_BYTES = 8 * HTB, NXCD = 8, WGM = 8;

__host__ __device__ __forceinline__ int lds_byte(int r, int c) { const int st = (r >> 4) * 2 + (c >> 5), rr = r & 15, cc = c & 31, ob = rr * 64 + cc * 2; return st * 1024 + (ob ^ (((ob >> 9) & 1) << 5)); }
__host__ __device__ __forceinline__ void stage_rc(int b, int& R, int& C) { const int st = b / 1024, sb = b % 1024, swz = sb ^ (((sb >> 9) & 1) << 5); R = (st >> 1) * 16 + swz / 64; C = (st & 1) * 32 + (swz % 64) / 2; }
__host__ __device__ __forceinline__ int perm32(int rho) { const int n = rho >> 4, i = rho & 15; return 8 * (i >> 2) + 4 * n + (i & 3); }

struct Unit { int pm, pn; };
struct Gemm { const bf16_t* A; const bf16_t* Bt; int M, N, K; };

struct StaticOrder {
    int nM, nN, nwg, G, c;
    __host__ __device__ void init(int M, int N, int G_, int c_) { nM = M / BM; nN = N / BM; nwg = nM * nN; G = G_; c = c_; }
    __host__ __device__ bool next(int i, Unit& u) const {
        const long L = (long)i * G + c; if (L >= nwg) return false;
        int wgid = (int)L; { const int q = nwg / NXCD, r = nwg % NXCD, xcd = wgid % NXCD, off = wgid / NXCD; wgid = (xcd < r ? xcd * (q + 1) : r * (q + 1) + (xcd - r) * q) + off; }
        const int nig = WGM * nN, gid = wgid / nig, fm = gid * WGM, gsz = (nM - fm) < WGM ? (nM - fm) : WGM;
        u.pm = fm + ((wgid % nig) % gsz); u.pn = (wgid % nig) / gsz; return true;
    }
    __device__ __forceinline__ void a_ready(const Unit&) const {}
    __device__ __forceinline__ void done(const Unit&) const {}
};

typedef float f32x2 __attribute__((ext_vector_type(2)));
typedef __bf16 bf16x2_t __attribute__((ext_vector_type(2)));
__device__ __forceinline__ unsigned cvtpk(float lo, float hi) { f32x2 v = {lo, hi}; bf16x2_t b = __builtin_convertvector(v, bf16x2_t); return __builtin_bit_cast(unsigned, b); }
constexpr int SEQ = 16384; constexpr int PROWS = SEQ + (PROJ_PAD ? SEQ / 16 : 0); constexpr size_t TSTRIDE = (size_t)PROWS * 64;
constexpr float EPSV = 1e-6f;
constexpr float QSCALE = 0.125f * 1.4426950408889634f;

struct EpiInProj {
    static constexpr bool PERM = true, AFTER_DRAIN = false; static constexpr int STORES = 16;
    unsigned char* wsb; const float* qg; const float* kg; PG8_LAS unsigned char* xl; mutable int pm_c;
    static constexpr size_t OFF_ROPE = (size_t)1 << 20, OFF_SSQ = (size_t)2 << 20, OFF_P = (size_t)110 << 20;
    static constexpr int XL_ROPE = 0, XL_RS = 16384, XL_G = 17408, XL_BYTES = 17920;
    struct Prep { f32x4 r0, r1, sq, gv; };
    static constexpr bool HAS_PREP = true;
    __device__ __forceinline__ void prep_load(Prep& pp, const Unit& u, int wr, int wc, int fr, int fq) const {
        const float* const ssq = (const float*)(wsb + OFF_SSQ); const float* const rp = (const float*)(wsb + OFF_ROPE) + (size_t)u.pm * BM * 16;
        const int t = (wr * 4 + wc) * 64 + fq * 16 + fr;
        pp.r0 = *(const f32x4*)(rp + 4 * t); pp.r1 = *(const f32x4*)(rp + 4 * (t + 512));
        pp.sq = (f32x4){0.f, 0.f, 0.f, 0.f}; pp.gv = (f32x4){0.f, 0.f, 0.f, 0.f};
        if (t < 256) pp.sq = *(const f32x4*)(ssq + (size_t)(u.pm * BM + t) * 4);
        if (t < 32) pp.gv = *(const f32x4*)((t < 16 ? qg : kg) + 4 * (t & 15)); }
    __device__ __forceinline__ void prep_store(const Prep& pp, const Unit& u, int wr, int wc, int fr, int fq) const {
        const int t = (wr * 4 + wc) * 64 + fq * 16 + fr; pm_c = u.pm;
        { const int a = t, b = t + 512;
          *(PG8_LAS f32x4*)(xl + XL_ROPE + (a >> 2) * 64 + (((a & 3) ^ ((a >> 4) & 3)) << 4)) = pp.r0; *(PG8_LAS f32x4*)(xl + XL_ROPE + (b >> 2) * 64 + (((b & 3) ^ ((b >> 4) & 3)) << 4)) = pp.r1; }
        if (t < 256) *(PG8_LAS float*)(xl + XL_RS + 4 * t) = __builtin_amdgcn_rsqf(((pp.sq[0] + pp.sq[1]) + (pp.sq[2] + pp.sq[3])) * (1.0f / 1024.0f) + EPSV);
        if (t < 32) *(PG8_LAS f32x4*)(xl + XL_G + 16 * t) = pp.gv; }
    __device__ __forceinline__ void operator()(const f32x4 (&acc)[2][2][4][2], const Unit& u, int wr, int wc, int fr, int fq) const {
        bf16_t* const P = (bf16_t*)(wsb + OFF_P);
        if (u.pm != pm_c) {
            Prep pp; prep_load(pp, u, wr, wc, fr, fq);
            __builtin_amdgcn_s_barrier();
            prep_store(pp, u, wr, wc, fr, fq);
            asm volatile("s_waitcnt lgkmcnt(0)" ::: "memory"); __builtin_amdgcn_s_barrier(); asm volatile("" ::: "memory");
        }
        const int pn = u.pn;
        const int kind = (pn == 0) ? 0 : ((pn == 3 || pn >= 13) ? 1 : ((pn >= 4 && pn <= 6) ? 2 : ((pn >= 7 && pn <= 9) ? 3 : 4)));
        bf16_t* const tens = P + (size_t)(pn * 4 + wc) * TSTRIDE + 8 * fq;
        const int rl0 = wr * 64 + fr, row0 = u.pm * BM + rl0;
        float rs[8];
#pragma unroll
        for (int j = 0; j < 8; ++j) rs[j] = *(const PG8_LAS float*)(xl + XL_RS + 4 * (rl0 + (j >> 2) * HALF + (j & 3) * 16));
        f32x4 g[2][2];
#pragma unroll
        for (int bj = 0; bj < 2; ++bj)
#pragma unroll
            for (int n = 0; n < 2; ++n) g[bj][n] = (f32x4){1.f, 1.f, 1.f, 1.f};
        if (kind == 2 || kind == 3) {
#pragma unroll
            for (int bj = 0; bj < 2; ++bj)
#pragma unroll
                for (int n = 0; n < 2; ++n) g[bj][n] = *(const PG8_LAS f32x4*)(xl + XL_G + (kind == 3 ? 256 : 0) + 4 * (32 * bj + 8 * fq + 4 * n)); }
        if (kind == 0) {
#pragma unroll
            for (int j = 0; j < 8; ++j) rs[j] *= QSCALE; }
        const PG8_LAS unsigned char* const rrow = xl + XL_ROPE + rl0 * 64; const int sw = ((fr >> 2) & 3) << 4;
#pragma unroll
        for (int ai = 0; ai < 2; ++ai)
#pragma unroll
            for (int m = 0; m < 4; ++m) {
                const int row = row0 + ai * HALF + m * 16;
                f32x4 v[2][2];
#pragma unroll
                for (int bj = 0; bj < 2; ++bj)
#pragma unroll
                    for (int n = 0; n < 2; ++n) v[bj][n] = acc[ai][bj][m][n] * rs[ai * 4 + m];
                if (kind == 1) {
#pragma unroll
                    for (int bj = 0; bj < 2; ++bj)
#pragma unroll
                        for (int n = 0; n < 2; ++n)
#pragma unroll
                            for (int e = 0; e < 4; ++e) { const float x = v[bj][n][e]; v[bj][n][e] = x * __builtin_amdgcn_rcpf(1.0f + __builtin_amdgcn_exp2f(-1.4426950408889634f * x)); }
                } else if (kind == 2 || kind == 3) {
                    f32x4 cs[2], sn[2];
#pragma unroll
                    for (int n = 0; n < 2; ++n) { cs[n] = *(const PG8_LAS f32x4*)(rrow + (ai * HALF + m * 16) * 64 + ((16 * n) ^ sw)); sn[n] = *(const PG8_LAS f32x4*)(rrow + (ai * HALF + m * 16) * 64 + ((32 + 16 * n) ^ sw)); }
                    float hs = 0.f;
#pragma unroll
                    for (int bj = 0; bj < 2; ++bj)
#pragma unroll
                        for (int n = 0; n < 2; ++n) { const f32x4 x = v[bj][n]; hs += (x[0] * x[0] + x[1] * x[1]) + (x[2] * x[2] + x[3] * x[3]); }
                    hs += lx_xor<16>(hs); hs = lx_sum32(hs);
                    const float hr = __builtin_amdgcn_rsqf(hs * (1.0f / 64.0f) + EPSV) * (kind == 2 ? QSCALE : 1.0f);
#pragma unroll
                    for (int bj = 0; bj < 2; ++bj)
#pragma unroll
                        for (int n = 0; n < 2; ++n) v[bj][n] = v[bj][n] * hr * g[bj][n];
#pragma unroll
                    for (int n = 0; n < 2; ++n)
#pragma unroll
                        for (int e = 0; e < 4; ++e) { const float cc = cs[n][e], ss2 = sn[n][e];
                            const float own = v[0][n][e]; const float oth = lx_xor<16>(own);
                            const float r0 = own * cc - oth * ss2, r1 = own * cc + oth * ss2;
                            v[0][n][e] = (fq == 0) ? r0 : ((fq == 1) ? r1 : own); }
                }
                bf16_t* rowp = tens + (size_t)(PROJ_PAD ? row + (row >> 4) : row) * 64;
#pragma unroll
                for (int bj = 0; bj < 2; ++bj) { u32x4 w; w.x = cvtpk(v[bj][0][0], v[bj][0][1]); w.y = cvtpk(v[bj][0][2], v[bj][0][3]); w.z = cvtpk(v[bj][1][0], v[bj][1][1]); w.w = cvtpk(v[bj][1][2], v[bj][1][3]);
                    *(u32x4*)(rowp + 32 * bj) = w; }
            }
    }
};

typedef unsigned u32x2 __attribute__((ext_vector_type(2)));
struct EpiOutProj {
    static constexpr bool PERM = true, AFTER_DRAIN = true, HAS_PREP = false; static constexpr int STORES = 0;
    bf16_t* xh; unsigned char* xl; float* xout; float* ssq; int last;
    struct Pre { u32x4 ph[2][2][2]; u32x2 pl[2][2][2]; };
    static constexpr int PRELOADS = 16;
#define EOP_LOAD(buf, pr) do { _Pragma("unroll") for (int q_ = 0; q_ < 2; ++q_) { const int j_ = 2 * (pr) + q_; const size_t o_ = off0 + (size_t)((j_ >> 2) * HALF + (j_ & 3) * 16) * 1024; \
            _Pragma("unroll") for (int bj = 0; bj < 2; ++bj) { ph[buf][q_][bj] = *(const u32x4*)(xh + o_ + bj * HALF); pl[buf][q_][bj] = *(const u32x2*)(xl + o_ + bj * HALF); } } } while (0)
    __device__ __forceinline__ void preload(Pre& P, const Unit& u, int wr, int wc, int fr, int fq) const {
        const size_t off0 = (size_t)(u.pm * BM + wr * 64 + fr) * 1024 + u.pn * BM + wc * 32 + 8 * fq; auto& ph = P.ph; auto& pl = P.pl;
        EOP_LOAD(0, 0); asm volatile("" ::: "memory"); EOP_LOAD(1, 1); asm volatile("" ::: "memory"); }
    __device__ __forceinline__ void fused(f32x4 (&acc)[2][2][4][2], const Unit& u, int wr, int wc, int fr, int fq, PG8_LAS unsigned char* lds, int wid, int lane, Pre& P) const {
        PG8_LAS float* Pw = (PG8_LAS float*)lds;
        const size_t off0 = (size_t)(u.pm * BM + wr * 64 + fr) * 1024 + u.pn * BM + wc * 32 + 8 * fq;
        auto& ph = P.ph; auto& pl = P.pl;
#pragma unroll
        for (int pr = 0; pr < 4; ++pr) {
#pragma unroll
            for (int q = 0; q < 2; ++q) { const int j = 2 * pr + q, ai = j >> 2, m = j & 3; const int rt = ai * HALF + wr * 64 + m * 16 + fr; const size_t off = off0 + (size_t)(ai * HALF + m * 16) * 1024;
                float s = 0.f;
#pragma unroll
                for (int bj = 0; bj < 2; ++bj) {
                    const u32x4 h = ph[pr & 1][q][bj]; const u32x2 lo = pl[pr & 1][q][bj];
                    float a[8];
#pragma unroll
                    for (int e = 0; e < 8; ++e) { const unsigned hw = h[e >> 1], hs = (e & 1) ? (hw & 0xffff0000u) : (hw << 16), l8 = (lo[e >> 2] >> (8 * (e & 3))) & 0xffu;
                        a[e] = xs_join(hs, l8) + acc[ai][bj][m][e >> 2][e & 3]; }
                    if (last) { *(f32x4*)(xout + off + bj * HALF) = (f32x4){a[0], a[1], a[2], a[3]}; *(f32x4*)(xout + off + bj * HALF + 4) = (f32x4){a[4], a[5], a[6], a[7]}; }
                    else { u32x4 w; w.x = cvtpk(a[0], a[1]); w.y = cvtpk(a[2], a[3]); w.z = cvtpk(a[4], a[5]); w.w = cvtpk(a[6], a[7]);
                        unsigned l[8];
#pragma unroll
                        for (int e = 0; e < 8; ++e) { const unsigned hw = w[e >> 1]; l[e] = xs_lo(a[e], (e & 1) ? (hw & 0xffff0000u) : (hw << 16)); }
                        u32x2 lw; lw.x = l[0] | (l[1] << 8) | (l[2] << 16) | (l[3] << 24); lw.y = l[4] | (l[5] << 8) | (l[6] << 16) | (l[7] << 24);
                        *(u32x4*)(xh + off + bj * HALF) = w; *(u32x2*)(xl + off + bj * HALF) = lw; }
                    s += ((a[0] * a[0] + a[1] * a[1]) + (a[2] * a[2] + a[3] * a[3])) + ((a[4] * a[4] + a[5] * a[5]) + (a[6] * a[6] + a[7] * a[7]));
                }
                s += lx_xor<16>(s); s = lx_sum32(s);
                if (fq == 0) Pw[rt * 4 + wc] = s; }
            asm volatile("" ::: "memory");
            if (pr + 2 < 4) { EOP_LOAD(pr & 1, pr + 2); asm volatile("" ::: "memory"); }
        }
#undef EOP_LOAD
        asm volatile("s_waitcnt lgkmcnt(0)" ::: "memory"); __builtin_amdgcn_s_barrier(); asm volatile("" ::: "memory");
        const int t = wid * 64 + lane;
        if (t < 256) { const float s = (Pw[t * 4 + 0] + Pw[t * 4 + 1]) + (Pw[t * 4 + 2] + Pw[t * 4 + 3]); ssq[(size_t)(u.pm * BM + t) * 4 + u.pn] = s; }
        asm volatile("s_waitcnt lgkmcnt(0)" ::: "memory"); __builtin_amdgcn_s_barrier(); asm volatile("" ::: "memory");
    }
};

template <class Epi, class Sched, bool ALIGN_EPI = false, bool SP2 = false>
__device__ __forceinline__ void gemm_phase(PG8_LAS unsigned char* lds, const Gemm g, const Sched& S, const Epi& E, int wave) {
    int wid = wave; asm volatile("" : "+s"(wid)); const int tid = lx_tid(wid);
    const int lane = tid & 63, wr = wid >> 2, wc = wid & 3, fr = lane & 15, fq = lane >> 4;
    const int K = g.K, nt = K / BK;
    unsigned voffA[2], voffB[2];
#pragma unroll
    for (int i = 0; i < 2; ++i) { int R, C; stage_rc(tid * 16 + i * 8192, R, C); const int Rb = Epi::PERM ? ((R & ~31) + perm32(R & 31)) : R;
        voffA[i] = (unsigned)(R * K + C) * 2u; voffB[i] = (unsigned)(Rb * K + C) * 2u; }
    const size_t kstep = (size_t)(BK * 2);
    const size_t hstep = (size_t)HALF * K * 2;
    const size_t tstep = 2 * hstep;
    const unsigned ldsw = (unsigned)wid * 1024u;
    const int aoff = lds_byte(wr * 64 + fr, fq * 8), boff = lds_byte(wc * 32 + fr, fq * 8);
#define PG8_SA(b, h) (((b) * 2 + (h)) * HTB)
#define PG8_SB(b, h) ((4 + (b) * 2 + (h)) * HTB)
#define PG8_STAGE(bufoff, gbase, voff) do { _Pragma("unroll") for (int _i = 0; _i < 2; ++_i) \
        __builtin_amdgcn_global_load_lds((const unsigned*)((const char*)(gbase) + (voff)[_i]), (PG8_LAS unsigned*)(lds + (bufoff) + ldsw + _i * 8192), 16, 0, 0); } while (0)
#define PG8_LDA(dst, b, h) do { _Pragma("unroll") for (int m = 0; m < 4; ++m) _Pragma("unroll") for (int k = 0; k < 2; ++k) dst[m][k] = *(const PG8_LAS bf16x8*)(lds + PG8_SA(b, h) + aoff + m * 2048 + k * 1024); } while (0)
#define PG8_LDB(dst, b, h) do { _Pragma("unroll") for (int n = 0; n < 2; ++n) _Pragma("unroll") for (int k = 0; k < 2; ++k) dst[n][k] = *(const PG8_LAS bf16x8*)(lds + PG8_SB(b, h) + boff + n * 2048 + k * 1024); } while (0)
#define PG8_MMA(ai, bj, At, Bt) do { __builtin_amdgcn_s_setprio(1); _Pragma("unroll") for (int m = 0; m < 4; ++m) _Pragma("unroll") for (int n = 0; n < 2; ++n) _Pragma("unroll") for (int k = 0; k < 2; ++k) \
        acc[ai][bj][m][n] = __builtin_amdgcn_mfma_f32_16x16x32_bf16(Bt[n][k], At[m][k], acc[ai][bj][m][n], 0, 0, 0); __builtin_amdgcn_s_setprio(0); } while (0)
#define PG8_WAIT_V(n) asm volatile("s_waitcnt vmcnt(" #n ")" ::: "memory")
#define PG8_WAIT_L(n) asm volatile("s_waitcnt lgkmcnt(" #n ")" ::: "memory")
#define PG8_WAIT_VS(relax) asm volatile("s_waitcnt vmcnt(%1)\n\ts_cmp_lg_u32 %0, 0\n\ts_cbranch_scc1 .Lpg8w%=\n\ts_waitcnt vmcnt(8)\n.Lpg8w%=:" :: "s"(relax), "n"(8 + Epi::STORES) : "scc", "memory")
#define PG8_BAR __builtin_amdgcn_s_barrier()
#define PG8_SCHED __builtin_amdgcn_sched_barrier(0)
    Unit cur, nxt; int ui = 0;
    if (!S.next(0, cur)) return;
    f32x4 acc[2][2][4][2];
#pragma unroll
    for (int a = 0; a < 2; ++a)
#pragma unroll
        for (int b = 0; b < 2; ++b)
#pragma unroll
            for (int m = 0; m < 4; ++m)
#pragma unroll
                for (int n = 0; n < 2; ++n) acc[a][b][m][n] = (f32x4){0.f, 0.f, 0.f, 0.f};
    bf16x8 At[4][2], B0[2][2], B1[2][2];
    const char* cA = (const char*)g.A + (size_t)cur.pm * tstep; const char* cB = (const char*)g.Bt + (size_t)cur.pn * tstep;
    S.a_ready(cur);
    if constexpr (SP2) {
        if constexpr (Epi::HAS_PREP) {
            typename Epi::Prep pp; E.prep_load(pp, cur, wr, wc, fr, fq);
            PG8_STAGE(PG8_SB(0, 0), cB, voffB); PG8_STAGE(PG8_SB(0, 1), cB + hstep, voffB); PG8_STAGE(PG8_SA(0, 0), cA, voffA); PG8_STAGE(PG8_SA(0, 1), cA + hstep, voffA);
            if (wr == 1) PG8_BAR;
            PG8_WAIT_V(2); PG8_BAR;
            E.prep_store(pp, cur, wr, wc, fr, fq);
        } else {
        PG8_STAGE(PG8_SB(0, 0), cB, voffB); PG8_STAGE(PG8_SB(0, 1), cB + hstep, voffB); PG8_STAGE(PG8_SA(0, 0), cA, voffA); PG8_STAGE(PG8_SA(0, 1), cA + hstep, voffA);
        if (wr == 1) PG8_BAR;
        PG8_WAIT_V(2); PG8_BAR;
        }
        PG8_STAGE(PG8_SB(1, 0), cB + kstep, voffB); PG8_STAGE(PG8_SA(1, 0), cA + kstep, voffA); PG8_STAGE(PG8_SB(1, 1), cB + hstep + kstep, voffB);
        PG8_WAIT_V(6); PG8_BAR;
    } else {
        PG8_STAGE(PG8_SB(0, 0), cB, voffB); PG8_STAGE(PG8_SA(0, 0), cA, voffA); PG8_STAGE(PG8_SB(0, 1), cB + hstep, voffB); PG8_STAGE(PG8_SA(0, 1), cA + hstep, voffA);
        if (wr == 1) PG8_BAR;
        PG8_WAIT_V(4); PG8_BAR;
        PG8_STAGE(PG8_SB(1, 0), cB + kstep, voffB); PG8_STAGE(PG8_SA(1, 0), cA + kstep, voffA); PG8_STAGE(PG8_SB(1, 1), cB + hstep + kstep, voffB);
        PG8_WAIT_V(6); PG8_BAR;
    }
    for (;;) {
        const bool has_next = S.next(ui + 1, nxt);
        const char* nA = has_next ? (const char*)g.A + (size_t)nxt.pm * tstep : cA; const char* nB = has_next ? (const char*)g.Bt + (size_t)nxt.pn * tstep : cB;
        for (int t = 0; t < nt; t += 2) {
            const bool last = (t == nt - 2);
            const char* a1 = cA + (size_t)(t + 1) * kstep;
            const char* a2 = last ? nA : cA + (size_t)(t + 2) * kstep; const char* b2 = last ? nB : cB + (size_t)(t + 2) * kstep;
            const char* a3 = a2 + kstep; const char* b3 = b2 + kstep;
            if (last && has_next) S.a_ready(nxt);
            const int relax = __builtin_amdgcn_readfirstlane((t == 0 && ui > 0) ? 1 : 0); (void)relax;
            if constexpr (SP2) {
            PG8_LDB(B0, 0, 0); PG8_LDB(B1, 0, 1); PG8_SCHED; PG8_LDA(At, 0, 0); PG8_STAGE(PG8_SA(1, 1), a1 + hstep, voffA);
            if constexpr (Epi::STORES > 0) PG8_WAIT_VS(relax); else PG8_WAIT_V(8);
            PG8_WAIT_L(0); PG8_BAR; PG8_MMA(0, 0, At, B0); PG8_MMA(0, 1, At, B1); PG8_BAR; PG8_SCHED;
            PG8_LDA(At, 0, 1); PG8_STAGE(PG8_SB(0, 0), b2, voffB); PG8_STAGE(PG8_SB(0, 1), b2 + hstep, voffB); PG8_STAGE(PG8_SA(0, 0), a2, voffA);
            if constexpr (Epi::STORES > 0) PG8_WAIT_VS(relax); else PG8_WAIT_V(8);
            PG8_WAIT_L(0); PG8_BAR; PG8_MMA(1, 0, At, B0); PG8_MMA(1, 1, At, B1); PG8_BAR; PG8_SCHED;
            PG8_LDB(B0, 1, 0); PG8_LDB(B1, 1, 1); PG8_SCHED; PG8_LDA(At, 1, 0); PG8_STAGE(PG8_SA(0, 1), a2 + hstep, voffA);
            PG8_WAIT_V(8); PG8_WAIT_L(0); PG8_BAR; PG8_MMA(0, 0, At, B0); PG8_MMA(0, 1, At, B1); PG8_BAR; PG8_SCHED;
            PG8_LDA(At, 1, 1); PG8_STAGE(PG8_SB(1, 0), b3, voffB); PG8_STAGE(PG8_SB(1, 1), b3 + hstep, voffB); PG8_STAGE(PG8_SA(1, 0), a3, voffA);
            PG8_WAIT_V(8); PG8_WAIT_L(0); PG8_BAR; PG8_MMA(1, 0, At, B0); PG8_MMA(1, 1, At, B1); PG8_BAR; PG8_SCHED;
            } else {
            PG8_LDB(B0, 0, 0); PG8_SCHED; PG8_LDA(At, 0, 0); PG8_STAGE(PG8_SA(1, 1), a1 + hstep, voffA);
            PG8_WAIT_L(8); PG8_BAR; PG8_WAIT_L(0); PG8_MMA(0, 0, At, B0); PG8_BAR; PG8_SCHED;
            PG8_LDB(B1, 0, 1); PG8_STAGE(PG8_SB(0, 0), b2, voffB);
            PG8_BAR; PG8_WAIT_L(0); PG8_MMA(0, 1, At, B1); PG8_BAR;
            PG8_LDA(At, 0, 1); PG8_STAGE(PG8_SA(0, 0), a2, voffA);
            PG8_BAR; PG8_WAIT_L(0); PG8_MMA(1, 0, At, B0); PG8_BAR; PG8_SCHED;
            PG8_STAGE(PG8_SB(0, 1), b2 + hstep, voffB);
            PG8_WAIT_V(6); PG8_BAR; PG8_MMA(1, 1, At, B1); PG8_BAR;
            PG8_LDB(B0, 1, 0); PG8_SCHED; PG8_LDA(At, 1, 0); PG8_STAGE(PG8_SA(0, 1), a2 + hstep, voffA);
            PG8_WAIT_L(8); PG8_BAR; PG8_WAIT_L(0); PG8_MMA(0, 0, At, B0); PG8_BAR; PG8_SCHED;
            PG8_LDB(B1, 1, 1); PG8_STAGE(PG8_SB(1, 0), b3, voffB);
            PG8_BAR; PG8_WAIT_L(0); PG8_MMA(0, 1, At, B1); PG8_BAR;
            PG8_LDA(At, 1, 1); PG8_STAGE(PG8_SA(1, 0), a3, voffA);
            PG8_BAR; PG8_WAIT_L(0); PG8_MMA(1, 0, At, B0); PG8_BAR; PG8_SCHED;
            PG8_STAGE(PG8_SB(1, 1), b3 + hstep, voffB);
            PG8_WAIT_V(6); PG8_BAR; PG8_MMA(1, 1, At, B1); PG8_BAR;
            }
        }
        if constexpr (ALIGN_EPI) { if (wr == 0) PG8_BAR; }
        if constexpr (!Epi::AFTER_DRAIN) { E(acc, cur, wr, wc, fr, fq);
            S.done(cur); }
        if (!has_next) break;
#pragma unroll
        for (int a = 0; a < 2; ++a)
#pragma unroll
            for (int b = 0; b < 2; ++b)
#pragma unroll
                for (int m = 0; m < 4; ++m)
#pragma unroll
                    for (int n = 0; n < 2; ++n) acc[a][b][m][n] = (f32x4){0.f, 0.f, 0.f, 0.f};
        cur = nxt; cA = nA; cB = nB; ++ui;
        if constexpr (ALIGN_EPI) { if (wr == 1) PG8_BAR; }
    }
    if constexpr (Epi::AFTER_DRAIN) {
        typename Epi::Pre pre; E.preload(pre, cur, wr, wc, fr, fq);
        asm volatile("s_waitcnt vmcnt(%0)" :: "n"(Epi::PRELOADS) : "memory");
        if constexpr (!ALIGN_EPI) { if (wr == 0) PG8_BAR; }
        PG8_BAR;
        E.fused(acc, cur, wr, wc, fr, fq, lds, wid, lane, pre); S.done(cur);
    } else {
    PG8_WAIT_V(0);
    if constexpr (!ALIGN_EPI) { if (wr == 0) PG8_BAR; }
    PG8_BAR;
    }
#undef PG8_SA
#undef PG8_SB
#undef PG8_STAGE
#undef PG8_LDA
#undef PG8_LDB
#undef PG8_MMA
#undef PG8_WAIT_V
#undef PG8_WAIT_L
#undef PG8_WAIT_VS
#undef PG8_BAR
#undef PG8_SCHED
}
}
namespace att {
#define ATT_LAS __attribute__((address_space(3)))
using bf16x8 = __attribute__((ext_vector_type(8))) short;
using s16x4 = __attribute__((ext_vector_type(4))) short;
using f32x16 = __attribute__((ext_vector_type(16))) float;
using u32x4 = __attribute__((ext_vector_type(4))) unsigned;
typedef unsigned short bf16_t;
typedef ATT_LAS const char* lds_cptr;
typedef ATT_LAS char* lds_ptr;
typedef short v4i16_t __attribute__((ext_vector_type(4)));
typedef float f32x2_t __attribute__((ext_vector_type(2))); typedef __bf16 bf16x2_t __attribute__((ext_vector_type(2)));
constexpr int SEQ = 16384;
constexpr int PROWS = SEQ + (PROJ_PAD ? SEQ / 16 : 0); constexpr size_t TSTRIDE = (size_t)PROWS * 64;
constexpr int T_QA = 0, T_KA = 4, T_VA = 8, T_GA = 12, T_QD = 16, T_KD = 28, T_VD = 40, T_GD = 52;
__device__ __forceinline__ int prow(int t) { return PROJ_PAD ? t + (t >> 4) : t; }
constexpr int SLOTB = 8192, NSLOT = 6;
constexpr int LDS_K = 0, LDS_K2 = NSLOT * SLOTB, LDS_V = 2 * NSLOT * SLOTB, LDS_WS = 3 * NSLOT * SLOTB, LDS_FLAG = LDS_WS + 8 * 64 * 4, LDS_END = LDS_FLAG + 128;
constexpr int LDS_OST = LDS_K2;
#define ATT_BAR_L() asm volatile("s_waitcnt lgkmcnt(0)\n\ts_barrier" ::: "memory")
__device__ __forceinline__ int crow(int r, int hi) { return (r & 3) + 8 * (r >> 2) + 4 * hi; }
__device__ __forceinline__ unsigned cvtpk_s(float lo, float hi) { f32x2_t v = {lo, hi}; bf16x2_t b = __builtin_convertvector(v, bf16x2_t); return __builtin_bit_cast(unsigned, b); }
__device__ __forceinline__ float bf2f(unsigned short b) { return __uint_as_float((unsigned)b << 16); }
__device__ __forceinline__ void glds16(const void* gsrc, unsigned lds_dst) { unsigned keep;
    asm volatile("s_mov_b32 %0, m0\n\ts_mov_b32 m0, %2\n\ts_nop 0\n\tglobal_load_lds_dwordx4 %1, off\n\ts_mov_b32 m0, %0" : "=&s"(keep) : "v"(gsrc), "s"(lds_dst) : "memory"); }
__device__ __forceinline__ void glds16s(unsigned voff, const void* sbase, unsigned lds_dst) { unsigned keep;
    const unsigned long long a_ = (unsigned long long)sbase;
    const unsigned long long b_ = (unsigned long long)(unsigned)__builtin_amdgcn_readfirstlane((int)(unsigned)a_) | ((unsigned long long)(unsigned)__builtin_amdgcn_readfirstlane((int)(unsigned)(a_ >> 32)) << 32);
    asm volatile("s_nop 4\n\ts_mov_b32 %0, m0\n\ts_mov_b32 m0, %3\n\ts_nop 0\n\tglobal_load_lds_dwordx4 %1, %2\n\ts_mov_b32 m0, %0" : "=&s"(keep) : "v"(voff), "s"(b_), "s"(lds_dst) : "memory"); }
#define ATT_WAIT_BAR(N) asm volatile("s_waitcnt vmcnt(" #N ") lgkmcnt(0)\n\ts_barrier" ::: "memory")
__device__ __forceinline__ s16x4 vtr(lds_cptr p) { return __builtin_bit_cast(s16x4, __builtin_amdgcn_ds_read_tr16_b64_v4i16((ATT_LAS v4i16_t*)p)); }

__device__ __forceinline__ void qkt(f32x16& p0, f32x16& p1, lds_cptr ks, const int (&koff)[4], const bf16x8* qr, const f32x16& cinit) {
#pragma unroll
    for (int d0 = 0; d0 < 4; ++d0) {
        const bf16x8 b0 = *(const ATT_LAS bf16x8*)(ks + koff[d0]);
        const bf16x8 b1 = *(const ATT_LAS bf16x8*)(ks + koff[d0] + 4096);
        if (d0 == 0) { p0 = __builtin_amdgcn_mfma_f32_32x32x16_bf16(b0, qr[0], cinit, 0, 0, 0); p1 = __builtin_amdgcn_mfma_f32_32x32x16_bf16(b1, qr[0], cinit, 0, 0, 0); }
        else { p0 = __builtin_amdgcn_mfma_f32_32x32x16_bf16(b0, qr[d0], p0, 0, 0, 0); p1 = __builtin_amdgcn_mfma_f32_32x32x16_bf16(b1, qr[d0], p1, 0, 0, 0); }
    }
}
__device__ __forceinline__ void pv(f32x16* o, lds_cptr vp, bf16x8 pa0, bf16x8 pa1, bf16x8 pa2, bf16x8 pa3) {
#pragma unroll
    for (int d0 = 0; d0 < 2; ++d0) { s16x4 lo[4], hi[4];
#pragma unroll
        for (int ks = 0; ks < 4; ++ks) { lo[ks] = vtr(vp + d0 * 4096 + ks * 1024); hi[ks] = vtr(vp + d0 * 4096 + ks * 1024 + 512); }
#define ATT_PK(k) (bf16x8){lo[k][0], lo[k][1], lo[k][2], lo[k][3], hi[k][0], hi[k][1], hi[k][2], hi[k][3]}
        o[d0] = __builtin_amdgcn_mfma_f32_32x32x16_bf16(ATT_PK(0), pa0, o[d0], 0, 0, 0);
        o[d0] = __builtin_amdgcn_mfma_f32_32x32x16_bf16(ATT_PK(1), pa1, o[d0], 0, 0, 0);
        o[d0] = __builtin_amdgcn_mfma_f32_32x32x16_bf16(ATT_PK(2), pa2, o[d0], 0, 0, 0);
        o[d0] = __builtin_amdgcn_mfma_f32_32x32x16_bf16(ATT_PK(3), pa3, o[d0], 0, 0, 0);
#undef ATT_PK
    }
}
__device__ __forceinline__ void ot_rows(const f32x16* o, lds_ptr stg, int q, int hi, int lane, u32x4* sv) {
#pragma unroll
    for (int d0 = 0; d0 < 2; ++d0)
#pragma unroll
        for (int pr = 0; pr < 2; ++pr) { const int g = 2 * pr;
            const unsigned ax = cvtpk_s(o[d0][4 * g], o[d0][4 * g + 1]), ay = cvtpk_s(o[d0][4 * g + 2], o[d0][4 * g + 3]), bx = cvtpk_s(o[d0][4 * g + 4], o[d0][4 * g + 5]), by = cvtpk_s(o[d0][4 * g + 6], o[d0][4 * g + 7]);
            const auto rx = __builtin_amdgcn_permlane32_swap(ax, bx, false, false); const auto ry = __builtin_amdgcn_permlane32_swap(ay, by, false, false);
            *(ATT_LAS u32x4*)(stg + q * 128 + (((4 * d0 + 2 * pr + hi) ^ (q & 7)) << 4)) = (u32x4){rx[0], ry[0], rx[1], ry[1]}; }
    asm volatile("s_waitcnt lgkmcnt(0)" ::: "memory");
#pragma unroll
    for (int i = 0; i < 4; ++i) { const int rw = 8 * i + (lane >> 3); sv[i] = *(const ATT_LAS u32x4*)(stg + rw * 128 + (((lane & 7) ^ (rw & 7)) << 4)); }
}
__device__ __forceinline__ bf16x8 pack8(const float* a) { u32x4 w; w.x = cvtpk_s(a[0], a[1]); w.y = cvtpk_s(a[2], a[3]); w.z = cvtpk_s(a[4], a[5]); w.w = cvtpk_s(a[6], a[7]); return __builtin_bit_cast(bf16x8, w); }

template <bool MASK> __device__ __forceinline__ void sb_tile(const f32x16& p0, const f32x16& p1, float& Srun, int qrel, int hi, bf16x8& pa0, bf16x8& pa1, bf16x8& pa2, bf16x8& pa3) {
    float run = Srun; unsigned pw[16];
#pragma unroll
    for (int g = 7; g >= 0; --g) {
        float bt[4], m[4];
#pragma unroll
        for (int e = 0; e < 4; ++e) { const int idx = 4 * g + e; const float z = (idx < 16) ? p0[idx] : p1[idx - 16];
            const float u = __builtin_amdgcn_exp2f(-__builtin_fmaxf(z, -100.0f));
            bt[e] = __builtin_amdgcn_rcpf(1.0f + u); m[e] = u * bt[e];
            if (MASK) { if (8 * g + 4 * hi + e >= qrel) { bt[e] = 0.f; m[e] = 1.f; } } }
        const float e2 = m[3], e1 = m[3] * m[2], e0 = e1 * m[1], T = e0 * m[0];
        const auto rr = __builtin_amdgcn_permlane32_swap(__float_as_uint(T), __float_as_uint(T), false, false);
        const float tev = __uint_as_float(rr[0]), tod = __uint_as_float(rr[1]);
        const float off = hi ? run : run * tod;
        run = run * (tev * tod);
        const float a0 = bt[0] * (off * e0), a1 = bt[1] * (off * e1), a2 = bt[2] * (off * e2), a3 = bt[3] * off;
        pw[2 * g] = cvtpk_s(a0, a1); pw[2 * g + 1] = cvtpk_s(a2, a3);
    }
    Srun = run;
    pa0 = __builtin_bit_cast(bf16x8, (u32x4){pw[0], pw[1], pw[2], pw[3]}); pa1 = __builtin_bit_cast(bf16x8, (u32x4){pw[4], pw[5], pw[6], pw[7]});
    pa2 = __builtin_bit_cast(bf16x8, (u32x4){pw[8], pw[9], pw[10], pw[11]}); pa3 = __builtin_bit_cast(bf16x8, (u32x4){pw[12], pw[13], pw[14], pw[15]});
}

struct SbArgs { const bf16_t* proj; bf16_t* mix; };
template <bool EARLY> __device__ __forceinline__ void sb_unit(int h, int qb, const SbArgs& A, lds_ptr shm, int wave) {
    int wid = wave; asm volatile("" : "+s"(wid)); const int tid = lx_tid(wid);
    const int lane = tid & 63, r32 = lane & 31, hi = lane >> 5;
    const int q0 = qb * 256;
    const bf16_t* Qh = A.proj + (size_t)(T_QA + h) * TSTRIDE; const bf16_t* Kh = A.proj + (size_t)(T_KA + h) * TSTRIDE; const bf16_t* Vh = A.proj + (size_t)(T_VA + h) * TSTRIDE;
    const unsigned lds0 = (unsigned)(size_t)shm;
    volatile ATT_LAS unsigned* flags = (volatile ATT_LAS unsigned*)(shm + LDS_FLAG);
    const unsigned kdst = lds0 + LDS_K + wid * 1024, vdst = lds0 + LDS_V + wid * 1024;
    const lds_cptr ks0 = (lds_cptr)shm + LDS_K; int koff[4];
#pragma unroll
    for (int d0 = 0; d0 < 4; ++d0) koff[d0] = r32 * 128 + (((2 * d0 + hi) ^ ((r32 >> 1) & 7)) << 4);
    const lds_cptr vp0 = (lds_cptr)shm + LDS_V + ((lane >> 4) & 1) * 32 + (lane & 3) * 8 + (4 * hi + ((lane & 15) >> 2)) * 64;
#define SB_DMA(jt, slot) do { const int jt_ = (jt) < 0 ? 0 : (jt); const int l_ = lx_lane(); const int kkey_ = 8 * wid + (l_ >> 3), vkey_ = 16 * (wid & 3) + (l_ >> 2); \
        const unsigned voffK_ = (unsigned)((prow(kkey_) * 64 + ((l_ & 7) ^ ((kkey_ >> 1) & 7)) * 8) * 2), voffV_ = (unsigned)((prow(vkey_) * 64 + (wid >> 2) * 32 + (l_ & 3) * 8) * 2); \
        glds16s(voffK_, (const char*)Kh + (size_t)jt_ * ((PROJ_PAD ? 68 : 64) * 128), (unsigned)__builtin_amdgcn_readfirstlane(kdst + (slot))); \
        glds16s(voffV_, (const char*)Vh + (size_t)jt_ * ((PROJ_PAD ? 68 : 64) * 128), (unsigned)__builtin_amdgcn_readfirstlane(vdst + (slot))); } while (0)
    const int jtop = 4 * qb + 3, jd = 4 * qb + (wid >> 1), qrel = 32 * (wid & 1) + r32;
    if (lane == 0) { flags[wid] = 0u; flags[8 + wid] = 0u; }
    bf16x8 qr[4];
    { const bf16_t* Qp = Qh + (size_t)prow(q0 + wid * 32 + r32) * 64;
#pragma unroll
      for (int d0 = 0; d0 < 4; ++d0) qr[d0] = *(const bf16x8*)(Qp + d0 * 16 + hi * 8); }
    const lds_ptr qst = shm + LDS_OST + wid * 4096 + lane * 16;
#pragma unroll
    for (int d0 = 0; d0 < 4; ++d0) *(ATT_LAS bf16x8*)(qst + d0 * 1024) = qr[d0];
    asm volatile("" ::: "memory");
#pragma unroll
    for (int i = 0; i < 6; ++i) SB_DMA(jtop - i, ((jtop - i + 6000) % 6) * SLOTB);
    f32x16 o[2]; o[0] = f32x16{}; o[1] = f32x16{}; const f32x16 zero = f32x16{};
    float Rsum = 1.0f; bool dead = false;
    for (int s = 0;; ++s) {
        const int jt = jd - s;
        if (s == 0) ATT_WAIT_BAR(4); else ATT_WAIT_BAR(2);
        if (s > 0) { const int fb = ((s - 1) & 1) * 8; unsigned all = 1u;
#pragma unroll
            for (int w = 0; w < 8; ++w) all &= flags[fb + w];
            if (all) break; }
        if (s > 0) SB_DMA(jtop - s - 5, ((jtop - s + 1 + 6000) % 6) * SLOTB);
        if (jt >= 0 && !dead) {
            const int slot = ((jt + 6000) % 6) * SLOTB;
            f32x16 p0, p1; bf16x8 pa0, pa1, pa2, pa3;
            { bf16x8 qf[4];
#pragma unroll
              for (int d0 = 0; d0 < 4; ++d0) qf[d0] = *(const ATT_LAS bf16x8*)(qst + d0 * 1024);
              qkt(p0, p1, ks0 + slot, koff, qf, zero); }
            __builtin_amdgcn_sched_barrier(0);
            if (s == 0) sb_tile<true>(p0, p1, Rsum, qrel, hi, pa0, pa1, pa2, pa3); else sb_tile<false>(p0, p1, Rsum, qrel, hi, pa0, pa1, pa2, pa3);
            __builtin_amdgcn_sched_barrier(0);
            pv(o, vp0 + slot, pa0, pa1, pa2, pa3);
            if (EARLY) dead = __all(Rsum == 0.0f);
        }
        const bool fin = dead || (jt <= 0);
        if (lane == 0) flags[(s & 1) * 8 + wid] = fin ? 1u : 0u;
    }
#undef SB_DMA
    asm volatile("s_waitcnt vmcnt(0)" ::: "memory");
    { const int l2 = lx_lane();
      u32x4 sv[4]; ot_rows(o, shm + LDS_OST + wid * 4096, l2 & 31, l2 >> 5, l2, sv);
      const bf16_t* Gh = A.proj + (size_t)(T_GA + h) * TSTRIDE; bf16_t* Mw = A.mix + (size_t)(q0 + wid * 32) * 1024 + h * 64;
#pragma unroll
      for (int i = 0; i < 4; ++i) { const int row = i * 8 + (l2 >> 3), chn = l2 & 7; const u32x4 gv = *(const u32x4*)(Gh + (size_t)prow(q0 + wid * 32 + row) * 64 + chn * 8);
          u32x4 w;
#pragma unroll
          for (int k = 0; k < 4; ++k) { const float lo = __uint_as_float(sv[i][k] << 16) * __uint_as_float(gv[k] << 16), hi2 = __uint_as_float(sv[i][k] & 0xffff0000u) * __uint_as_float(gv[k] & 0xffff0000u); w[k] = cvtpk_s(lo, hi2); }
          *(u32x4*)(Mw + (size_t)row * 1024 + chn * 8) = w; } }
    ATT_BAR_L();
}

struct att_true { static constexpr bool value = true; }; struct att_false { static constexpr bool value = false; };
struct DilArgs { const bf16_t* proj; bf16_t* o1; bf16_t* mix; float* lp; unsigned* gcnt; const float* qg; const float* kg; };
template <int DUMMY = 0> __device__ __forceinline__ void dil_phase(int v, int G, const DilArgs& A, lds_ptr shm, int wave) {
    int wid = wave; asm volatile("" : "+s"(wid)); const int tid = lx_tid(wid);
    const int lane = tid & 63, r32 = lane & 31, hi = lane >> 5;
    const unsigned lds0 = (unsigned)(size_t)shm;
    ATT_LAS float* wsf = (ATT_LAS float*)(shm + LDS_WS) + wid * 64;
    const unsigned kdst0 = lds0 + LDS_K + wid * 1024, vdst = lds0 + LDS_V + wid * 1024;
    const lds_cptr ks00 = (lds_cptr)shm + LDS_K; int koff[4];
#pragma unroll
    for (int d0 = 0; d0 < 4; ++d0) koff[d0] = r32 * 128 + (((2 * d0 + hi) ^ ((r32 >> 1) & 7)) << 4);
    const lds_cptr vp0 = (lds_cptr)shm + LDS_V + ((lane >> 4) & 1) * 32 + (lane & 3) * 8 + (4 * hi + ((lane & 15) >> 2)) * 64;
#define DIL_KKEY(l_) (8 * wid + ((l_) >> 3))
#define DIL_KCH(l_) ((((l_) & 7) ^ ((DIL_KKEY(l_) >> 1) & 7)) * 8)
#define DIL_VKEY(l_) (16 * (wid & 3) + ((l_) >> 2))
#define DIL_VCH(l_) ((wid >> 2) * 32 + ((l_) & 3) * 8)
    float gq = __builtin_fabsf(A.qg[lane]), gk = __builtin_fabsf(A.kg[lane]);
    gq = lx_wave_max(gq); gk = lx_wave_max(gk);
    const float Mb = 64.0f * 0.125f * 1.4426950408889634f * 1.02f * gq * gk;
    f32x16 negm, negm0, negm4;
#pragma unroll
    for (int r = 0; r < 16; ++r) { const int dd = 8 * (r >> 2) + 4 * hi + (r & 3) - r32; negm[r] = -Mb; negm0[r] = (dd < 0) ? -3.0e38f : -Mb; negm4[r] = (dd > 0) ? -3.0e38f : -Mb; }
    const __amdgpu_buffer_rsrc_t o1_rsrc = __builtin_amdgcn_make_buffer_rsrc((void*)A.o1, 0, SEQ * 768 * 2, 0x00020000);
    const __amdgpu_buffer_rsrc_t mix_rsrc = __builtin_amdgcn_make_buffer_rsrc((void*)A.mix, 0, SEQ * 1024 * 2, 0x00020000);
#define DIL_DECODE(k, H, P, C, BLK) const int q_##H = 3 * (v >> 5) + (k) / 3, H = q_##H >> 1, P = (k) % 3, C = (v & 31) >> (5 - 2 * P), BLK = (q_##H & 1) * (32 >> (2 * P)) + ((v & 31) & ((32 >> (2 * P)) - 1))
#define DIL_ISSUE_K(H, P, C, BLK, KB) do { const int rsh_ = 2 * P; const int ll_ = lx_lane(); const unsigned kdst = kdst0 + (KB) * (LDS_K2 - LDS_K); const unsigned vo_ = (unsigned)((prow(C + (DIL_KKEY(ll_) << rsh_)) * 64 + DIL_KCH(ll_)) * 2); \
        const char* kb_ = (const char*)(A.proj + (size_t)(T_KD + H) * TSTRIDE) + (long)((BLK * 256 - 128) << rsh_) * (PROJ_PAD ? 136 : 128); \
        _Pragma("unroll") for (int j = 0; j < 6; ++j) glds16s(vo_, kb_ + (long)((64 * j) << rsh_) * (PROJ_PAD ? 136 : 128), (unsigned)__builtin_amdgcn_readfirstlane(kdst + j * SLOTB)); } while (0)
#define DIL_ISSUE_V(H, P, C, BLK) do { const int rsh_ = 2 * P; const int ll_ = lx_lane(); const unsigned vo_ = (unsigned)((prow(C + (DIL_VKEY(ll_) << rsh_)) * 64 + DIL_VCH(ll_)) * 2); \
        const char* vb_ = (const char*)(A.proj + (size_t)(T_VD + H) * TSTRIDE) + (long)((BLK * 256 - 128) << rsh_) * (PROJ_PAD ? 136 : 128); \
        _Pragma("unroll") for (int j = 0; j < 6; ++j) glds16s(vo_, vb_ + (long)((64 * j) << rsh_) * (PROJ_PAD ? 136 : 128), (unsigned)__builtin_amdgcn_readfirstlane(vdst + j * SLOTB)); } while (0)
#define DIL_LOADQ(QR, H, P, C, BLK) do { const bf16_t* Qp_ = A.proj + (size_t)(T_QD + H) * TSTRIDE + (size_t)prow(C + ((BLK * 256 + wid * 32 + r32) << (2 * P))) * 64; \
        _Pragma("unroll") for (int d0 = 0; d0 < 4; ++d0) QR[d0] = *(const bf16x8*)(Qp_ + d0 * 16 + hi * 8); } while (0)
    if (G != 256) return;
    bf16x8 qr[4];
    { DIL_DECODE(0, h0, p0_, c0, b0); DIL_ISSUE_K(h0, p0_, c0, b0, 0); DIL_LOADQ(qr, h0, p0_, c0, b0); DIL_ISSUE_V(h0, p0_, c0, b0); }
    asm volatile("" :: "v"(qr[0]), "v"(qr[1]), "v"(qr[2]), "v"(qr[3]));
    for (int k = 0; k < 9; ++k) {
        DIL_DECODE(k, h, p, c, blk);
        const int rsh = 2 * p, u0 = blk * 256;
        if (k == 0) asm volatile("s_waitcnt vmcnt(6) lgkmcnt(0)\n\ts_barrier" ::: "memory"); else asm volatile("s_waitcnt vmcnt(5) lgkmcnt(0)\n\ts_barrier" ::: "memory");
        if (p == 2 && tid == 0) __hip_atomic_fetch_add(A.gcnt + (3 * (v >> 5) + k / 3) * 64, 1u, __ATOMIC_RELAXED, __HIP_MEMORY_SCOPE_AGENT);
        if (k > 0) DIL_ISSUE_V(h, p, c, blk);
        const int kb = k & 1; const lds_cptr ks0 = ks00 + kb * (LDS_K2 - LDS_K);
        bf16x8 qn[4];
        unsigned kn_vo = 0u, kn_dst = 0u; const char* kn_b = nullptr; long kn_st = 0;
        if (k + 1 < 9) { DIL_DECODE(k + 1, hn, pn, cn, bn);
            const int rsh_ = 2 * pn; const int ll_ = lx_lane(); kn_vo = (unsigned)((prow(cn + (DIL_KKEY(ll_) << rsh_)) * 64 + DIL_KCH(ll_)) * 2); kn_dst = kdst0 + (kb ^ 1) * (LDS_K2 - LDS_K);
            kn_b = (const char*)(A.proj + (size_t)(T_KD + hn) * TSTRIDE) + (long)((bn * 256 - 128) << rsh_) * (PROJ_PAD ? 136 : 128); kn_st = (long)(64 << rsh_) * (PROJ_PAD ? 136 : 128); }
#define DIL_K_PIECE(j) glds16s(kn_vo, kn_b + (j) * kn_st, (unsigned)__builtin_amdgcn_readfirstlane(kn_dst + (j) * SLOTB))
        unsigned pw[5][8]; f32x2_t l2 = {0.f, 0.f};
#define DIL_QK(HH, S) do { const int ht_ = wid + (HH); const lds_cptr ks_ = ks0 + (ht_ >> 1) * SLOTB + (ht_ & 1) * 4096; bf16x8 kb_[4]; \
            _Pragma("unroll") for (int d0 = 0; d0 < 4; ++d0) kb_[d0] = *(const ATT_LAS bf16x8*)(ks_ + koff[d0]); \
            _Pragma("unroll") for (int d0 = 0; d0 < 4; ++d0) S = __builtin_amdgcn_mfma_f32_32x32x16_bf16(kb_[d0], qr[d0], d0 == 0 ? ((HH) == 0 ? negm0 : ((HH) == 4 ? negm4 : negm)) : S, 0, 0, 0); } while (0)
#define DIL_SM(HH, S) do { _Pragma("unroll") for (int g = 0; g < 4; ++g) { float a[4]; \
            _Pragma("unroll") for (int e = 0; e < 4; ++e) a[e] = __builtin_amdgcn_exp2f(S[4 * g + e]);        \
            l2 += (f32x2_t){a[0], a[1]}; l2 += (f32x2_t){a[2], a[3]}; pw[HH][2 * g] = cvtpk_s(a[0], a[1]); pw[HH][2 * g + 1] = cvtpk_s(a[2], a[3]); } } while (0)
#define DIL_PIN(HH) asm volatile("" :: "v"(pw[HH][0]), "v"(pw[HH][1]), "v"(pw[HH][2]), "v"(pw[HH][3]), "v"(pw[HH][4]), "v"(pw[HH][5]), "v"(pw[HH][6]), "v"(pw[HH][7]), "v"(l2))
#define DIL_SB() __builtin_amdgcn_sched_barrier(0)
#define DIL_SMG(HH, S, g) do { float a[4]; _Pragma("unroll") for (int e = 0; e < 4; ++e) a[e] = __builtin_amdgcn_exp2f(S[4 * (g) + e]); \
            l2 += (f32x2_t){a[0], a[1]}; l2 += (f32x2_t){a[2], a[3]}; pw[HH][2 * (g)] = cvtpk_s(a[0], a[1]); pw[HH][2 * (g) + 1] = cvtpk_s(a[2], a[3]); } while (0)
#define DIL_STAGE(HN, SN, HC, SC) do { const int ht_ = wid + (HN); const lds_cptr ks_ = ks0 + (ht_ >> 1) * SLOTB + (ht_ & 1) * 4096; bf16x8 k0_, k1_, k2_, k3_; \
            k0_ = *(const ATT_LAS bf16x8*)(ks_ + koff[0]); k1_ = *(const ATT_LAS bf16x8*)(ks_ + koff[1]); DIL_SB(); \
            SN = __builtin_amdgcn_mfma_f32_32x32x16_bf16(k0_, qr[0], (HN) == 4 ? negm4 : negm, 0, 0, 0); DIL_SB(); DIL_SMG(HC, SC, 0); k2_ = *(const ATT_LAS bf16x8*)(ks_ + koff[2]); DIL_SB(); \
            SN = __builtin_amdgcn_mfma_f32_32x32x16_bf16(k1_, qr[1], SN, 0, 0, 0); DIL_SB(); DIL_SMG(HC, SC, 1); k3_ = *(const ATT_LAS bf16x8*)(ks_ + koff[3]); DIL_SB(); \
            SN = __builtin_amdgcn_mfma_f32_32x32x16_bf16(k2_, qr[2], SN, 0, 0, 0); DIL_SB(); DIL_SMG(HC, SC, 2); DIL_SB(); \
            SN = __builtin_amdgcn_mfma_f32_32x32x16_bf16(k3_, qr[3], SN, 0, 0, 0); DIL_SB(); DIL_SMG(HC, SC, 3); DIL_SB(); } while (0)
        if (blk != 0) {
            f32x16 sA, sB;
            DIL_QK(0, sA); __builtin_amdgcn_sched_barrier(0);
            DIL_STAGE(1, sB, 0, sA); DIL_PIN(0); DIL_SB(); if (k + 1 < 9) DIL_K_PIECE(0);
            DIL_STAGE(2, sA, 1, sB); DIL_PIN(1); DIL_SB(); if (k + 1 < 9) DIL_K_PIECE(1);
            DIL_STAGE(3, sB, 2, sA); DIL_PIN(2); DIL_SB(); if (k + 1 < 9) DIL_K_PIECE(2);
            DIL_STAGE(4, sA, 3, sB); DIL_PIN(3); DIL_SB(); if (k + 1 < 9) DIL_K_PIECE(3);
            DIL_SM(4, sA); DIL_PIN(4); __builtin_amdgcn_sched_barrier(0); if (k + 1 < 9) { DIL_K_PIECE(4); DIL_K_PIECE(5); }
        } else {
#pragma unroll
        for (int hh = 0; hh < 5; ++hh) {
            const int ht = wid + hh;
#pragma unroll
            for (int e = 0; e < 8; ++e) pw[hh][e] = 0u;
            if (ht >= 4) { f32x16 s; DIL_QK(hh, s); DIL_SM(hh, s); }
            if (k + 1 < 9) { DIL_K_PIECE(hh); if (hh == 4) DIL_K_PIECE(5); }
        }
        }
#undef DIL_QK
#undef DIL_SM
#undef DIL_STAGE
#undef DIL_SMG
#undef DIL_SB
#undef DIL_PIN
#undef DIL_K_PIECE
        if (k + 1 < 9) { DIL_DECODE(k + 1, hn, pn, cn, bn); DIL_LOADQ(qn, hn, pn, cn, bn); }
        float l_reg = lx_sum32(l2[0] + l2[1]);
        unsigned* const gc = A.gcnt + (3 * (v >> 5) + k / 3) * 64;
        if (p == 2 && wid == 0) {
            unsigned spins = 0u;
            while (__hip_atomic_load(gc, __ATOMIC_RELAXED, __HIP_MEMORY_SCOPE_AGENT) < 32u) { __builtin_amdgcn_s_sleep(2); if (++spins > (1u << 22)) break; }
            __builtin_amdgcn_fence(__ATOMIC_ACQUIRE, "agent"); asm volatile("s_waitcnt vmcnt(0)" ::: "memory"); }
        if (k == 8) asm volatile("s_waitcnt vmcnt(0) lgkmcnt(0)\n\ts_barrier" ::: "memory");
        else asm volatile("s_waitcnt vmcnt(10) lgkmcnt(0)\n\ts_barrier" ::: "memory");

        u32x4 a0[4], a1[4], gvv[4]; float lp0, lp1;
        if (p == 2) { const bf16_t* Gh = A.proj + (size_t)(T_GD + h) * TSTRIDE; const int ln = lx_lane();
#pragma unroll
            for (int i = 0; i < 4; ++i) { const int t = c + ((u0 + wid * 32 + i * 8 + (ln >> 3)) << rsh);
                a0[i] = *(const u32x4*)(A.o1 + (size_t)t * 768 + h * 64 + (ln & 7) * 8); a1[i] = *(const u32x4*)(A.mix + (size_t)t * 1024 + 256 + h * 64 + (ln & 7) * 8);
                gvv[i] = *(const u32x4*)(Gh + (size_t)prow(t) * 64 + (ln & 7) * 8); }
            const int tq0 = c + ((u0 + wid * 32 + (ln & 31)) << rsh); lp0 = A.lp[((size_t)0 * SEQ + tq0) * 12 + h]; lp1 = A.lp[((size_t)1 * SEQ + tq0) * 12 + h]; }
        f32x16 o[2];
        o[0] = f32x16{}; o[1] = f32x16{};
#pragma unroll
        for (int hh = 0; hh < 5; ++hh) {
            const int ht = wid + hh;
            if (blk == 0 && ht < 4) continue;
            const lds_cptr vp = vp0 + (ht >> 1) * SLOTB + (ht & 1) * 2048;
            const bf16x8 pa0 = __builtin_bit_cast(bf16x8, (u32x4){pw[hh][0], pw[hh][1], pw[hh][2], pw[hh][3]}), pa1 = __builtin_bit_cast(bf16x8, (u32x4){pw[hh][4], pw[hh][5], pw[hh][6], pw[hh][7]});
#pragma unroll
            for (int d0 = 0; d0 < 2; ++d0) { const s16x4 l0 = vtr(vp + d0 * 4096), h0_ = vtr(vp + d0 * 4096 + 512), l1 = vtr(vp + d0 * 4096 + 1024), h1_ = vtr(vp + d0 * 4096 + 1536);
                o[d0] = __builtin_amdgcn_mfma_f32_32x32x16_bf16((bf16x8){l0[0], l0[1], l0[2], l0[3], h0_[0], h0_[1], h0_[2], h0_[3]}, pa0, o[d0], 0, 0, 0);
                o[d0] = __builtin_amdgcn_mfma_f32_32x32x16_bf16((bf16x8){l1[0], l1[1], l1[2], l1[3], h1_[0], h1_[1], h1_[2], h1_[3]}, pa1, o[d0], 0, 0, 0); }
        }
        auto tail = [&](auto is2_) __attribute__((always_inline)) { constexpr bool IS2 = decltype(is2_)::value;
        if (k + 1 < 9) { asm volatile("" :: "v"(qn[0]), "v"(qn[1]), "v"(qn[2]), "v"(qn[3]));
#pragma unroll
            for (int d0 = 0; d0 < 4; ++d0) qr[d0] = qn[d0]; }
        if constexpr (IS2) asm volatile("" :: "v"(a0[0]), "v"(a0[1]), "v"(a0[2]), "v"(a0[3]), "v"(a1[0]), "v"(a1[1]), "v"(a1[2]), "v"(a1[3]), "v"(gvv[0]), "v"(gvv[1]), "v"(gvv[2]), "v"(gvv[3]), "v"(lp0), "v"(lp1));
        { const int tq = c + ((u0 + wid * 32 + r32) << rsh);
          if constexpr (IS2) { const float inv_ = __builtin_amdgcn_rcpf((lp0 + lp1) + l_reg); const int le_ = lx_lane(); if (le_ < 32) wsf[le_] = inv_; }
          u32x4 sv[4]; ot_rows(o, shm + LDS_K + kb * (LDS_K2 - LDS_K) + wid * 4096, r32, hi, lane, sv);
          asm volatile("" ::: "memory");
          if constexpr (!IS2) {
#pragma unroll
              for (int i = 0; i < 4; ++i) { const int t = c + ((u0 + wid * 32 + i * 8 + (lane >> 3)) << rsh);
                  if (p == 0) __builtin_amdgcn_raw_buffer_store_b128(sv[i], o1_rsrc, (unsigned)((t * 768 + h * 64 + (lane & 7) * 8) * 2), 0, 16);
                  else __builtin_amdgcn_raw_buffer_store_b128(sv[i], mix_rsrc, (unsigned)((t * 1024 + 256 + h * 64 + (lane & 7) * 8) * 2), 0, 16); }
              if (hi == 0) __hip_atomic_store((unsigned*)(A.lp + ((size_t)p * SEQ + tq) * 12 + h), __float_as_uint(l_reg), __ATOMIC_RELAXED, __HIP_MEMORY_SCOPE_AGENT);
              asm volatile("" ::: "memory");
              if (p == 1) asm volatile("s_waitcnt vmcnt(0)" ::: "memory");
          } else {
              float inv[4];
#pragma unroll
              for (int i = 0; i < 4; ++i) inv[i] = wsf[i * 8 + (lx_lane() >> 3)];
#pragma unroll
              for (int i = 0; i < 4; ++i) { u32x4 w;
#pragma unroll
                  for (int e = 0; e < 4; ++e) {
                      const float lo = (__uint_as_float(a0[i][e] << 16) + __uint_as_float(a1[i][e] << 16) + __uint_as_float(sv[i][e] << 16)) * inv[i] * __uint_as_float(gvv[i][e] << 16);
                      const float hi2 = (__uint_as_float(a0[i][e] & 0xffff0000u) + __uint_as_float(a1[i][e] & 0xffff0000u) + __uint_as_float(sv[i][e] & 0xffff0000u)) * inv[i] * __uint_as_float(gvv[i][e] & 0xffff0000u);
                      w[e] = cvtpk_s(lo, hi2); }
                  sv[i] = w; }
              asm volatile("" ::: "memory");
#pragma unroll
              for (int i = 0; i < 4; ++i) { const int t = c + ((u0 + wid * 32 + i * 8 + (lane >> 3)) << rsh); *(u32x4*)(A.mix + (size_t)t * 1024 + 256 + h * 64 + (lane & 7) * 8) = sv[i]; }
              if (hi == 0) A.lp[((size_t)2 * SEQ + tq) * 12 + h] = l_reg;
          } } };
        if (p == 2) tail(att_true{}); else tail(att_false{});
    }
#undef DIL_DECODE
#undef DIL_KKEY
#undef DIL_KCH
#undef DIL_VKEY
#undef DIL_VCH
#undef DIL_ISSUE_K
#undef DIL_ISSUE_V
#undef DIL_LOADQ
    ATT_BAR_L();
}
#undef ATT_WAIT_BAR
#undef ATT_BAR_L
}
constexpr int NWAVES = 8;
constexpr int N_LAUNCHES = MK_N_LAUNCHES;
constexpr int DEPTH = 4, SEQ = 16384, DM = 1024, NIN = 4096;
constexpr int N_PHASES = 1 + 3 * DEPTH;
constexpr size_t MiB = 1u << 20;
constexpr size_t WS_CTL = 0, CTL_ZERO_BYTES = 128 * 1024;
constexpr size_t WS_ROPE = 1 * MiB;
constexpr size_t WS_SSQ = 2 * MiB;
constexpr size_t WS_LP = 3 * MiB;
constexpr size_t WS_W = 6 * MiB, W_STRIDE = 10 * MiB, W_OUT_OFF = 8 * MiB;
constexpr size_t WS_XB = 46 * MiB;
constexpr size_t WS_MIX = 78 * MiB;
constexpr size_t WS_PROJ = 110 * MiB;
constexpr size_t WS_XL = 238 * MiB;
constexpr size_t WS_END = 254 * MiB;
static_assert(PROJ_PAD == 0, "workspace map assumes unpadded head tensors");
constexpr int CW_BAR = 4096;
static_assert((16384 + 4 * 8 * 3 * 64) * 4 <= 128 * 1024, "control words inside the memset region");
constexpr int CW_GRP = 16384;
constexpr int RING_OFF = 0, RING_BYTES = 131072;
constexpr int LDSCTL_OFF = 151552, MISC_OFF = LDSCTL_OFF + 320;
constexpr int LDS_BYTES = 153600;
static_assert(att::LDS_END <= LDSCTL_OFF && RING_BYTES + pg8::EpiInProj::XL_BYTES <= LDSCTL_OFF, "phase scratch below the control words");

#define GAS __attribute__((address_space(1)))
#define LAS __attribute__((address_space(3)))
typedef unsigned short bf16;
typedef unsigned v4u __attribute__((ext_vector_type(4)));
typedef float f32x4 __attribute__((ext_vector_type(4)));
typedef GAS unsigned gu32;
#define RLX_AGENT __ATOMIC_RELAXED, __HIP_MEMORY_SCOPE_AGENT
#define LDS_WAIT() asm volatile("s_waitcnt lgkmcnt(0)" ::: "memory")
#define VM_WAIT() asm volatile("s_waitcnt vmcnt(0)" ::: "memory")
__device__ __forceinline__ unsigned f2bf(float f) { unsigned u = __builtin_bit_cast(unsigned, f); return (u + 0x7fffu + ((u >> 16) & 1u)) >> 16; }
__device__ __forceinline__ unsigned pk2(float lo, float hi) { return f2bf(lo) | (f2bf(hi) << 16); }
#define XB_TMO      128
#define XB_XCNT(j)  (256  + 64 * (j))
#define XB_XSUB(j)  (1280 + 64 * (j))
#define XB_XGEN(j)  (2304 + 64 * (j))
#define XB_TOP      3328
#define XB_TOPGEN   3392
#define XCD_BAR_WORDS 3456
#define XB_SPIN_CAP (1u << 18)

__device__ __forceinline__ unsigned xb_ld(unsigned* p)              { return __hip_atomic_load(p, __ATOMIC_RELAXED, __HIP_MEMORY_SCOPE_AGENT); }
__device__ __forceinline__ unsigned xb_add(unsigned* p, unsigned v) { return __hip_atomic_fetch_add(p, v, __ATOMIC_RELAXED, __HIP_MEMORY_SCOPE_AGENT); }
__device__ __forceinline__ unsigned xb_xcc_id() { return (unsigned)__builtin_amdgcn_s_getreg((3 << 11) | 20) & 0xFu; }
#define XB_SPIN(cond, bar) do { unsigned _sp = 0; while (cond) { __builtin_amdgcn_s_sleep(1); \
    if ((++_sp & 255u) == 0u) { if (xb_ld(&(bar)[XB_TMO])) break; if (_sp > XB_SPIN_CAP) { atomicAdd(&(bar)[XB_TMO], 1u); break; } } } } while (0)

struct XcdBarrier {
    unsigned* bar; unsigned x;
    volatile LAS unsigned* st;
};

__device__ __forceinline__ XcdBarrier xcd_barrier_post(unsigned* bar, volatile LAS unsigned* st, bool leader) {
    XcdBarrier b; b.bar = bar; b.x = xb_xcc_id(); b.st = st;
    if (leader) (void)xb_add(&bar[XB_XCNT(b.x)], 1u);
    return b;
}
__device__ __forceinline__ void xcd_barrier_complete(unsigned* bar, unsigned x, unsigned& nloc, unsigned& nx) {
    const unsigned G = gridDim.x * gridDim.y * gridDim.z;
    unsigned sum, cnt, mine, sp = 0u;
    for (;;) {
        sum = 0u; cnt = 0u; mine = 0u;
#pragma unroll
        for (unsigned j = 0; j < 16; ++j) { const unsigned c = xb_ld(&bar[XB_XCNT(j)]); sum += c; cnt += (c > 0u) ? 1u : 0u; mine = (j == x) ? c : mine; }
        if (sum == G) break;
        __builtin_amdgcn_s_sleep(1);
        if ((++sp & 255u) == 0u) { if (xb_ld(&bar[XB_TMO])) break; if (sp > XB_SPIN_CAP) { atomicAdd(&bar[XB_TMO], 1u); break; } }
    }
    nloc = mine > 0u ? mine : 1u; nx = cnt > 0u ? cnt : 1u;
}

__device__ __forceinline__ void xcd_barrier(const XcdBarrier& b, bool leader) {
    asm volatile("s_waitcnt vmcnt(0)" ::: "memory");
    __syncthreads();
    if (leader) {
        unsigned* bar = b.bar;
        __builtin_amdgcn_s_waitcnt(0);
        unsigned nloc = b.st[0], nx = b.st[1];
        if (nloc == 0u) { xcd_barrier_complete(bar, b.x, nloc, nx); b.st[0] = nloc; b.st[1] = nx; }
        const unsigned old = xb_add(&bar[XB_XSUB(b.x)], 1u);
        const unsigned gen = old / nloc;
        if (old + 1u == (gen + 1u) * nloc) {
            __builtin_amdgcn_fence(__ATOMIC_RELEASE, "agent");
            asm volatile("s_waitcnt vmcnt(0)" ::: "memory");
            const unsigned og = xb_add(&bar[XB_TOP], 1u);
            const unsigned tg = og / nx;
            if (og + 1u == (tg + 1u) * nx) xb_add(&bar[XB_TOPGEN], 1u);
            else XB_SPIN(xb_ld(&bar[XB_TOPGEN]) == tg, bar);
            __builtin_amdgcn_fence(__ATOMIC_ACQUIRE, "agent");
            xb_add(&bar[XB_XGEN(b.x)], 1u);
            asm volatile("s_waitcnt vmcnt(0)" ::: "memory");
        } else {
            XB_SPIN(xb_ld(&bar[XB_XGEN(b.x)]) == gen, bar);
            __builtin_amdgcn_fence(__ATOMIC_ACQUIRE, "agent");
            asm volatile("s_waitcnt vmcnt(0)" ::: "memory");
        }
    }
    __syncthreads();
}


__device__ __forceinline__ void xcd_barrier_census(unsigned* bar, unsigned x, unsigned& nloc, unsigned& mask) {
    const unsigned G = gridDim.x * gridDim.y * gridDim.z;
    unsigned sum, msk, mine, sp = 0u;
    for (;;) {
        sum = 0u; msk = 0u; mine = 0u;
#pragma unroll
        for (unsigned j = 0; j < 16; ++j) { const unsigned c = xb_ld(&bar[XB_XCNT(j)]); sum += c; msk |= (c > 0u) ? (1u << j) : 0u; mine = (j == x) ? c : mine; }
        if (sum == G) break;
        __builtin_amdgcn_s_sleep(1);
        if ((++sp & 255u) == 0u) { if (xb_ld(&bar[XB_TMO])) break; if (sp > XB_SPIN_CAP) { atomicAdd(&bar[XB_TMO], 1u); break; } }
    }
    nloc = mine > 0u ? mine : 1u; mask = msk | (1u << x);
}
__device__ __forceinline__ void xcd_barrier_flat(const XcdBarrier& b, int wave) {
    asm volatile("s_waitcnt vmcnt(0)" ::: "memory");
    __syncthreads();
    if (wave == 0) {
        unsigned* bar = b.bar;
        __builtin_amdgcn_s_waitcnt(0);
        unsigned nloc = b.st[0], mask = b.st[1];
        if (nloc == 0u) { xcd_barrier_census(bar, b.x, nloc, mask); b.st[0] = nloc; b.st[1] = mask; }
        const int lane = lx_lane();
        unsigned old = 0u; if (lane == 0) old = xb_add(&bar[XB_XSUB(b.x)], 1u);
        old = (unsigned)__builtin_amdgcn_readfirstlane((int)old);
        const unsigned gen = old / nloc;
        if (old + 1u == (gen + 1u) * nloc) {
            __builtin_amdgcn_fence(__ATOMIC_RELEASE, "agent");
            asm volatile("s_waitcnt vmcnt(0)" ::: "memory");
            if (lane == 0) (void)xb_add(&bar[XB_XGEN(b.x)], 1u);
        }
        const unsigned j = (unsigned)lane & 15u; const bool need = ((mask >> j) & 1u) != 0u;
        unsigned sp = 0u;
        for (;;) { const unsigned v = need ? xb_ld(&bar[XB_XGEN(j)]) : 0xffffffffu;
            if (__builtin_amdgcn_ballot_w64(v <= gen) == 0ull) break;
            __builtin_amdgcn_s_sleep(1);
            if ((++sp & 255u) == 0u) { if (xb_ld(&bar[XB_TMO])) break; if (sp > XB_SPIN_CAP) { if (lane == 0) atomicAdd(&bar[XB_TMO], 1u); break; } } }
        __builtin_amdgcn_fence(__ATOMIC_ACQUIRE, "agent");
        asm volatile("s_waitcnt vmcnt(0)" ::: "memory");
    }
    __syncthreads();
}

__device__ __forceinline__ void xcd_barrier_arrive(const XcdBarrier& b, int wave) {
    asm volatile("s_waitcnt vmcnt(0)" ::: "memory");
    __syncthreads();
    if (wave == 0) {
        unsigned* bar = b.bar;
        __builtin_amdgcn_s_waitcnt(0);
        unsigned nloc = b.st[0], mask = b.st[1];
        if (nloc == 0u) { xcd_barrier_census(bar, b.x, nloc, mask); b.st[0] = nloc; b.st[1] = mask; }
        const int lane = lx_lane();
        unsigned old = 0u; if (lane == 0) old = xb_add(&bar[XB_XSUB(b.x)], 1u);
        old = (unsigned)__builtin_amdgcn_readfirstlane((int)old);
        const unsigned gen = old / nloc;
        if (old + 1u == (gen + 1u) * nloc) {
            __builtin_amdgcn_fence(__ATOMIC_RELEASE, "agent");
            asm volatile("s_waitcnt vmcnt(0)" ::: "memory");
            if (lane == 0) (void)xb_add(&bar[XB_XGEN(b.x)], 1u);
        }
        b.st[2] = gen;
    }
}
__device__ __forceinline__ void xcd_barrier_wait(const XcdBarrier& b, int wave) {
    if (wave == 0) {
        unsigned* bar = b.bar; const unsigned mask = b.st[1], gen = b.st[2]; const int lane = lx_lane();
        const unsigned j = (unsigned)lane & 15u; const bool need = ((mask >> j) & 1u) != 0u;
        unsigned sp = 0u;
        for (;;) { const unsigned v = need ? xb_ld(&bar[XB_XGEN(j)]) : 0xffffffffu;
            if (__builtin_amdgcn_ballot_w64(v <= gen) == 0ull) break;
            __builtin_amdgcn_s_sleep(1);
            if ((++sp & 255u) == 0u) { if (xb_ld(&bar[XB_TMO])) break; if (sp > XB_SPIN_CAP) { if (lane == 0) atomicAdd(&bar[XB_TMO], 1u); break; } } }
        __builtin_amdgcn_fence(__ATOMIC_ACQUIRE, "agent");
        asm volatile("s_waitcnt vmcnt(0)" ::: "memory");
    }
    __syncthreads();
}
__device__ __forceinline__ float wave_sum(float v) {
    return lx_wave_sum(v);
}
template <bool PERMN> __device__ __forceinline__ void transpose_item(const float* W, int K, int N, bf16* WT, const float* gk, LAS float* scr, int item, int lane) {
    const int nblk = N / 32, kb = item / nblk, nb = item % nblk, k0 = 64 * kb, n0 = 32 * nb;
    float wv[32];
#pragma unroll
    for (int i = 0; i < 32; ++i) wv[i] = W[(size_t)(k0 + 2 * i + (lane >> 5)) * N + n0 + (lane & 31)];
    if (gk) {
#pragma unroll
        for (int i = 0; i < 32; ++i) wv[i] *= gk[k0 + 2 * i + (lane >> 5)]; }
#pragma unroll
    for (int i = 0; i < 32; ++i) scr[(2 * i + (lane >> 5)) * 33 + (lane & 31)] = wv[i];
    LDS_WAIT(); asm volatile("" ::: "memory");
    const int c = lane & 7;
#pragma unroll
    for (int j = 0; j < 4; ++j) { const int n = (lane >> 3) + 8 * j; const LAS float* s = scr + (8 * c) * 33 + n;
        v4u o; o.x = pk2(s[0 * 33], s[1 * 33]); o.y = pk2(s[2 * 33], s[3 * 33]); o.z = pk2(s[4 * 33], s[5 * 33]); o.w = pk2(s[6 * 33], s[7 * 33]);
        const int col = n0 + n; const int pos = PERMN ? ((col & ~255) + 128 * ((col >> 5) & 1) + 32 * ((col >> 6) & 3) + (col & 31)) : col;
        *(GAS v4u*)(WT + (size_t)pos * K + k0 + 8 * c) = o; }
    LDS_WAIT(); asm volatile("" ::: "memory");
}
struct KArgs { const float* x; const float* norm_g; const float* w_in; const float* q_norm_g; const float* k_norm_g; const float* w_out; float* out; unsigned char* ws; int ph_lo, ph_hi; };

__device__ __forceinline__ void convert_weights(const KArgs& a, LAS unsigned char* lds, int vcu, int G, int wave0, int l_lo, int l_hi) {
    const int wave = wave0; const int tid = lx_tid(wave); const int lane = tid & 63; const int gw = vcu * NWAVES + wave, NGW = G * NWAVES;
    LAS float* scr = (LAS float*)(lds + RING_OFF + wave * 16384);
    constexpr int I_IN = (DM / 64) * (NIN / 32), I_OUT = (DM / 64) * (DM / 32), I_L = I_IN + I_OUT;
    for (int it0 = l_lo * I_L + gw; it0 < l_hi * I_L; it0 += NGW) { const int l = it0 / I_L, it = it0 - l * I_L;
        bf16* WinT = (bf16*)(a.ws + WS_W + (size_t)l * W_STRIDE); bf16* WoutT = (bf16*)(a.ws + WS_W + (size_t)l * W_STRIDE + W_OUT_OFF);
        if (it < I_IN) transpose_item<true>(a.w_in + (size_t)l * DM * NIN, DM, NIN, WinT, a.norm_g + l * DM, scr, it, lane);
        else transpose_item<false>(a.w_out + (size_t)l * DM * DM, DM, DM, WoutT, nullptr, scr, it - I_IN, lane);
    }
}
__device__ __forceinline__ void sincos_acc(float angf, float& c, float& s) {
    const double ang = (double)angf; const double kq = __builtin_rint(ang * 0.63661977236758134308);
    const double r = __builtin_fma(-kq, 1.5707963267948966192, ang) - kq * 6.123233995736766036e-17; const double r2 = r * r;
    double sp = -1.0 / 1307674368000.0; sp = sp * r2 + 1.0 / 6227020800.0; sp = sp * r2 - 1.0 / 39916800.0; sp = sp * r2 + 1.0 / 362880.0; sp = sp * r2 - 1.0 / 5040.0; sp = sp * r2 + 1.0 / 120.0; sp = sp * r2 - 1.0 / 6.0; sp = sp * r2 * r + r;
    double cp = 1.0 / 87178291200.0; cp = cp * r2 - 1.0 / 479001600.0; cp = cp * r2 + 1.0 / 3628800.0; cp = cp * r2 - 1.0 / 40320.0; cp = cp * r2 + 1.0 / 720.0; cp = cp * r2 - 1.0 / 24.0; cp = cp * r2 + 0.5; cp = 1.0 - cp * r2;
    const int q = ((int)kq) & 3;
    const double sv = (q == 0) ? sp : (q == 1) ? cp : (q == 2) ? -sp : -cp, cv = (q == 0) ? cp : (q == 1) ? -sp : (q == 2) ? -cp : sp;
    c = (float)cv; s = (float)sv;
}
__device__ __forceinline__ float inv_freq(int i) {
    return i == 0 ? 1.0f : i == 1 ? 0.193922758102417f : i == 2 ? 0.03760603070259094f : i == 3 ? 0.00729266507551074f : i == 4 ? 0.001414213445968926f : i == 5 ? 0.00027424818836152554f : i == 6 ? 5.318296462064609e-05f : 1.0313385246263351e-05f;
}

#define AS1(p) ((decltype(p))(GAS void*)(p))
__global__ void __launch_bounds__(NWAVES * 64, 2) hsdg_fwd(KArgs args_in) {
    KArgs args = args_in; args.x = AS1(args_in.x); args.norm_g = AS1(args_in.norm_g); args.w_in = AS1(args_in.w_in); args.q_norm_g = AS1(args_in.q_norm_g); args.k_norm_g = AS1(args_in.k_norm_g);
    args.w_out = AS1(args_in.w_out); args.out = AS1(args_in.out); args.ws = AS1(args_in.ws);
    extern __shared__ __attribute__((aligned(16))) unsigned char lds_raw[];
    LAS unsigned char* lds = (LAS unsigned char*)lds_raw;
    volatile LAS unsigned* MISC = (volatile LAS unsigned*)(lds + MISC_OFF);
    const int wave0 = __builtin_amdgcn_readfirstlane((int)threadIdx.x >> 6); const int tid0 = lx_tid(wave0);
    const int G = gridDim.x; const int bx = blockIdx.x; const int vcu = (G % 8 == 0) ? (bx % 8) * (G / 8) + bx / 8 : bx;
    unsigned char* ws = args.ws;
    gu32* ctl = (gu32*)(ws + WS_CTL);
    for (int u = tid0; u < (LDS_BYTES - LDSCTL_OFF) / 4; u += NWAVES * 64) ((LAS unsigned*)(lds + LDSCTL_OFF))[u] = 0u;
    __syncthreads();
    XcdBarrier bar; bar.bar = (unsigned*)(ctl + CW_BAR); bar.x = 0; bar.st = nullptr;
    if (N_LAUNCHES == 1) bar = xcd_barrier_post((unsigned*)(ctl + CW_BAR), MISC + 8, tid0 == 0);
#define GRID_BAR() do { if (N_LAUNCHES == 1) xcd_barrier_flat(bar, wave0); } while (0)
    const int lo = args.ph_lo, hi = args.ph_hi;
#define IN(k) (lo <= (k) && (k) < hi)
#define BOTH(k) (IN(k) && IN((k) + 1))
#define PHASE_PTRS() unsigned char* wsp; { unsigned long long w_ = (unsigned long long)ws; asm volatile("" : "+s"(w_)); wsp = (unsigned char*)(GAS unsigned char*)w_; } float* rope = (float*)(wsp + WS_ROPE); float* ssq = (float*)(wsp + WS_SSQ); float* lp = (float*)(wsp + WS_LP); \
        bf16* XB = (bf16*)(wsp + WS_XB); unsigned char* XL = wsp + WS_XL; (void)XL; bf16* MIX = (bf16*)(wsp + WS_MIX); bf16* PROJ = (bf16*)(wsp + WS_PROJ); (void)rope; (void)ssq; (void)lp; (void)XB; (void)MIX; (void)PROJ

    if (IN(0)) {
        PHASE_PTRS(); convert_weights(args, lds, vcu, G, wave0, 0, 1);
        const int wave = wave0; const int tid = lx_tid(wave); const int lane = tid & 63; const int gw = vcu * NWAVES + wave, NGW = G * NWAVES;
        for (int m = gw; m < SEQ; m += 4 * NGW) {
            f32x4 v[4][4]; float s2[4];
#pragma unroll
            for (int q = 0; q < 4; ++q) { const int mm = m + q * NGW; const GAS f32x4* xr = (const GAS f32x4*)(args.x + (size_t)(mm < SEQ ? mm : m) * DM) + lane;
#pragma unroll
                for (int j = 0; j < 4; ++j) v[q][j] = xr[64 * j]; }
#pragma unroll
            for (int q = 0; q < 4; ++q) { float a = 0.f;
#pragma unroll
                for (int j = 0; j < 4; ++j) a += (v[q][j].x * v[q][j].x + v[q][j].y * v[q][j].y) + (v[q][j].z * v[q][j].z + v[q][j].w * v[q][j].w);
                s2[q] = wave_sum(a); }
#pragma unroll
            for (int q = 0; q < 4; ++q) { const int mm = m + q * NGW; if (mm < SEQ) {
                GAS unsigned long long* o8 = (GAS unsigned long long*)(XB + (size_t)mm * DM) + lane;
#pragma unroll
                for (int j = 0; j < 4; ++j) { const unsigned h0 = pk2(v[q][j].x, v[q][j].y), h1 = pk2(v[q][j].z, v[q][j].w); o8[64 * j] = (unsigned long long)h0 | ((unsigned long long)h1 << 32);
                    ((GAS unsigned*)(XL + (size_t)mm * DM))[lane + 64 * j] = xs_lo(v[q][j].x, h0 << 16) | (xs_lo(v[q][j].y, h0 & 0xffff0000u) << 8) | (xs_lo(v[q][j].z, h1 << 16) << 16) | (xs_lo(v[q][j].w, h1 & 0xffff0000u) << 24); }
                if (lane < 4) ssq[(size_t)mm * 4 + lane] = (lane == 0) ? s2[q] : 0.f; } }
        }
        for (int i = bx * (NWAVES * 64) + tid; i < SEQ * 8; i += G * NWAVES * 64) { const int pos = i >> 3, k = i & 7; float c, s; sincos_acc((float)pos * inv_freq(k), c, s); rope[pos * 16 + k] = c; rope[pos * 16 + 8 + k] = s; }
        if (N_LAUNCHES == 1) { if (BOTH(0)) { xcd_barrier_arrive(bar, wave0); convert_weights(args, lds, vcu, G, wave0, 1, 2); xcd_barrier_wait(bar, wave0); } }
        else convert_weights(args, lds, vcu, G, wave0, 1, DEPTH);
    }
    for (int l = 0; l < DEPTH; ++l) {
        const int pA = 1 + 3 * l, pB = pA + 1, pC = pA + 2;
        if (IN(pA)) {
            PHASE_PTRS(); bf16* WinT = (bf16*)(wsp + WS_W + (size_t)l * W_STRIDE); const float* qg = args.q_norm_g + l * 64; const float* kg = args.k_norm_g + l * 64;
            pg8::Gemm g{XB, WinT, SEQ, NIN, DM}; pg8::StaticOrder S; S.init(SEQ, NIN, G, bx);
            { static_assert(pg8::EpiInProj::OFF_ROPE == WS_ROPE && pg8::EpiInProj::OFF_SSQ == WS_SSQ && pg8::EpiInProj::OFF_P == WS_PROJ, "workspace offsets"); pg8::EpiInProj E{wsp, qg, kg, (LAS unsigned char*)(lds + RING_OFF + RING_BYTES), -1};
            pg8::gemm_phase<pg8::EpiInProj, pg8::StaticOrder, true, true>(lds + RING_OFF, g, S, E, wave0); }
            if (BOTH(pA)) { if (N_LAUNCHES == 1 && l == 0 && DEPTH > 2) { xcd_barrier_arrive(bar, wave0); convert_weights(args, lds, vcu, G, wave0, 2, 3); xcd_barrier_wait(bar, wave0); } else GRID_BAR(); }
        }
        if (IN(pB)) {
            PHASE_PTRS(); const float* qg = args.q_norm_g + l * 64; const float* kg = args.k_norm_g + l * 64; gu32* ctlp = (gu32*)(wsp + WS_CTL);
            const att::SbArgs SA{PROJ, MIX};
            const att::DilArgs DA{PROJ, (bf16*)args.out, MIX, lp, (unsigned*)(ctlp + CW_GRP + l * 8 * 3 * 64), qg, kg};
            for (int u = vcu; u < 256; u += G) att::sb_unit<SB_EARLY_EXIT != 0>(u >> 6, u & 63, SA, (att::lds_ptr)(lds + RING_OFF), wave0);
            att::dil_phase<0>(vcu, G, DA, (att::lds_ptr)(lds + RING_OFF), wave0);
            if (BOTH(pB)) { if (N_LAUNCHES == 1 && l == 0 && DEPTH > 3) { xcd_barrier_arrive(bar, wave0); convert_weights(args, lds, vcu, G, wave0, 3, DEPTH); xcd_barrier_wait(bar, wave0); } else GRID_BAR(); }
        }
        if (IN(pC)) {
            PHASE_PTRS(); bf16* WoutT = (bf16*)(wsp + WS_W + (size_t)l * W_STRIDE + W_OUT_OFF);
            pg8::Gemm g{MIX, WoutT, SEQ, DM, DM}; pg8::StaticOrder S; S.init(SEQ, DM, G, bx);
            pg8::EpiOutProj E{XB, XL, args.out, ssq, l == DEPTH - 1 ? 1 : 0};
            pg8::gemm_phase<pg8::EpiOutProj, pg8::StaticOrder, false, true>(lds + RING_OFF, g, S, E, wave0);
            if (pC + 1 < N_PHASES && BOTH(pC)) GRID_BAR();
        }
    }
#undef IN
#undef BOTH
#undef GRID_BAR
}

extern "C" void kernel_launch(void* const* d_in, const int* in_sizes, int n_in, void* d_out, int out_size, void* d_ws, size_t ws_size, hipStream_t stream) {
    static int grid = 0;
    if (grid == 0) {
        if (n_in != 6 || in_sizes[0] != SEQ * DM || out_size != SEQ * DM || ws_size < WS_END) { fprintf(stderr, "kernel_launch: unexpected shapes / workspace (n_in %d, in0 %d, out %d, ws %zu, need %zu)\n", n_in, n_in > 0 ? in_sizes[0] : -1, out_size, ws_size, (size_t)WS_END); grid = -1; return; }
        int dev = 0, cus = 0, per_cu = 0;
        if (hipGetDevice(&dev) != hipSuccess || hipDeviceGetAttribute(&cus, hipDeviceAttributeMultiprocessorCount, dev) != hipSuccess) { fprintf(stderr, "kernel_launch: device query failed\n"); grid = -1; return; }
        if (hipFuncSetAttribute((const void*)hsdg_fwd, hipFuncAttributeMaxDynamicSharedMemorySize, LDS_BYTES) != hipSuccess) { fprintf(stderr, "kernel_launch: hipFuncSetAttribute failed\n"); grid = -1; return; }
        if (hipOccupancyMaxActiveBlocksPerMultiprocessor(&per_cu, (const void*)hsdg_fwd, NWAVES * 64, LDS_BYTES) != hipSuccess || per_cu < 1) fprintf(stderr, "kernel_launch: note: occupancy query reports %d workgroups per CU\n", per_cu);
        (void)hipGetLastError();
        grid = cus;
        if (grid != 256) fprintf(stderr, "kernel_launch: %d CUs; the out-proj phase assumes 256 workgroups\n", grid);
    }
    if (grid < 0) return;
    if (hipMemsetAsync((char*)d_ws + WS_CTL, 0, CTL_ZERO_BYTES, stream) != hipSuccess) { fprintf(stderr, "kernel_launch: hipMemsetAsync failed\n"); return; }
    KArgs a{};
    a.x = (const float*)d_in[0]; a.norm_g = (const float*)d_in[1]; a.w_in = (const float*)d_in[2]; a.q_norm_g = (const float*)d_in[3]; a.k_norm_g = (const float*)d_in[4]; a.w_out = (const float*)d_in[5];
    a.out = (float*)d_out; a.ws = (unsigned char*)d_ws;
    if (N_LAUNCHES == 1) { a.ph_lo = 0; a.ph_hi = N_PHASES; hipLaunchKernelGGL(hsdg_fwd, dim3(grid), dim3(NWAVES * 64), LDS_BYTES, stream, a); }
    else for (int ph = 0; ph < N_PHASES; ++ph) { a.ph_lo = ph; a.ph_hi = ph + 1; hipLaunchKernelGGL(hsdg_fwd, dim3(grid), dim3(NWAVES * 64), LDS_BYTES, stream, a); }
    const hipError_t le = hipPeekAtLastError();
    if (le != hipSuccess) fprintf(stderr, "kernel_launch: launch failed: %s\n", hipGetErrorName(le));
}
```

```cpp
#include <hip/hip_runtime.h>
#include <cstdio>
#include <cstdint>
#ifndef MK_N_LAUNCHES
#define MK_N_LAUNCHES 1
#endif
#ifndef PROJ_PAD
#define PROJ_PAD 0
#endif
#ifndef SB_EARLY_EXIT
#define SB_EARLY_EXIT 1
#endif
template <int X> __device__ __forceinline__ float lx_xor(float v) { return __builtin_bit_cast(float, __builtin_amdgcn_ds_swizzle(__builtin_bit_cast(int, v), (X << 10) | 0x1f)); }
__device__ __forceinline__ int lx_lane() { int l; asm volatile("v_mbcnt_lo_u32_b32 %0, -1, 0\n\tv_mbcnt_hi_u32_b32 %0, -1, %0" : "=v"(l)); return l; }
__device__ __forceinline__ float lx_xor32(float v) { return __builtin_bit_cast(float, __builtin_amdgcn_ds_bpermute((lx_lane() ^ 32) << 2, __builtin_bit_cast(int, v))); }
__device__ __forceinline__ float lx_sum32(float v) { return v + lx_xor32(v); }
__device__ __forceinline__ float lx_max32(float v) { return __builtin_fmaxf(v, lx_xor32(v)); }
__device__ __forceinline__ float lx_wave_sum(float v) { v += lx_xor<1>(v); v += lx_xor<2>(v); v += lx_xor<4>(v); v += lx_xor<8>(v); v += lx_xor<16>(v); return lx_sum32(v); }
__device__ __forceinline__ float lx_wave_max(float v) { v = __builtin_fmaxf(v, lx_xor<1>(v)); v = __builtin_fmaxf(v, lx_xor<2>(v)); v = __builtin_fmaxf(v, lx_xor<4>(v)); v = __builtin_fmaxf(v, lx_xor<8>(v)); v = __builtin_fmaxf(v, lx_xor<16>(v)); return lx_max32(v); }
__device__ __forceinline__ int lx_tid(int wave) { return wave * 64 + lx_lane(); }
__device__ __forceinline__ unsigned xs_lo(float x, unsigned hi_shl16) { const unsigned u = (__builtin_bit_cast(unsigned, x) - hi_shl16 + 0x8080u) >> 8; return u < 255u ? u : 255u; }
__device__ __forceinline__ float xs_join(unsigned hi_shl16, unsigned lo8) { return __builtin_bit_cast(float, hi_shl16 + (lo8 << 8) - 0x8000u); }
namespace pg8 {
#define PG8_LAS __attribute__((address_space(3)))
typedef unsigned short bf16_t;
typedef short bf16x8 __attribute__((ext_vector_type(8)));
typedef float f32x4 __attribute__((ext_vector_type(4)));
typedef unsigned u32x4 __attribute__((ext_vector_type(4)));
constexpr int BM = 256, BK = 64, HALF = 128, HTB = HALF * BK * 2  , STAGE_BYTES = 8 * HTB, NXCD = 8, WGM = 8;

__host__ __device__ __forceinline__ int lds_byte(int r, int c) { const int st = (r >> 4) * 2 + (c >> 5), rr = r & 15, cc = c & 31, ob = rr * 64 + cc * 2; return st * 1024 + (ob ^ (((ob >> 9) & 1) << 5)); }
__host__ __device__ __forceinline__ void stage_rc(int b, int& R, int& C) { const int st = b / 1024, sb = b % 1024, swz = sb ^ (((sb >> 9) & 1) << 5); R = (st >> 1) * 16 + swz / 64; C = (st & 1) * 32 + (swz % 64) / 2; }
__host__ __device__ __forceinline__ int perm32(int rho) { const int n = rho >> 4, i = rho & 15; return 8 * (i >> 2) + 4 * n + (i & 3); }

struct Unit { int pm, pn; };
struct Gemm { const bf16_t* A; const bf16_t* Bt; int M, N, K; };

struct StaticOrder {
    int nM, nN, nwg, G, c;
    __host__ __device__ void init(int M, int N, int G_, int c_) { nM = M / BM; nN = N / BM; nwg = nM * nN; G = G_; c = c_; }
    __host__ __device__ bool next(int i, Unit& u) const {
        const long L = (long)i * G + c; if (L >= nwg) return false;
        int wgid = (int)L; { const int q = nwg / NXCD, r = nwg % NXCD, xcd = wgid % NXCD, off = wgid / NXCD; wgid = (xcd < r ? xcd * (q + 1) : r * (q + 1) + (xcd - r) * q) + off; }
        const int nig = WGM * nN, gid = wgid / nig, fm = gid * WGM, gsz = (nM - fm) < WGM ? (nM - fm) : WGM;
        u.pm = fm + ((wgid % nig) % gsz); u.pn = (wgid % nig) / gsz; return true;
    }
    __device__ __forceinline__ void a_ready(const Unit&) const {}
    __device__ __forceinline__ void done(const Unit&) const {}
};

typedef float f32x2 __attribute__((ext_vector_type(2)));
typedef __bf16 bf16x2_t __attribute__((ext_vector_type(2)));
__device__ __forceinline__ unsigned cvtpk(float lo, float hi) { f32x2 v = {lo, hi}; bf16x2_t b = __builtin_convertvector(v, bf16x2_t); return __builtin_bit_cast(unsigned, b); }
constexpr int SEQ = 16384; constexpr int PROWS = SEQ + (PROJ_PAD ? SEQ / 16 : 0); constexpr size_t TSTRIDE = (size_t)PROWS * 64;
constexpr float EPSV = 1e-6f;
constexpr float QSCALE = 0.125f * 1.4426950408889634f;

struct EpiInProj {
    static constexpr bool PERM = true, AFTER_DRAIN = false; static constexpr int STORES = 16;
    unsigned char* wsb; const float* qg; const float* kg; PG8_LAS unsigned char* xl; mutable int pm_c;
    static constexpr size_t OFF_ROPE = (size_t)1 << 20, OFF_SSQ = (size_t)2 << 20, OFF_P = (size_t)110 << 20;
    static constexpr int XL_ROPE = 0, XL_RS = 16384, XL_G = 17408, XL_BYTES = 17920;
    struct Prep { f32x4 r0, r1, sq, gv; };
    static constexpr bool HAS_PREP = true;
    __device__ __forceinline__ void prep_load(Prep& pp, const Unit& u, int wr, int wc, int fr, int fq) const {
        const float* const ssq = (const float*)(wsb + OFF_SSQ); const float* const rp = (const float*)(wsb + OFF_ROPE) + (size_t)u.pm * BM * 16;
        const int t = (wr * 4 + wc) * 64 + fq * 16 + fr;
        pp.r0 = *(const f32x4*)(rp + 4 * t); pp.r1 = *(const f32x4*)(rp + 4 * (t + 512));
        pp.sq = (f32x4){0.f, 0.f, 0.f, 0.f}; pp.gv = (f32x4){0.f, 0.f, 0.f, 0.f};
        if (t < 256) { const size_t r_ = (size_t)(u.pm * BM + t); pp.sq = (f32x4){ssq[r_], ssq[SEQ + r_], ssq[2 * (size_t)SEQ + r_], ssq[3 * (size_t)SEQ + r_]}; }
        if (t < 32) pp.gv = *(const f32x4*)((t < 16 ? qg : kg) + 4 * (t & 15)); }
    __device__ __forceinline__ void prep_store(const Prep& pp, const Unit& u, int wr, int wc, int fr, int fq) const {
        const int t = (wr * 4 + wc) * 64 + fq * 16 + fr; pm_c = u.pm;
        { const int a = t, b = t + 512;
          *(PG8_LAS f32x4*)(xl + XL_ROPE + (a >> 2) * 64 + (((a & 3) ^ ((a >> 4) & 3)) << 4)) = pp.r0; *(PG8_LAS f32x4*)(xl + XL_ROPE + (b >> 2) * 64 + (((b & 3) ^ ((b >> 4) & 3)) << 4)) = pp.r1; }
        if (t < 256) *(PG8_LAS float*)(xl + XL_RS + 4 * t) = __builtin_amdgcn_rsqf(((pp.sq[0] + pp.sq[1]) + (pp.sq[2] + pp.sq[3])) * (1.0f / 1024.0f) + EPSV);
        if (t < 32) *(PG8_LAS f32x4*)(xl + XL_G + 16 * t) = pp.gv; }
    __device__ __forceinline__ void operator()(const f32x4 (&acc)[2][2][4][2], const Unit& u, int wr, int wc, int fr, int fq) const {
        bf16_t* const P = (bf16_t*)(wsb + OFF_P);
        if (u.pm != pm_c) {
            Prep pp; prep_load(pp, u, wr, wc, fr, fq);
            __builtin_amdgcn_s_barrier();
            prep_store(pp, u, wr, wc, fr, fq);
            asm volatile("s_waitcnt lgkmcnt(0)" ::: "memory"); __builtin_amdgcn_s_barrier(); asm volatile("" ::: "memory");
        }
        const int pn = u.pn;
        const __amdgpu_buffer_rsrc_t p_rsrc = __builtin_amdgcn_make_buffer_rsrc((void*)P, 0, 0x08000000, 0x00020000);
        const int kind = (pn == 0) ? 0 : ((pn == 3 || pn >= 13) ? 1 : ((pn >= 4 && pn <= 6) ? 2 : ((pn >= 7 && pn <= 9) ? 3 : 4)));
        bf16_t* const tens = P + (size_t)(pn * 4 + wc) * TSTRIDE + 8 * fq;
        const int rl0 = wr * 64 + fr, row0 = u.pm * BM + rl0;
        float rs[8];
#pragma unroll
        for (int j = 0; j < 8; ++j) rs[j] = *(const PG8_LAS float*)(xl + XL_RS + 4 * (rl0 + (j >> 2) * HALF + (j & 3) * 16));
        f32x4 g[2][2];
#pragma unroll
        for (int bj = 0; bj < 2; ++bj)
#pragma unroll
            for (int n = 0; n < 2; ++n) g[bj][n] = (f32x4){1.f, 1.f, 1.f, 1.f};
        if (kind == 2 || kind == 3) {
#pragma unroll
            for (int bj = 0; bj < 2; ++bj)
#pragma unroll
                for (int n = 0; n < 2; ++n) g[bj][n] = *(const PG8_LAS f32x4*)(xl + XL_G + (kind == 3 ? 256 : 0) + 4 * (32 * bj + 8 * fq + 4 * n)); }
        if (kind == 0) {
#pragma unroll
            for (int j = 0; j < 8; ++j) rs[j] *= QSCALE; }
        const PG8_LAS unsigned char* const rrow = xl + XL_ROPE + rl0 * 64; const int sw = ((fr >> 2) & 3) << 4;
#pragma unroll
        for (int ai = 0; ai < 2; ++ai)
#pragma unroll
            for (int m = 0; m < 4; ++m) {
                const int row = row0 + ai * HALF + m * 16;
                f32x4 v[2][2];
#pragma unroll
                for (int bj = 0; bj < 2; ++bj)
#pragma unroll
                    for (int n = 0; n < 2; ++n) v[bj][n] = acc[ai][bj][m][n] * rs[ai * 4 + m];
                if (kind == 1) {
#pragma unroll
                    for (int bj = 0; bj < 2; ++bj)
#pragma unroll
                        for (int n = 0; n < 2; ++n)
#pragma unroll
                            for (int e = 0; e < 4; ++e) { const float x = v[bj][n][e]; v[bj][n][e] = x * __builtin_amdgcn_rcpf(1.0f + __builtin_amdgcn_exp2f(-1.4426950408889634f * x)); }
                } else if (kind == 2 || kind == 3) {
                    f32x4 cs[2], sn[2];
#pragma unroll
                    for (int n = 0; n < 2; ++n) { cs[n] = *(const PG8_LAS f32x4*)(rrow + (ai * HALF + m * 16) * 64 + ((16 * n) ^ sw)); sn[n] = *(const PG8_LAS f32x4*)(rrow + (ai * HALF + m * 16) * 64 + ((32 + 16 * n) ^ sw)); }
                    float hs = 0.f;
#pragma unroll
                    for (int bj = 0; bj < 2; ++bj)
#pragma unroll
                        for (int n = 0; n < 2; ++n) { const f32x4 x = v[bj][n]; hs += (x[0] * x[0] + x[1] * x[1]) + (x[2] * x[2] + x[3] * x[3]); }
                    hs += lx_xor<16>(hs); hs = lx_sum32(hs);
                    const float hr = __builtin_amdgcn_rsqf(hs * (1.0f / 64.0f) + EPSV) * (kind == 2 ? QSCALE : 1.0f);
#pragma unroll
                    for (int bj = 0; bj < 2; ++bj)
#pragma unroll
                        for (int n = 0; n < 2; ++n) v[bj][n] = v[bj][n] * hr * g[bj][n];
#pragma unroll
                    for (int n = 0; n < 2; ++n)
#pragma unroll
                        for (int e = 0; e < 4; ++e) { const float cc = cs[n][e], ss2 = sn[n][e];
                            const float own = v[0][n][e]; const float oth = lx_xor<16>(own);
                            const float r0 = own * cc - oth * ss2, r1 = own * cc + oth * ss2;
                            v[0][n][e] = (fq == 0) ? r0 : ((fq == 1) ? r1 : own); }
                }
                bf16_t* rowp = tens + (size_t)(PROJ_PAD ? row + (row >> 4) : row) * 64;
#pragma unroll
                for (int bj = 0; bj < 2; ++bj) { u32x4 w; w.x = cvtpk(v[bj][0][0], v[bj][0][1]); w.y = cvtpk(v[bj][0][2], v[bj][0][3]); w.z = cvtpk(v[bj][1][0], v[bj][1][1]); w.w = cvtpk(v[bj][1][2], v[bj][1][3]);
                    __builtin_amdgcn_raw_buffer_store_b128(w, p_rsrc, (unsigned)((size_t)((const char*)(rowp + 32 * bj) - (const char*)P)), 0, 16); }
            }
    }
};

typedef unsigned u32x2 __attribute__((ext_vector_type(2)));
struct EpiOutProj {
    static constexpr bool PERM = true, AFTER_DRAIN = true, HAS_PREP = false; static constexpr int STORES = 0;
    bf16_t* xh; unsigned char* xl; float* xout; float* ssq; int last; int wt;
    struct Pre { u32x4 ph[2][2][2]; u32x2 pl[2][2][2]; };
    static constexpr int PRELOADS = 16;
#define EOP_LOAD(buf, pr) do { _Pragma("unroll") for (int q_ = 0; q_ < 2; ++q_) { const int j_ = 2 * (pr) + q_; const size_t o_ = off0 + (size_t)((j_ >> 2) * HALF + (j_ & 3) * 16) * 1024; \
            _Pragma("unroll") for (int bj = 0; bj < 2; ++bj) { ph[buf][q_][bj] = *(const u32x4*)(xh + o_ + bj * HALF); pl[buf][q_][bj] = *(const u32x2*)(xl + o_ + bj * HALF); } } } while (0)
    __device__ __forceinline__ void preload(Pre& P, const Unit& u, int wr, int wc, int fr, int fq) const {
        const size_t off0 = (size_t)(u.pm * BM + wr * 64 + fr) * 1024 + u.pn * BM + wc * 32 + 8 * fq; auto& ph = P.ph; auto& pl = P.pl;
        EOP_LOAD(0, 0); asm volatile("" ::: "memory"); EOP_LOAD(1, 1); asm volatile("" ::: "memory"); }
    __device__ __forceinline__ void fused(f32x4 (&acc)[2][2][4][2], const Unit& u, int wr, int wc, int fr, int fq, PG8_LAS unsigned char* lds, int wid, int lane, Pre& P) const {
        PG8_LAS float* Pw = (PG8_LAS float*)lds;
        const size_t off0 = (size_t)(u.pm * BM + wr * 64 + fr) * 1024 + u.pn * BM + wc * 32 + 8 * fq;
        const __amdgpu_buffer_rsrc_t xh_rsrc = __builtin_amdgcn_make_buffer_rsrc((void*)xh, 0, 16384 * 1024 * 2, 0x00020000);
        auto& ph = P.ph; auto& pl = P.pl;
#pragma unroll
        for (int pr = 0; pr < 4; ++pr) {
#pragma unroll
            for (int q = 0; q < 2; ++q) { const int j = 2 * pr + q, ai = j >> 2, m = j & 3; const int rt = ai * HALF + wr * 64 + m * 16 + fr; const size_t off = off0 + (size_t)(ai * HALF + m * 16) * 1024;
                float s = 0.f;
#pragma unroll
                for (int bj = 0; bj < 2; ++bj) {
                    const u32x4 h = ph[pr & 1][q][bj]; const u32x2 lo = pl[pr & 1][q][bj];
                    float a[8];
#pragma unroll
                    for (int e = 0; e < 8; ++e) { const unsigned hw = h[e >> 1], hs = (e & 1) ? (hw & 0xffff0000u) : (hw << 16), l8 = (lo[e >> 2] >> (8 * (e & 3))) & 0xffu;
                        a[e] = xs_join(hs, l8) + acc[ai][bj][m][e >> 2][e & 3]; }
                    if (last) { *(f32x4*)(xout + off + bj * HALF) = (f32x4){a[0], a[1], a[2], a[3]}; *(f32x4*)(xout + off + bj * HALF + 4) = (f32x4){a[4], a[5], a[6], a[7]}; }
                    else { u32x4 w; w.x = cvtpk(a[0], a[1]); w.y = cvtpk(a[2], a[3]); w.z = cvtpk(a[4], a[5]); w.w = cvtpk(a[6], a[7]);
                        unsigned l[8];
#pragma unroll
                        for (int e = 0; e < 8; ++e) { const unsigned hw = w[e >> 1]; l[e] = xs_lo(a[e], (e & 1) ? (hw & 0xffff0000u) : (hw << 16)); }
                        u32x2 lw; lw.x = l[0] | (l[1] << 8) | (l[2] << 16) | (l[3] << 24); lw.y = l[4] | (l[5] << 8) | (l[6] << 16) | (l[7] << 24);
                        if (wt) __builtin_amdgcn_raw_buffer_store_b128(w, xh_rsrc, (unsigned)((off + bj * HALF) * 2), 0, 16); else *(u32x4*)(xh + off + bj * HALF) = w;
                        *(u32x2*)(xl + off + bj * HALF) = lw; }
                    s += ((a[0] * a[0] + a[1] * a[1]) + (a[2] * a[2] + a[3] * a[3])) + ((a[4] * a[4] + a[5] * a[5]) + (a[6] * a[6] + a[7] * a[7]));
                }
                s += lx_xor<16>(s); s = lx_sum32(s);
                if (fq == 0) Pw[rt * 4 + wc] = s; }
            asm volatile("" ::: "memory");
            if (pr + 2 < 4) { EOP_LOAD(pr & 1, pr + 2); asm volatile("" ::: "memory"); }
        }
#undef EOP_LOAD
        asm volatile("s_waitcnt lgkmcnt(0)" ::: "memory"); __builtin_amdgcn_s_barrier(); asm volatile("" ::: "memory");
        const int t = wid * 64 + lane;
        if (t < 64) { f32x4 s4;
#pragma unroll
            for (int j = 0; j < 4; ++j) { const int r_ = 4 * t + j; s4[j] = (Pw[r_ * 4 + 0] + Pw[r_ * 4 + 1]) + (Pw[r_ * 4 + 2] + Pw[r_ * 4 + 3]); }
            float* dst = ssq + (size_t)u.pn * SEQ + (size_t)u.pm * BM + 4 * t;
            if (wt) { const __amdgpu_buffer_rsrc_t sq_rsrc = __builtin_amdgcn_make_buffer_rsrc((void*)ssq, 0, 4 * SEQ * 4, 0x00020000);
                __builtin_amdgcn_raw_buffer_store_b128(__builtin_bit_cast(u32x4, s4), sq_rsrc, (unsigned)((u.pn * SEQ + u.pm * BM + 4 * t) * 4), 0, 16); }
            else *(f32x4*)dst = s4; }
        asm volatile("s_waitcnt lgkmcnt(0)" ::: "memory"); __builtin_amdgcn_s_barrier(); asm volatile("" ::: "memory");
    }
};

template <class Epi, class Sched, bool ALIGN_EPI = false, bool SP2 = false>
__device__ __forceinline__ void gemm_phase(PG8_LAS unsigned char* lds, const Gemm g, const Sched& S, const Epi& E, int wave) {
    int wid = wave; asm volatile("" : "+s"(wid)); const int tid = lx_tid(wid);
    const int lane = tid & 63, wr = wid >> 2, wc = wid & 3, fr = lane & 15, fq = lane >> 4;
    const int K = g.K, nt = K / BK;
    unsigned voffA[2], voffB[2];
#pragma unroll
    for (int i = 0; i < 2; ++i) { int R, C; stage_rc(tid * 16 + i * 8192, R, C); const int Rb = Epi::PERM ? ((R & ~31) + perm32(R & 31)) : R;
        voffA[i] = (unsigned)(R * K + C) * 2u; voffB[i] = (unsigned)(Rb * K + C) * 2u; }
    const size_t kstep = (size_t)(BK * 2);
    const size_t hstep = (size_t)HALF * K * 2;
    const size_t tstep = 2 * hstep;
    const unsigned ldsw = (unsigned)wid * 1024u;
    const int aoff = lds_byte(wr * 64 + fr, fq * 8), boff = lds_byte(wc * 32 + fr, fq * 8);
#define PG8_SA(b, h) (((b) * 2 + (h)) * HTB)
#define PG8_SB(b, h) ((4 + (b) * 2 + (h)) * HTB)
#define PG8_STAGE(bufoff, gbase, voff) do { _Pragma("unroll") for (int _i = 0; _i < 2; ++_i) \
        __builtin_amdgcn_global_load_lds((const unsigned*)((const char*)(gbase) + (voff)[_i]), (PG8_LAS unsigned*)(lds + (bufoff) + ldsw + _i * 8192), 16, 0, 0); } while (0)
#define PG8_LDA(dst, b, h) do { _Pragma("unroll") for (int m = 0; m < 4; ++m) _Pragma("unroll") for (int k = 0; k < 2; ++k) dst[m][k] = *(const PG8_LAS bf16x8*)(lds + PG8_SA(b, h) + aoff + m * 2048 + k * 1024); } while (0)
#define PG8_LDB(dst, b, h) do { _Pragma("unroll") for (int n = 0; n < 2; ++n) _Pragma("unroll") for (int k = 0; k < 2; ++k) dst[n][k] = *(const PG8_LAS bf16x8*)(lds + PG8_SB(b, h) + boff + n * 2048 + k * 1024); } while (0)
#define PG8_MMA(ai, bj, At, Bt) do { __builtin_amdgcn_s_setprio(1); _Pragma("unroll") for (int m = 0; m < 4; ++m) _Pragma("unroll") for (int n = 0; n < 2; ++n) _Pragma("unroll") for (int k = 0; k < 2; ++k) \
        acc[ai][bj][m][n] = __builtin_amdgcn_mfma_f32_16x16x32_bf16(Bt[n][k], At[m][k], acc[ai][bj][m][n], 0, 0, 0); __builtin_amdgcn_s_setprio(0); } while (0)
#define PG8_WAIT_V(n) asm volatile("s_waitcnt vmcnt(" #n ")" ::: "memory")
#define PG8_WAIT_L(n) asm volatile("s_waitcnt lgkmcnt(" #n ")" ::: "memory")
#define PG8_WAIT_VS(relax) asm volatile("s_waitcnt vmcnt(%1)\n\ts_cmp_lg_u32 %0, 0\n\ts_cbranch_scc1 .Lpg8w%=\n\ts_waitcnt vmcnt(8)\n.Lpg8w%=:" :: "s"(relax), "n"(8 + Epi::STORES) : "scc", "memory")
#define PG8_BAR __builtin_amdgcn_s_barrier()
#define PG8_SCHED __builtin_amdgcn_sched_barrier(0)
    Unit cur, nxt; int ui = 0;
    if (!S.next(0, cur)) return;
    f32x4 acc[2][2][4][2];
#pragma unroll
    for (int a = 0; a < 2; ++a)
#pragma unroll
        for (int b = 0; b < 2; ++b)
#pragma unroll
            for (int m = 0; m < 4; ++m)
#pragma unroll
                for (int n = 0; n < 2; ++n) acc[a][b][m][n] = (f32x4){0.f, 0.f, 0.f, 0.f};
    bf16x8 At[4][2], B0[2][2], B1[2][2];
    const char* cA = (const char*)g.A + (size_t)cur.pm * tstep; const char* cB = (const char*)g.Bt + (size_t)cur.pn * tstep;
    S.a_ready(cur);
    if constexpr (SP2) {
        if constexpr (Epi::HAS_PREP) {
            typename Epi::Prep pp; E.prep_load(pp, cur, wr, wc, fr, fq);
            PG8_STAGE(PG8_SB(0, 0), cB, voffB); PG8_STAGE(PG8_SB(0, 1), cB + hstep, voffB); PG8_STAGE(PG8_SA(0, 0), cA, voffA); PG8_STAGE(PG8_SA(0, 1), cA + hstep, voffA);
            if (wr == 1) PG8_BAR;
            PG8_WAIT_V(2); PG8_BAR;
            E.prep_store(pp, cur, wr, wc, fr, fq);
        } else {
        PG8_STAGE(PG8_SB(0, 0), cB, voffB); PG8_STAGE(PG8_SB(0, 1), cB + hstep, voffB); PG8_STAGE(PG8_SA(0, 0), cA, voffA); PG8_STAGE(PG8_SA(0, 1), cA + hstep, voffA);
        if (wr == 1) PG8_BAR;
        PG8_WAIT_V(2); PG8_BAR;
        }
        PG8_STAGE(PG8_SB(1, 0), cB + kstep, voffB); PG8_STAGE(PG8_SA(1, 0), cA + kstep, voffA); PG8_STAGE(PG8_SB(1, 1), cB + hstep + kstep, voffB);
        PG8_WAIT_V(6); PG8_BAR;
    } else {
        PG8_STAGE(PG8_SB(0, 0), cB, voffB); PG8_STAGE(PG8_SA(0, 0), cA, voffA); PG8_STAGE(PG8_SB(0, 1), cB + hstep, voffB); PG8_STAGE(PG8_SA(0, 1), cA + hstep, voffA);
        if (wr == 1) PG8_BAR;
        PG8_WAIT_V(4); PG8_BAR;
        PG8_STAGE(PG8_SB(1, 0), cB + kstep, voffB); PG8_STAGE(PG8_SA(1, 0), cA + kstep, voffA); PG8_STAGE(PG8_SB(1, 1), cB + hstep + kstep, voffB);
        PG8_WAIT_V(6); PG8_BAR;
    }
    for (;;) {
        const bool has_next = S.next(ui + 1, nxt);
        const char* nA = has_next ? (const char*)g.A + (size_t)nxt.pm * tstep : cA; const char* nB = has_next ? (const char*)g.Bt + (size_t)nxt.pn * tstep : cB;
        for (int t = 0; t < nt; t += 2) {
            const bool last = (t == nt - 2);
            const char* a1 = cA + (size_t)(t + 1) * kstep;
            const char* a2 = last ? nA : cA + (size_t)(t + 2) * kstep; const char* b2 = last ? nB : cB + (size_t)(t + 2) * kstep;
            const char* a3 = a2 + kstep; const char* b3 = b2 + kstep;
            if (last && has_next) S.a_ready(nxt);
            const int relax = __builtin_amdgcn_readfirstlane((t == 0 && ui > 0) ? 1 : 0); (void)relax;
            if constexpr (SP2) {
            PG8_LDB(B0, 0, 0); PG8_LDB(B1, 0, 1); PG8_SCHED; PG8_LDA(At, 0, 0); PG8_STAGE(PG8_SA(1, 1), a1 + hstep, voffA);
            if constexpr (Epi::STORES > 0) PG8_WAIT_VS(relax); else PG8_WAIT_V(8);
            PG8_WAIT_L(0); PG8_BAR; PG8_MMA(0, 0, At, B0); PG8_MMA(0, 1, At, B1); PG8_BAR; PG8_SCHED;
            PG8_LDA(At, 0, 1); PG8_STAGE(PG8_SB(0, 0), b2, voffB); PG8_STAGE(PG8_SB(0, 1), b2 + hstep, voffB); PG8_STAGE(PG8_SA(0, 0), a2, voffA);
            if constexpr (Epi::STORES > 0) PG8_WAIT_VS(relax); else PG8_WAIT_V(8);
            PG8_WAIT_L(0); PG8_BAR; PG8_MMA(1, 0, At, B0); PG8_MMA(1, 1, At, B1); PG8_BAR; PG8_SCHED;
            PG8_LDB(B0, 1, 0); PG8_LDB(B1, 1, 1); PG8_SCHED; PG8_LDA(At, 1, 0); PG8_STAGE(PG8_SA(0, 1), a2 + hstep, voffA);
            PG8_WAIT_V(8); PG8_WAIT_L(0); PG8_BAR; PG8_MMA(0, 0, At, B0); PG8_MMA(0, 1, At, B1); PG8_BAR; PG8_SCHED;
            PG8_LDA(At, 1, 1); PG8_STAGE(PG8_SB(1, 0), b3, voffB); PG8_STAGE(PG8_SB(1, 1), b3 + hstep, voffB); PG8_STAGE(PG8_SA(1, 0), a3, voffA);
            PG8_WAIT_V(8); PG8_WAIT_L(0); PG8_BAR; PG8_MMA(1, 0, At, B0); PG8_MMA(1, 1, At, B1); PG8_BAR; PG8_SCHED;
            } else {
            PG8_LDB(B0, 0, 0); PG8_SCHED; PG8_LDA(At, 0, 0); PG8_STAGE(PG8_SA(1, 1), a1 + hstep, voffA);
            PG8_WAIT_L(8); PG8_BAR; PG8_WAIT_L(0); PG8_MMA(0, 0, At, B0); PG8_BAR; PG8_SCHED;
            PG8_LDB(B1, 0, 1); PG8_STAGE(PG8_SB(0, 0), b2, voffB);
            PG8_BAR; PG8_WAIT_L(0); PG8_MMA(0, 1, At, B1); PG8_BAR;
            PG8_LDA(At, 0, 1); PG8_STAGE(PG8_SA(0, 0), a2, voffA);
            PG8_BAR; PG8_WAIT_L(0); PG8_MMA(1, 0, At, B0); PG8_BAR; PG8_SCHED;
            PG8_STAGE(PG8_SB(0, 1), b2 + hstep, voffB);
            PG8_WAIT_V(6); PG8_BAR; PG8_MMA(1, 1, At, B1); PG8_BAR;
            PG8_LDB(B0, 1, 0); PG8_SCHED; PG8_LDA(At, 1, 0); PG8_STAGE(PG8_SA(0, 1), a2 + hstep, voffA);
            PG8_WAIT_L(8); PG8_BAR; PG8_WAIT_L(0); PG8_MMA(0, 0, At, B0); PG8_BAR; PG8_SCHED;
            PG8_LDB(B1, 1, 1); PG8_STAGE(PG8_SB(1, 0), b3, voffB);
            PG8_BAR; PG8_WAIT_L(0); PG8_MMA(0, 1, At, B1); PG8_BAR;
            PG8_LDA(At, 1, 1); PG8_STAGE(PG8_SA(1, 0), a3, voffA);
            PG8_BAR; PG8_WAIT_L(0); PG8_MMA(1, 0, At, B0); PG8_BAR; PG8_SCHED;
            PG8_STAGE(PG8_SB(1, 1), b3 + hstep, voffB);
            PG8_WAIT_V(6); PG8_BAR; PG8_MMA(1, 1, At, B1); PG8_BAR;
            }
        }
        if constexpr (ALIGN_EPI) { if (wr == 0) PG8_BAR; }
        if constexpr (!Epi::AFTER_DRAIN) { E(acc, cur, wr, wc, fr, fq);
            S.done(cur); }
        if (!has_next) break;
#pragma unroll
        for (int a = 0; a < 2; ++a)
#pragma unroll
            for (int b = 0; b < 2; ++b)
#pragma unroll
                for (int m = 0; m < 4; ++m)
#pragma unroll
                    for (int n = 0; n < 2; ++n) acc[a][b][m][n] = (f32x4){0.f, 0.f, 0.f, 0.f};
        cur = nxt; cA = nA; cB = nB; ++ui;
        if constexpr (ALIGN_EPI) { if (wr == 1) PG8_BAR; }
    }
    if constexpr (Epi::AFTER_DRAIN) {
        typename Epi::Pre pre; E.preload(pre, cur, wr, wc, fr, fq);
        asm volatile("s_waitcnt vmcnt(%0)" :: "n"(Epi::PRELOADS) : "memory");
        if constexpr (!ALIGN_EPI) { if (wr == 0) PG8_BAR; }
        PG8_BAR;
        E.fused(acc, cur, wr, wc, fr, fq, lds, wid, lane, pre); S.done(cur);
    } else {
    PG8_WAIT_V(0);
    if constexpr (!ALIGN_EPI) { if (wr == 0) PG8_BAR; }
    PG8_BAR;
    }
#undef PG8_SA
#undef PG8_SB
#undef PG8_STAGE
#undef PG8_LDA
#undef PG8_LDB
#undef PG8_MMA
#undef PG8_WAIT_V
#undef PG8_WAIT_L
#undef PG8_WAIT_VS
#undef PG8_BAR
#undef PG8_SCHED
}
}
namespace att {
#define ATT_LAS __attribute__((address_space(3)))
using bf16x8 = __attribute__((ext_vector_type(8))) short;
using s16x4 = __attribute__((ext_vector_type(4))) short;
using f32x16 = __attribute__((ext_vector_type(16))) float;
using u32x4 = __attribute__((ext_vector_type(4))) unsigned;
typedef unsigned short bf16_t;
typedef ATT_LAS const char* lds_cptr;
typedef ATT_LAS char* lds_ptr;
typedef short v4i16_t __attribute__((ext_vector_type(4)));
typedef float f32x2_t __attribute__((ext_vector_type(2))); typedef __bf16 bf16x2_t __attribute__((ext_vector_type(2)));
constexpr int SEQ = 16384;
constexpr int PROWS = SEQ + (PROJ_PAD ? SEQ / 16 : 0); constexpr size_t TSTRIDE = (size_t)PROWS * 64;
constexpr int T_QA = 0, T_KA = 4, T_VA = 8, T_GA = 12, T_QD = 16, T_KD = 28, T_VD = 40, T_GD = 52;
__device__ __forceinline__ int prow(int t) { return PROJ_PAD ? t + (t >> 4) : t; }
constexpr int SLOTB = 8192, NSLOT = 6;
constexpr int LDS_K = 0, LDS_K2 = NSLOT * SLOTB, LDS_V = 2 * NSLOT * SLOTB, LDS_WS = 3 * NSLOT * SLOTB, LDS_FLAG = LDS_WS + 8 * 64 * 4, LDS_END = LDS_FLAG + 128;
constexpr int LDS_OST = LDS_K2;
#define ATT_BAR_L() asm volatile("s_waitcnt lgkmcnt(0)\n\ts_barrier" ::: "memory")
__device__ __forceinline__ int crow(int r, int hi) { return (r & 3) + 8 * (r >> 2) + 4 * hi; }
__device__ __forceinline__ unsigned cvtpk_s(float lo, float hi) { f32x2_t v = {lo, hi}; bf16x2_t b = __builtin_convertvector(v, bf16x2_t); return __builtin_bit_cast(unsigned, b); }
__device__ __forceinline__ float bf2f(unsigned short b) { return __uint_as_float((unsigned)b << 16); }
__device__ __forceinline__ void glds16(const void* gsrc, unsigned lds_dst) { unsigned keep;
    asm volatile("s_mov_b32 %0, m0\n\ts_mov_b32 m0, %2\n\ts_nop 0\n\tglobal_load_lds_dwordx4 %1, off\n\ts_mov_b32 m0, %0" : "=&s"(keep) : "v"(gsrc), "s"(lds_dst) : "memory"); }
__device__ __forceinline__ void glds16s(unsigned voff, const void* sbase, unsigned lds_dst) { unsigned keep;
    const unsigned long long a_ = (unsigned long long)sbase;
    const unsigned long long b_ = (unsigned long long)(unsigned)__builtin_amdgcn_readfirstlane((int)(unsigned)a_) | ((unsigned long long)(unsigned)__builtin_amdgcn_readfirstlane((int)(unsigned)(a_ >> 32)) << 32);
    asm volatile("s_nop 4\n\ts_mov_b32 %0, m0\n\ts_mov_b32 m0, %3\n\ts_nop 0\n\tglobal_load_lds_dwordx4 %1, %2\n\ts_mov_b32 m0, %0" : "=&s"(keep) : "v"(voff), "s"(b_), "s"(lds_dst) : "memory"); }
#define ATT_WAIT_BAR(N) asm volatile("s_waitcnt vmcnt(" #N ") lgkmcnt(0)\n\ts_barrier" ::: "memory")
__device__ __forceinline__ s16x4 vtr(lds_cptr p) { return __builtin_bit_cast(s16x4, __builtin_amdgcn_ds_read_tr16_b64_v4i16((ATT_LAS v4i16_t*)p)); }

__device__ __forceinline__ void qkt(f32x16& p0, f32x16& p1, lds_cptr ks, const int (&koff)[4], const bf16x8* qr, const f32x16& cinit) {
#pragma unroll
    for (int d0 = 0; d0 < 4; ++d0) {
        const bf16x8 b0 = *(const ATT_LAS bf16x8*)(ks + koff[d0]);
        const bf16x8 b1 = *(const ATT_LAS bf16x8*)(ks + koff[d0] + 4096);
        if (d0 == 0) { p0 = __builtin_amdgcn_mfma_f32_32x32x16_bf16(b0, qr[0], cinit, 0, 0, 0); p1 = __builtin_amdgcn_mfma_f32_32x32x16_bf16(b1, qr[0], cinit, 0, 0, 0); }
        else { p0 = __builtin_amdgcn_mfma_f32_32x32x16_bf16(b0, qr[d0], p0, 0, 0, 0); p1 = __builtin_amdgcn_mfma_f32_32x32x16_bf16(b1, qr[d0], p1, 0, 0, 0); }
    }
}
__device__ __forceinline__ void pv(f32x16* o, lds_cptr vp, bf16x8 pa0, bf16x8 pa1, bf16x8 pa2, bf16x8 pa3) {
#pragma unroll
    for (int d0 = 0; d0 < 2; ++d0) { s16x4 lo[4], hi[4];
#pragma unroll
        for (int ks = 0; ks < 4; ++ks) { lo[ks] = vtr(vp + d0 * 4096 + ks * 1024); hi[ks] = vtr(vp + d0 * 4096 + ks * 1024 + 512); }
#define ATT_PK(k) (bf16x8){lo[k][0], lo[k][1], lo[k][2], lo[k][3], hi[k][0], hi[k][1], hi[k][2], hi[k][3]}
        o[d0] = __builtin_amdgcn_mfma_f32_32x32x16_bf16(ATT_PK(0), pa0, o[d0], 0, 0, 0);
        o[d0] = __builtin_amdgcn_mfma_f32_32x32x16_bf16(ATT_PK(1), pa1, o[d0], 0, 0, 0);
        o[d0] = __builtin_amdgcn_mfma_f32_32x32x16_bf16(ATT_PK(2), pa2, o[d0], 0, 0, 0);
        o[d0] = __builtin_amdgcn_mfma_f32_32x32x16_bf16(ATT_PK(3), pa3, o[d0], 0, 0, 0);
#undef ATT_PK
    }
}
__device__ __forceinline__ void ot_rows(const f32x16* o, lds_ptr stg, int q, int hi, int lane, u32x4* sv) {
#pragma unroll
    for (int d0 = 0; d0 < 2; ++d0)
#pragma unroll
        for (int pr = 0; pr < 2; ++pr) { const int g = 2 * pr;
            const unsigned ax = cvtpk_s(o[d0][4 * g], o[d0][4 * g + 1]), ay = cvtpk_s(o[d0][4 * g + 2], o[d0][4 * g + 3]), bx = cvtpk_s(o[d0][4 * g + 4], o[d0][4 * g + 5]), by = cvtpk_s(o[d0][4 * g + 6], o[d0][4 * g + 7]);
            const auto rx = __builtin_amdgcn_permlane32_swap(ax, bx, false, false); const auto ry = __builtin_amdgcn_permlane32_swap(ay, by, false, false);
            *(ATT_LAS u32x4*)(stg + q * 128 + (((4 * d0 + 2 * pr + hi) ^ (q & 7)) << 4)) = (u32x4){rx[0], ry[0], rx[1], ry[1]}; }
    asm volatile("s_waitcnt lgkmcnt(0)" ::: "memory");
#pragma unroll
    for (int i = 0; i < 4; ++i) { const int rw = 8 * i + (lane >> 3); sv[i] = *(const ATT_LAS u32x4*)(stg + rw * 128 + (((lane & 7) ^ (rw & 7)) << 4)); }
}
__device__ __forceinline__ bf16x8 pack8(const float* a) { u32x4 w; w.x = cvtpk_s(a[0], a[1]); w.y = cvtpk_s(a[2], a[3]); w.z = cvtpk_s(a[4], a[5]); w.w = cvtpk_s(a[6], a[7]); return __builtin_bit_cast(bf16x8, w); }

template <bool MASK> __device__ __forceinline__ void sb_tile(const f32x16& p0, const f32x16& p1, float& Srun, int qrel, int hi, bf16x8& pa0, bf16x8& pa1, bf16x8& pa2, bf16x8& pa3) {
    float run = Srun; unsigned pw[16];
#pragma unroll
    for (int g = 7; g >= 0; --g) {
        float bt[4], m[4];
#pragma unroll
        for (int e = 0; e < 4; ++e) { const int idx = 4 * g + e; const float z = (idx < 16) ? p0[idx] : p1[idx - 16];
            const float u = __builtin_amdgcn_exp2f(-__builtin_fmaxf(z, -100.0f));
            bt[e] = __builtin_amdgcn_rcpf(1.0f + u); m[e] = u * bt[e];
            if (MASK) { if (8 * g + 4 * hi + e >= qrel) { bt[e] = 0.f; m[e] = 1.f; } } }
        const float e2 = m[3], e1 = m[3] * m[2], e0 = e1 * m[1], T = e0 * m[0];
        const auto rr = __builtin_amdgcn_permlane32_swap(__float_as_uint(T), __float_as_uint(T), false, false);
        const float tev = __uint_as_float(rr[0]), tod = __uint_as_float(rr[1]);
        const float off = hi ? run : run * tod;
        run = run * (tev * tod);
        const float a0 = bt[0] * (off * e0), a1 = bt[1] * (off * e1), a2 = bt[2] * (off * e2), a3 = bt[3] * off;
        pw[2 * g] = cvtpk_s(a0, a1); pw[2 * g + 1] = cvtpk_s(a2, a3);
    }
    Srun = run;
    pa0 = __builtin_bit_cast(bf16x8, (u32x4){pw[0], pw[1], pw[2], pw[3]}); pa1 = __builtin_bit_cast(bf16x8, (u32x4){pw[4], pw[5], pw[6], pw[7]});
    pa2 = __builtin_bit_cast(bf16x8, (u32x4){pw[8], pw[9], pw[10], pw[11]}); pa3 = __builtin_bit_cast(bf16x8, (u32x4){pw[12], pw[13], pw[14], pw[15]});
}

struct SbArgs { const bf16_t* proj; bf16_t* mix; };
template <bool EARLY> __device__ __forceinline__ void sb_unit(int h, int qb, const SbArgs& A, lds_ptr shm, int wave) {
    int wid = wave; asm volatile("" : "+s"(wid)); const int tid = lx_tid(wid);
    const int lane = tid & 63, r32 = lane & 31, hi = lane >> 5;
    const int q0 = qb * 256;
    const bf16_t* Qh = A.proj + (size_t)(T_QA + h) * TSTRIDE; const bf16_t* Kh = A.proj + (size_t)(T_KA + h) * TSTRIDE; const bf16_t* Vh = A.proj + (size_t)(T_VA + h) * TSTRIDE;
    const unsigned lds0 = (unsigned)(size_t)shm;
    volatile ATT_LAS unsigned* flags = (volatile ATT_LAS unsigned*)(shm + LDS_FLAG);
    const unsigned kdst = lds0 + LDS_K + wid * 1024, vdst = lds0 + LDS_V + wid * 1024;
    const lds_cptr ks0 = (lds_cptr)shm + LDS_K; int koff[4];
#pragma unroll
    for (int d0 = 0; d0 < 4; ++d0) koff[d0] = r32 * 128 + (((2 * d0 + hi) ^ ((r32 >> 1) & 7)) << 4);
    const lds_cptr vp0 = (lds_cptr)shm + LDS_V + ((lane >> 4) & 1) * 32 + (lane & 3) * 8 + (4 * hi + ((lane & 15) >> 2)) * 64;
#define SB_DMA(jt, slot) do { const int jt_ = (jt) < 0 ? 0 : (jt); const int l_ = lx_lane(); const int kkey_ = 8 * wid + (l_ >> 3), vkey_ = 16 * (wid & 3) + (l_ >> 2); \
        const unsigned voffK_ = (unsigned)((prow(kkey_) * 64 + ((l_ & 7) ^ ((kkey_ >> 1) & 7)) * 8) * 2), voffV_ = (unsigned)((prow(vkey_) * 64 + (wid >> 2) * 32 + (l_ & 3) * 8) * 2); \
        glds16s(voffK_, (const char*)Kh + (size_t)jt_ * ((PROJ_PAD ? 68 : 64) * 128), (unsigned)__builtin_amdgcn_readfirstlane(kdst + (slot))); \
        glds16s(voffV_, (const char*)Vh + (size_t)jt_ * ((PROJ_PAD ? 68 : 64) * 128), (unsigned)__builtin_amdgcn_readfirstlane(vdst + (slot))); } while (0)
    const int jtop = 4 * qb + 3, jd = 4 * qb + (wid >> 1), qrel = 32 * (wid & 1) + r32;
    if (lane == 0) { flags[wid] = 0u; flags[8 + wid] = 0u; }
    bf16x8 qr[4];
    { const bf16_t* Qp = Qh + (size_t)prow(q0 + wid * 32 + r32) * 64;
#pragma unroll
      for (int d0 = 0; d0 < 4; ++d0) qr[d0] = *(const bf16x8*)(Qp + d0 * 16 + hi * 8); }
    const lds_ptr qst = shm + LDS_OST + wid * 4096 + lane * 16;
#pragma unroll
    for (int d0 = 0; d0 < 4; ++d0) *(ATT_LAS bf16x8*)(qst + d0 * 1024) = qr[d0];
    asm volatile("" ::: "memory");
#pragma unroll
    for (int i = 0; i < 6; ++i) SB_DMA(jtop - i, ((jtop - i + 6000) % 6) * SLOTB);
    f32x16 o[2]; o[0] = f32x16{}; o[1] = f32x16{}; const f32x16 zero = f32x16{};
    float Rsum = 1.0f; bool dead = false;
    for (int s = 0;; ++s) {
        const int jt = jd - s;
        if (s == 0) ATT_WAIT_BAR(4); else ATT_WAIT_BAR(2);
        if (s > 0) { const int fb = ((s - 1) & 1) * 8; unsigned all = 1u;
#pragma unroll
            for (int w = 0; w < 8; ++w) all &= flags[fb + w];
            if (all) break; }
        if (s > 0) SB_DMA(jtop - s - 5, ((jtop - s + 1 + 6000) % 6) * SLOTB);
        if (jt >= 0 && !dead) {
            const int slot = ((jt + 6000) % 6) * SLOTB;
            f32x16 p0, p1; bf16x8 pa0, pa1, pa2, pa3;
            { bf16x8 qf[4];
#pragma unroll
              for (int d0 = 0; d0 < 4; ++d0) qf[d0] = *(const ATT_LAS bf16x8*)(qst + d0 * 1024);
              qkt(p0, p1, ks0 + slot, koff, qf, zero); }
            __builtin_amdgcn_sched_barrier(0);
            if (s == 0) sb_tile<true>(p0, p1, Rsum, qrel, hi, pa0, pa1, pa2, pa3); else sb_tile<false>(p0, p1, Rsum, qrel, hi, pa0, pa1, pa2, pa3);
            __builtin_amdgcn_sched_barrier(0);
            pv(o, vp0 + slot, pa0, pa1, pa2, pa3);
            if (EARLY) dead = __all(Rsum == 0.0f);
        }
        const bool fin = dead || (jt <= 0);
        if (lane == 0) flags[(s & 1) * 8 + wid] = fin ? 1u : 0u;
    }
#undef SB_DMA
    asm volatile("s_waitcnt vmcnt(0)" ::: "memory");
    { const int l2 = lx_lane();
      u32x4 sv[4]; ot_rows(o, shm + LDS_OST + wid * 4096, l2 & 31, l2 >> 5, l2, sv);
      const bf16_t* Gh = A.proj + (size_t)(T_GA + h) * TSTRIDE; bf16_t* Mw = A.mix + (size_t)(q0 + wid * 32) * 1024 + h * 64;
#pragma unroll
      for (int i = 0; i < 4; ++i) { const int row = i * 8 + (l2 >> 3), chn = l2 & 7; const u32x4 gv = *(const u32x4*)(Gh + (size_t)prow(q0 + wid * 32 + row) * 64 + chn * 8);
          u32x4 w;
#pragma unroll
          for (int k = 0; k < 4; ++k) { const float lo = __uint_as_float(sv[i][k] << 16) * __uint_as_float(gv[k] << 16), hi2 = __uint_as_float(sv[i][k] & 0xffff0000u) * __uint_as_float(gv[k] & 0xffff0000u); w[k] = cvtpk_s(lo, hi2); }
          __builtin_amdgcn_raw_buffer_store_b128(w, __builtin_amdgcn_make_buffer_rsrc((void*)A.mix, 0, SEQ * 1024 * 2, 0x00020000), (unsigned)((size_t)((const char*)(Mw + (size_t)row * 1024 + chn * 8) - (const char*)A.mix)), 0, 16); } }
    ATT_BAR_L();
}

struct att_true { static constexpr bool value = true; }; struct att_false { static constexpr bool value = false; };
struct DilArgs { const bf16_t* proj; bf16_t* o1; bf16_t* mix; float* lp; unsigned* gcnt; const float* qg; const float* kg; };
template <int DUMMY = 0> __device__ __forceinline__ void dil_phase(int v, int G, const DilArgs& A, lds_ptr shm, int wave) {
    int wid = wave; asm volatile("" : "+s"(wid)); const int tid = lx_tid(wid);
    const int lane = tid & 63, r32 = lane & 31, hi = lane >> 5;
    const unsigned lds0 = (unsigned)(size_t)shm;
    ATT_LAS float* wsf = (ATT_LAS float*)(shm + LDS_WS) + wid * 64;
    const unsigned kdst0 = lds0 + LDS_K + wid * 1024, vdst = lds0 + LDS_V + wid * 1024;
    const lds_cptr ks00 = (lds_cptr)shm + LDS_K; int koff[4];
#pragma unroll
    for (int d0 = 0; d0 < 4; ++d0) koff[d0] = r32 * 128 + (((2 * d0 + hi) ^ ((r32 >> 1) & 7)) << 4);
    const lds_cptr vp0 = (lds_cptr)shm + LDS_V + ((lane >> 4) & 1) * 32 + (lane & 3) * 8 + (4 * hi + ((lane & 15) >> 2)) * 64;
#define DIL_KKEY(l_) (8 * wid + ((l_) >> 3))
#define DIL_KCH(l_) ((((l_) & 7) ^ ((DIL_KKEY(l_) >> 1) & 7)) * 8)
#define DIL_VKEY(l_) (16 * (wid & 3) + ((l_) >> 2))
#define DIL_VCH(l_) ((wid >> 2) * 32 + ((l_) & 3) * 8)
    float gq = __builtin_fabsf(A.qg[lane]), gk = __builtin_fabsf(A.kg[lane]);
    gq = lx_wave_max(gq); gk = lx_wave_max(gk);
    const float Mb = 64.0f * 0.125f * 1.4426950408889634f * 1.02f * gq * gk;
    f32x16 negm, negm0, negm4;
#pragma unroll
    for (int r = 0; r < 16; ++r) { const int dd = 8 * (r >> 2) + 4 * hi + (r & 3) - r32; negm[r] = -Mb; negm0[r] = (dd < 0) ? -3.0e38f : -Mb; negm4[r] = (dd > 0) ? -3.0e38f : -Mb; }
    const __amdgpu_buffer_rsrc_t o1_rsrc = __builtin_amdgcn_make_buffer_rsrc((void*)A.o1, 0, SEQ * 768 * 2, 0x00020000);
    const __amdgpu_buffer_rsrc_t mix_rsrc = __builtin_amdgcn_make_buffer_rsrc((void*)A.mix, 0, SEQ * 1024 * 2, 0x00020000);
#define DIL_DECODE(k, H, P, C, BLK) const int q_##H = 3 * (v >> 5) + (k) / 3, H = q_##H >> 1, P = (k) % 3, C = (v & 31) >> (5 - 2 * P), BLK = (q_##H & 1) * (32 >> (2 * P)) + ((v & 31) & ((32 >> (2 * P)) - 1))
#define DIL_ISSUE_K(H, P, C, BLK, KB) do { const int rsh_ = 2 * P; const int ll_ = lx_lane(); const unsigned kdst = kdst0 + (KB) * (LDS_K2 - LDS_K); const unsigned vo_ = (unsigned)((prow(C + (DIL_KKEY(ll_) << rsh_)) * 64 + DIL_KCH(ll_)) * 2); \
        const char* kb_ = (const char*)(A.proj + (size_t)(T_KD + H) * TSTRIDE) + (long)((BLK * 256 - 128) << rsh_) * (PROJ_PAD ? 136 : 128); \
        _Pragma("unroll") for (int j = 0; j < 6; ++j) glds16s(vo_, kb_ + (long)((64 * j) << rsh_) * (PROJ_PAD ? 136 : 128), (unsigned)__builtin_amdgcn_readfirstlane(kdst + j * SLOTB)); } while (0)
#define DIL_ISSUE_V(H, P, C, BLK) do { const int rsh_ = 2 * P; const int ll_ = lx_lane(); const unsigned vo_ = (unsigned)((prow(C + (DIL_VKEY(ll_) << rsh_)) * 64 + DIL_VCH(ll_)) * 2); \
        const char* vb_ = (const char*)(A.proj + (size_t)(T_VD + H) * TSTRIDE) + (long)((BLK * 256 - 128) << rsh_) * (PROJ_PAD ? 136 : 128); \
        _Pragma("unroll") for (int j = 0; j < 6; ++j) glds16s(vo_, vb_ + (long)((64 * j) << rsh_) * (PROJ_PAD ? 136 : 128), (unsigned)__builtin_amdgcn_readfirstlane(vdst + j * SLOTB)); } while (0)
#define DIL_LOADQ(QR, H, P, C, BLK) do { const bf16_t* Qp_ = A.proj + (size_t)(T_QD + H) * TSTRIDE + (size_t)prow(C + ((BLK * 256 + wid * 32 + r32) << (2 * P))) * 64; \
        _Pragma("unroll") for (int d0 = 0; d0 < 4; ++d0) QR[d0] = *(const bf16x8*)(Qp_ + d0 * 16 + hi * 8); } while (0)
    if (G != 256) return;
    bf16x8 qr[4];
    { DIL_DECODE(0, h0, p0_, c0, b0); DIL_ISSUE_K(h0, p0_, c0, b0, 0); DIL_LOADQ(qr, h0, p0_, c0, b0); DIL_ISSUE_V(h0, p0_, c0, b0); }
    asm volatile("" :: "v"(qr[0]), "v"(qr[1]), "v"(qr[2]), "v"(qr[3]));
    for (int k = 0; k < 9; ++k) {
        DIL_DECODE(k, h, p, c, blk);
        const int rsh = 2 * p, u0 = blk * 256;
        if (k == 0) asm volatile("s_waitcnt vmcnt(6) lgkmcnt(0)\n\ts_barrier" ::: "memory"); else asm volatile("s_waitcnt vmcnt(5) lgkmcnt(0)\n\ts_barrier" ::: "memory");
        if (p == 2 && tid == 0) __hip_atomic_fetch_add(A.gcnt + (3 * (v >> 5) + k / 3) * 64, 1u, __ATOMIC_RELAXED, __HIP_MEMORY_SCOPE_AGENT);
        if (k > 0) DIL_ISSUE_V(h, p, c, blk);
        const int kb = k & 1; const lds_cptr ks0 = ks00 + kb * (LDS_K2 - LDS_K);
        bf16x8 qn[4];
        unsigned kn_vo = 0u, kn_dst = 0u; const char* kn_b = nullptr; long kn_st = 0;
        if (k + 1 < 9) { DIL_DECODE(k + 1, hn, pn, cn, bn);
            const int rsh_ = 2 * pn; const int ll_ = lx_lane(); kn_vo = (unsigned)((prow(cn + (DIL_KKEY(ll_) << rsh_)) * 64 + DIL_KCH(ll_)) * 2); kn_dst = kdst0 + (kb ^ 1) * (LDS_K2 - LDS_K);
            kn_b = (const char*)(A.proj + (size_t)(T_KD + hn) * TSTRIDE) + (long)((bn * 256 - 128) << rsh_) * (PROJ_PAD ? 136 : 128); kn_st = (long)(64 << rsh_) * (PROJ_PAD ? 136 : 128); }
#define DIL_K_PIECE(j) glds16s(kn_vo, kn_b + (j) * kn_st, (unsigned)__builtin_amdgcn_readfirstlane(kn_dst + (j) * SLOTB))
        unsigned pw[5][8]; f32x2_t l2 = {0.f, 0.f};
#define DIL_QK(HH, S) do { const int ht_ = wid + (HH); const lds_cptr ks_ = ks0 + (ht_ >> 1) * SLOTB + (ht_ & 1) * 4096; bf16x8 kb_[4]; \
            _Pragma("unroll") for (int d0 = 0; d0 < 4; ++d0) kb_[d0] = *(const ATT_LAS bf16x8*)(ks_ + koff[d0]); \
            _Pragma("unroll") for (int d0 = 0; d0 < 4; ++d0) S = __builtin_amdgcn_mfma_f32_32x32x16_bf16(kb_[d0], qr[d0], d0 == 0 ? ((HH) == 0 ? negm0 : ((HH) == 4 ? negm4 : negm)) : S, 0, 0, 0); } while (0)
#define DIL_SM(HH, S) do { _Pragma("unroll") for (int g = 0; g < 4; ++g) { float a[4]; \
            _Pragma("unroll") for (int e = 0; e < 4; ++e) a[e] = __builtin_amdgcn_exp2f(S[4 * g + e]);        \
            l2 += (f32x2_t){a[0], a[1]}; l2 += (f32x2_t){a[2], a[3]}; pw[HH][2 * g] = cvtpk_s(a[0], a[1]); pw[HH][2 * g + 1] = cvtpk_s(a[2], a[3]); } } while (0)
#define DIL_PIN(HH) asm volatile("" :: "v"(pw[HH][0]), "v"(pw[HH][1]), "v"(pw[HH][2]), "v"(pw[HH][3]), "v"(pw[HH][4]), "v"(pw[HH][5]), "v"(pw[HH][6]), "v"(pw[HH][7]), "v"(l2))
#define DIL_SB() __builtin_amdgcn_sched_barrier(0)
#define DIL_SMG(HH, S, g) do { float a[4]; _Pragma("unroll") for (int e = 0; e < 4; ++e) a[e] = __builtin_amdgcn_exp2f(S[4 * (g) + e]); \
            l2 += (f32x2_t){a[0], a[1]}; l2 += (f32x2_t){a[2], a[3]}; pw[HH][2 * (g)] = cvtpk_s(a[0], a[1]); pw[HH][2 * (g) + 1] = cvtpk_s(a[2], a[3]); } while (0)
#define DIL_STAGE(HN, SN, HC, SC) do { const int ht_ = wid + (HN); const lds_cptr ks_ = ks0 + (ht_ >> 1) * SLOTB + (ht_ & 1) * 4096; bf16x8 k0_, k1_, k2_, k3_; \
            k0_ = *(const ATT_LAS bf16x8*)(ks_ + koff[0]); k1_ = *(const ATT_LAS bf16x8*)(ks_ + koff[1]); DIL_SB(); \
            SN = __builtin_amdgcn_mfma_f32_32x32x16_bf16(k0_, qr[0], (HN) == 4 ? negm4 : negm, 0, 0, 0); DIL_SB(); DIL_SMG(HC, SC, 0); k2_ = *(const ATT_LAS bf16x8*)(ks_ + koff[2]); DIL_SB(); \
            SN = __builtin_amdgcn_mfma_f32_32x32x16_bf16(k1_, qr[1], SN, 0, 0, 0); DIL_SB(); DIL_SMG(HC, SC, 1); k3_ = *(const ATT_LAS bf16x8*)(ks_ + koff[3]); DIL_SB(); \
            SN = __builtin_amdgcn_mfma_f32_32x32x16_bf16(k2_, qr[2], SN, 0, 0, 0); DIL_SB(); DIL_SMG(HC, SC, 2); DIL_SB(); \
            SN = __builtin_amdgcn_mfma_f32_32x32x16_bf16(k3_, qr[3], SN, 0, 0, 0); DIL_SB(); DIL_SMG(HC, SC, 3); DIL_SB(); } while (0)
        if (blk != 0) {
            f32x16 sA, sB;
            DIL_QK(0, sA); __builtin_amdgcn_sched_barrier(0);
            DIL_STAGE(1, sB, 0, sA); DIL_PIN(0); DIL_SB(); if (k + 1 < 9) DIL_K_PIECE(0);
            DIL_STAGE(2, sA, 1, sB); DIL_PIN(1); DIL_SB(); if (k + 1 < 9) DIL_K_PIECE(1);
            DIL_STAGE(3, sB, 2, sA); DIL_PIN(2); DIL_SB(); if (k + 1 < 9) DIL_K_PIECE(2);
            DIL_STAGE(4, sA, 3, sB); DIL_PIN(3); DIL_SB(); if (k + 1 < 9) DIL_K_PIECE(3);
            DIL_SM(4, sA); DIL_PIN(4); __builtin_amdgcn_sched_barrier(0); if (k + 1 < 9) { DIL_K_PIECE(4); DIL_K_PIECE(5); }
        } else {
#pragma unroll
        for (int hh = 0; hh < 5; ++hh) {
            const int ht = wid + hh;
#pragma unroll
            for (int e = 0; e < 8; ++e) pw[hh][e] = 0u;
            if (ht >= 4) { f32x16 s; DIL_QK(hh, s); DIL_SM(hh, s); }
            if (k + 1 < 9) { DIL_K_PIECE(hh); if (hh == 4) DIL_K_PIECE(5); }
        }
        }
#undef DIL_QK
#undef DIL_SM
#undef DIL_STAGE
#undef DIL_SMG
#undef DIL_SB
#undef DIL_PIN
#undef DIL_K_PIECE
        if (k + 1 < 9) { DIL_DECODE(k + 1, hn, pn, cn, bn); DIL_LOADQ(qn, hn, pn, cn, bn); }
        float l_reg = lx_sum32(l2[0] + l2[1]);
        unsigned* const gc = A.gcnt + (3 * (v >> 5) + k / 3) * 64;
        if (p == 2 && wid == 0) {
            unsigned spins = 0u;
            while (__hip_atomic_load(gc, __ATOMIC_RELAXED, __HIP_MEMORY_SCOPE_AGENT) < 32u) { __builtin_amdgcn_s_sleep(2); if (++spins > (1u << 22)) break; }
            __builtin_amdgcn_fence(__ATOMIC_ACQUIRE, "agent"); asm volatile("s_waitcnt vmcnt(0)" ::: "memory"); }
        if (k == 8) asm volatile("s_waitcnt vmcnt(0) lgkmcnt(0)\n\ts_barrier" ::: "memory");
        else asm volatile("s_waitcnt vmcnt(10) lgkmcnt(0)\n\ts_barrier" ::: "memory");

        u32x4 a0[4], a1[4], gvv[4]; float lp0, lp1;
        if (p == 2) { const bf16_t* Gh = A.proj + (size_t)(T_GD + h) * TSTRIDE; const int ln = lx_lane();
#pragma unroll
            for (int i = 0; i < 4; ++i) { const int t = c + ((u0 + wid * 32 + i * 8 + (ln >> 3)) << rsh);
                a0[i] = *(const u32x4*)(A.o1 + (size_t)t * 768 + h * 64 + (ln & 7) * 8); a1[i] = *(const u32x4*)(A.mix + (size_t)t * 1024 + 256 + h * 64 + (ln & 7) * 8);
                gvv[i] = *(const u32x4*)(Gh + (size_t)prow(t) * 64 + (ln & 7) * 8); }
            const int tq0 = c + ((u0 + wid * 32 + (ln & 31)) << rsh); lp0 = A.lp[(size_t)(0 * 12 + h) * SEQ + tq0]; lp1 = A.lp[(size_t)(1 * 12 + h) * SEQ + (tq0 & 3) * (SEQ >> 2) + (tq0 >> 2)]; }
        f32x16 o[2];
        o[0] = f32x16{}; o[1] = f32x16{};
#pragma unroll
        for (int hh = 0; hh < 5; ++hh) {
            const int ht = wid + hh;
            if (blk == 0 && ht < 4) continue;
            const lds_cptr vp = vp0 + (ht >> 1) * SLOTB + (ht & 1) * 2048;
            const bf16x8 pa0 = __builtin_bit_cast(bf16x8, (u32x4){pw[hh][0], pw[hh][1], pw[hh][2], pw[hh][3]}), pa1 = __builtin_bit_cast(bf16x8, (u32x4){pw[hh][4], pw[hh][5], pw[hh][6], pw[hh][7]});
#pragma unroll
            for (int d0 = 0; d0 < 2; ++d0) { const s16x4 l0 = vtr(vp + d0 * 4096), h0_ = vtr(vp + d0 * 4096 + 512), l1 = vtr(vp + d0 * 4096 + 1024), h1_ = vtr(vp + d0 * 4096 + 1536);
                o[d0] = __builtin_amdgcn_mfma_f32_32x32x16_bf16((bf16x8){l0[0], l0[1], l0[2], l0[3], h0_[0], h0_[1], h0_[2], h0_[3]}, pa0, o[d0], 0, 0, 0);
                o[d0] = __builtin_amdgcn_mfma_f32_32x32x16_bf16((bf16x8){l1[0], l1[1], l1[2], l1[3], h1_[0], h1_[1], h1_[2], h1_[3]}, pa1, o[d0], 0, 0, 0); }
        }
        auto tail = [&](auto is2_) __attribute__((always_inline)) { constexpr bool IS2 = decltype(is2_)::value;
        if (k + 1 < 9) { asm volatile("" :: "v"(qn[0]), "v"(qn[1]), "v"(qn[2]), "v"(qn[3]));
#pragma unroll
            for (int d0 = 0; d0 < 4; ++d0) qr[d0] = qn[d0]; }
        if constexpr (IS2) asm volatile("" :: "v"(a0[0]), "v"(a0[1]), "v"(a0[2]), "v"(a0[3]), "v"(a1[0]), "v"(a1[1]), "v"(a1[2]), "v"(a1[3]), "v"(gvv[0]), "v"(gvv[1]), "v"(gvv[2]), "v"(gvv[3]), "v"(lp0), "v"(lp1));
        { const int tq = c + ((u0 + wid * 32 + r32) << rsh);
          if constexpr (IS2) { const float inv_ = __builtin_amdgcn_rcpf((lp0 + lp1) + l_reg); const int le_ = lx_lane(); if (le_ < 32) wsf[le_] = inv_; }
          u32x4 sv[4]; ot_rows(o, shm + LDS_K + kb * (LDS_K2 - LDS_K) + wid * 4096, r32, hi, lane, sv);
          asm volatile("" ::: "memory");
          if constexpr (!IS2) {
#pragma unroll
              for (int i = 0; i < 4; ++i) { const int t = c + ((u0 + wid * 32 + i * 8 + (lane >> 3)) << rsh);
                  if (p == 0) __builtin_amdgcn_raw_buffer_store_b128(sv[i], o1_rsrc, (unsigned)((t * 768 + h * 64 + (lane & 7) * 8) * 2), 0, 16);
                  else __builtin_amdgcn_raw_buffer_store_b128(sv[i], mix_rsrc, (unsigned)((t * 1024 + 256 + h * 64 + (lane & 7) * 8) * 2), 0, 16); }
              {
                const float x1 = lx_xor<1>(l_reg), x2 = lx_xor<2>(l_reg), x3 = lx_xor<2>(x1); const int le_ = lx_lane();
                const __amdgpu_buffer_rsrc_t lp_rsrc = __builtin_amdgcn_make_buffer_rsrc((void*)A.lp, 0, 3 * 12 * SEQ * 4, 0x00020000);
                if ((le_ & 35) == 0) __builtin_amdgcn_raw_buffer_store_b128((u32x4){__float_as_uint(l_reg), __float_as_uint(x1), __float_as_uint(x2), __float_as_uint(x3)}, lp_rsrc,
                    (unsigned)(((p * 12 + h) * SEQ + c * (SEQ >> rsh) + u0 + wid * 32 + (le_ & 31)) * 4), 0, 16); }
              asm volatile("" ::: "memory");
              if (p == 1) asm volatile("s_waitcnt vmcnt(0)" ::: "memory");
          } else {
              float inv[4];
#pragma unroll
              for (int i = 0; i < 4; ++i) inv[i] = wsf[i * 8 + (lx_lane() >> 3)];
#pragma unroll
              for (int i = 0; i < 4; ++i) { u32x4 w;
#pragma unroll
                  for (int e = 0; e < 4; ++e) {
                      const float lo = (__uint_as_float(a0[i][e] << 16) + __uint_as_float(a1[i][e] << 16) + __uint_as_float(sv[i][e] << 16)) * inv[i] * __uint_as_float(gvv[i][e] << 16);
                      const float hi2 = (__uint_as_float(a0[i][e] & 0xffff0000u) + __uint_as_float(a1[i][e] & 0xffff0000u) + __uint_as_float(sv[i][e] & 0xffff0000u)) * inv[i] * __uint_as_float(gvv[i][e] & 0xffff0000u);
                      w[e] = cvtpk_s(lo, hi2); }
                  sv[i] = w; }
              asm volatile("" ::: "memory");
#pragma unroll
              for (int i = 0; i < 4; ++i) { const int t = c + ((u0 + wid * 32 + i * 8 + (lane >> 3)) << rsh); __builtin_amdgcn_raw_buffer_store_b128(sv[i], mix_rsrc, (unsigned)((t * 1024 + 256 + h * 64 + (lane & 7) * 8) * 2), 0, 16); }
              if (hi == 0) A.lp[(size_t)(2 * 12 + h) * SEQ + c * (SEQ >> rsh) + u0 + wid * 32 + r32] = l_reg;
          } } };
        if (p == 2) tail(att_true{}); else tail(att_false{});
    }
#undef DIL_DECODE
#undef DIL_KKEY
#undef DIL_KCH
#undef DIL_VKEY
#undef DIL_VCH
#undef DIL_ISSUE_K
#undef DIL_ISSUE_V
#undef DIL_LOADQ
    ATT_BAR_L();
}
#undef ATT_WAIT_BAR
#undef ATT_BAR_L
}
constexpr int NWAVES = 8;
constexpr int N_LAUNCHES = MK_N_LAUNCHES;
constexpr int DEPTH = 4, SEQ = 16384, DM = 1024, NIN = 4096;
constexpr int N_PHASES = 1 + 3 * DEPTH;
constexpr size_t MiB = 1u << 20;
constexpr size_t WS_CTL = 0, CTL_ZERO_BYTES = 128 * 1024;
constexpr size_t WS_ROPE = 1 * MiB;
constexpr size_t WS_SSQ = 2 * MiB;
constexpr size_t WS_LP = 3 * MiB;
constexpr size_t WS_W = 6 * MiB, W_STRIDE = 10 * MiB, W_OUT_OFF = 8 * MiB;
constexpr size_t WS_XB = 46 * MiB;
constexpr size_t WS_MIX = 78 * MiB;
constexpr size_t WS_PROJ = 110 * MiB;
constexpr size_t WS_XL = 238 * MiB;
constexpr size_t WS_END = 254 * MiB;
static_assert(PROJ_PAD == 0, "workspace map assumes unpadded head tensors");
constexpr int CW_BAR = 4096;
static_assert((16384 + 4 * 8 * 3 * 64) * 4 <= 128 * 1024, "control words inside the memset region");
constexpr int CW_ROW = 24576;
constexpr int CW_GRP = 16384;
constexpr int RING_OFF = 0, RING_BYTES = 131072;
constexpr int LDSCTL_OFF = 151552, MISC_OFF = LDSCTL_OFF + 320;
constexpr int LDS_BYTES = 153600;
static_assert(att::LDS_END <= LDSCTL_OFF && RING_BYTES + pg8::EpiInProj::XL_BYTES <= LDSCTL_OFF, "phase scratch below the control words");

#define GAS __attribute__((address_space(1)))
#define LAS __attribute__((address_space(3)))
typedef unsigned short bf16;
typedef unsigned v4u __attribute__((ext_vector_type(4)));
typedef float f32x4 __attribute__((ext_vector_type(4)));
typedef GAS unsigned gu32;
#define RLX_AGENT __ATOMIC_RELAXED, __HIP_MEMORY_SCOPE_AGENT
#define LDS_WAIT() asm volatile("s_waitcnt lgkmcnt(0)" ::: "memory")
#define VM_WAIT() asm volatile("s_waitcnt vmcnt(0)" ::: "memory")
__device__ __forceinline__ unsigned f2bf(float f) { unsigned u = __builtin_bit_cast(unsigned, f); return (u + 0x7fffu + ((u >> 16) & 1u)) >> 16; }
__device__ __forceinline__ unsigned pk2(float lo, float hi) { return f2bf(lo) | (f2bf(hi) << 16); }
#define XB_TMO      128
#define XB_XCNT(j)  (256  + 64 * (j))
#define XB_XSUB(j)  (1280 + 64 * (j))
#define XB_XGEN(j)  (2304 + 64 * (j))
#define XB_TOP      3328
#define XB_TOPGEN   3392
#define XCD_BAR_WORDS 3456
#define XB_SPIN_CAP (1u << 18)

__device__ __forceinline__ unsigned xb_ld(unsigned* p)              { return __hip_atomic_load(p, __ATOMIC_RELAXED, __HIP_MEMORY_SCOPE_AGENT); }
__device__ __forceinline__ unsigned xb_add(unsigned* p, unsigned v) { return __hip_atomic_fetch_add(p, v, __ATOMIC_RELAXED, __HIP_MEMORY_SCOPE_AGENT); }
__device__ __forceinline__ unsigned xb_xcc_id() { return (unsigned)__builtin_amdgcn_s_getreg((3 << 11) | 20) & 0xFu; }
#define XB_SPIN(cond, bar) do { unsigned _sp = 0; while (cond) { __builtin_amdgcn_s_sleep(1); \
    if ((++_sp & 255u) == 0u) { if (xb_ld(&(bar)[XB_TMO])) break; if (_sp > XB_SPIN_CAP) { atomicAdd(&(bar)[XB_TMO], 1u); break; } } } } while (0)

struct XcdBarrier {
    unsigned* bar; unsigned x;
    volatile LAS unsigned* st;
};

__device__ __forceinline__ XcdBarrier xcd_barrier_post(unsigned* bar, volatile LAS unsigned* st, bool leader) {
    XcdBarrier b; b.bar = bar; b.x = xb_xcc_id(); b.st = st;
    if (leader) (void)xb_add(&bar[XB_XCNT(b.x)], 1u);
    return b;
}
__device__ __forceinline__ void xcd_barrier_complete(unsigned* bar, unsigned x, unsigned& nloc, unsigned& nx) {
    const unsigned G = gridDim.x * gridDim.y * gridDim.z;
    unsigned sum, cnt, mine, sp = 0u;
    for (;;) {
        sum = 0u; cnt = 0u; mine = 0u;
#pragma unroll
        for (unsigned j = 0; j < 16; ++j) { const unsigned c = xb_ld(&bar[XB_XCNT(j)]); sum += c; cnt += (c > 0u) ? 1u : 0u; mine = (j == x) ? c : mine; }
        if (sum == G) break;
        __builtin_amdgcn_s_sleep(1);
        if ((++sp & 255u) == 0u) { if (xb_ld(&bar[XB_TMO])) break; if (sp > XB_SPIN_CAP) { atomicAdd(&bar[XB_TMO], 1u); break; } }
    }
    nloc = mine > 0u ? mine : 1u; nx = cnt > 0u ? cnt : 1u;
}

__device__ __forceinline__ void xcd_barrier(const XcdBarrier& b, bool leader) {
    asm volatile("s_waitcnt vmcnt(0)" ::: "memory");
    __syncthreads();
    if (leader) {
        unsigned* bar = b.bar;
        __builtin_amdgcn_s_waitcnt(0);
        unsigned nloc = b.st[0], nx = b.st[1];
        if (nloc == 0u) { xcd_barrier_complete(bar, b.x, nloc, nx); b.st[0] = nloc; b.st[1] = nx; }
        const unsigned old = xb_add(&bar[XB_XSUB(b.x)], 1u);
        const unsigned gen = old / nloc;
        if (old + 1u == (gen + 1u) * nloc) {
            __builtin_amdgcn_fence(__ATOMIC_RELEASE, "agent");
            asm volatile("s_waitcnt vmcnt(0)" ::: "memory");
            const unsigned og = xb_add(&bar[XB_TOP], 1u);
            const unsigned tg = og / nx;
            if (og + 1u == (tg + 1u) * nx) xb_add(&bar[XB_TOPGEN], 1u);
            else XB_SPIN(xb_ld(&bar[XB_TOPGEN]) == tg, bar);
            __builtin_amdgcn_fence(__ATOMIC_ACQUIRE, "agent");
            xb_add(&bar[XB_XGEN(b.x)], 1u);
            asm volatile("s_waitcnt vmcnt(0)" ::: "memory");
        } else {
            XB_SPIN(xb_ld(&bar[XB_XGEN(b.x)]) == gen, bar);
            __builtin_amdgcn_fence(__ATOMIC_ACQUIRE, "agent");
            asm volatile("s_waitcnt vmcnt(0)" ::: "memory");
        }
    }
    __syncthreads();
}


__device__ __forceinline__ void xcd_barrier_census(unsigned* bar, unsigned x, unsigned& nloc, unsigned& mask) {
    const unsigned G = gridDim.x * gridDim.y * gridDim.z;
    unsigned sum, msk, mine, sp = 0u;
    for (;;) {
        sum = 0u; msk = 0u; mine = 0u;
#pragma unroll
        for (unsigned j = 0; j < 16; ++j) { const unsigned c = xb_ld(&bar[XB_XCNT(j)]); sum += c; msk |= (c > 0u) ? (1u << j) : 0u; mine = (j == x) ? c : mine; }
        if (sum == G) break;
        __builtin_amdgcn_s_sleep(1);
        if ((++sp & 255u) == 0u) { if (xb_ld(&bar[XB_TMO])) break; if (sp > XB_SPIN_CAP) { atomicAdd(&bar[XB_TMO], 1u); break; } }
    }
    nloc = mine > 0u ? mine : 1u; mask = msk | (1u << x);
}
template <bool WB = true> __device__ __forceinline__ void xcd_barrier_flat(const XcdBarrier& b, int wave) {
    asm volatile("s_waitcnt vmcnt(0)" ::: "memory");
    __syncthreads();
    if (wave == 0) {
        unsigned* bar = b.bar;
        __builtin_amdgcn_s_waitcnt(0);
        unsigned nloc = b.st[0], mask = b.st[1];
        if (nloc == 0u) { xcd_barrier_census(bar, b.x, nloc, mask); b.st[0] = nloc; b.st[1] = mask; }
        const int lane = lx_lane();
        unsigned old = 0u; if (lane == 0) old = xb_add(&bar[XB_XSUB(b.x)], 1u);
        old = (unsigned)__builtin_amdgcn_readfirstlane((int)old);
        const unsigned gen = old / nloc;
        if (old + 1u == (gen + 1u) * nloc) {
            if constexpr (WB) { __builtin_amdgcn_fence(__ATOMIC_RELEASE, "agent");
                asm volatile("s_waitcnt vmcnt(0)" ::: "memory"); }
            if (lane == 0) (void)xb_add(&bar[XB_XGEN(b.x)], 1u);
        }
        const unsigned j = (unsigned)lane & 15u; const bool need = ((mask >> j) & 1u) != 0u;
        unsigned sp = 0u;
        for (;;) { const unsigned v = need ? xb_ld(&bar[XB_XGEN(j)]) : 0xffffffffu;
            if (__builtin_amdgcn_ballot_w64(v <= gen) == 0ull) break;
            __builtin_amdgcn_s_sleep(1);
            if ((++sp & 255u) == 0u) { if (xb_ld(&bar[XB_TMO])) break; if (sp > XB_SPIN_CAP) { if (lane == 0) atomicAdd(&bar[XB_TMO], 1u); break; } } }
        __builtin_amdgcn_fence(__ATOMIC_ACQUIRE, "agent");
        asm volatile("s_waitcnt vmcnt(0)" ::: "memory");
    }
    __syncthreads();
}

__device__ __forceinline__ void xcd_barrier_arrive(const XcdBarrier& b, int wave) {
    asm volatile("s_waitcnt vmcnt(0)" ::: "memory");
    __syncthreads();
    if (wave == 0) {
        unsigned* bar = b.bar;
        __builtin_amdgcn_s_waitcnt(0);
        unsigned nloc = b.st[0], mask = b.st[1];
        if (nloc == 0u) { xcd_barrier_census(bar, b.x, nloc, mask); b.st[0] = nloc; b.st[1] = mask; }
        const int lane = lx_lane();
        unsigned old = 0u; if (lane == 0) old = xb_add(&bar[XB_XSUB(b.x)], 1u);
        old = (unsigned)__builtin_amdgcn_readfirstlane((int)old);
        const unsigned gen = old / nloc;
        if (old + 1u == (gen + 1u) * nloc) {
            __builtin_amdgcn_fence(__ATOMIC_RELEASE, "agent");
            asm volatile("s_waitcnt vmcnt(0)" ::: "memory");
            if (lane == 0) (void)xb_add(&bar[XB_XGEN(b.x)], 1u);
        }
        b.st[2] = gen;
    }
}
__device__ __forceinline__ void xcd_barrier_wait(const XcdBarrier& b, int wave) {
    if (wave == 0) {
        unsigned* bar = b.bar; const unsigned mask = b.st[1], gen = b.st[2]; const int lane = lx_lane();
        const unsigned j = (unsigned)lane & 15u; const bool need = ((mask >> j) & 1u) != 0u;
        unsigned sp = 0u;
        for (;;) { const unsigned v = need ? xb_ld(&bar[XB_XGEN(j)]) : 0xffffffffu;
            if (__builtin_amdgcn_ballot_w64(v <= gen) == 0ull) break;
            __builtin_amdgcn_s_sleep(1);
            if ((++sp & 255u) == 0u) { if (xb_ld(&bar[XB_TMO])) break; if (sp > XB_SPIN_CAP) { if (lane == 0) atomicAdd(&bar[XB_TMO], 1u); break; } } }
        __builtin_amdgcn_fence(__ATOMIC_ACQUIRE, "agent");
        asm volatile("s_waitcnt vmcnt(0)" ::: "memory");
    }
    __syncthreads();
}
__device__ __forceinline__ float wave_sum(float v) {
    return lx_wave_sum(v);
}
template <bool PERMN> __device__ __forceinline__ void transpose_item(const float* W, int K, int N, bf16* WT, const float* gk, LAS float* scr, int item, int lane) {
    const int nblk = N / 32, kb = item / nblk, nb = item % nblk, k0 = 64 * kb, n0 = 32 * nb;
    float wv[32];
#pragma unroll
    for (int i = 0; i < 32; ++i) wv[i] = W[(size_t)(k0 + 2 * i + (lane >> 5)) * N + n0 + (lane & 31)];
    if (gk) {
#pragma unroll
        for (int i = 0; i < 32; ++i) wv[i] *= gk[k0 + 2 * i + (lane >> 5)]; }
#pragma unroll
    for (int i = 0; i < 32; ++i) scr[(2 * i + (lane >> 5)) * 33 + (lane & 31)] = wv[i];
    LDS_WAIT(); asm volatile("" ::: "memory");
    const int c = lane & 7;
#pragma unroll
    for (int j = 0; j < 4; ++j) { const int n = (lane >> 3) + 8 * j; const LAS float* s = scr + (8 * c) * 33 + n;
        v4u o; o.x = pk2(s[0 * 33], s[1 * 33]); o.y = pk2(s[2 * 33], s[3 * 33]); o.z = pk2(s[4 * 33], s[5 * 33]); o.w = pk2(s[6 * 33], s[7 * 33]);
        const int col = n0 + n; const int pos = PERMN ? ((col & ~255) + 128 * ((col >> 5) & 1) + 32 * ((col >> 6) & 3) + (col & 31)) : col;
        *(GAS v4u*)(WT + (size_t)pos * K + k0 + 8 * c) = o; }
    LDS_WAIT(); asm volatile("" ::: "memory");
}
struct KArgs { const float* x; const float* norm_g; const float* w_in; const float* q_norm_g; const float* k_norm_g; const float* w_out; float* out; unsigned char* ws; int ph_lo, ph_hi; };

__device__ __forceinline__ void convert_weights(const KArgs& a, LAS unsigned char* lds, int vcu, int G, int wave0, int it_lo, int it_hi) {
    const int wave = wave0; const int tid = lx_tid(wave); const int lane = tid & 63; const int gw = vcu * NWAVES + wave, NGW = G * NWAVES;
    LAS float* scr = (LAS float*)(lds + RING_OFF + wave * 16384);
    constexpr int I_IN = (DM / 64) * (NIN / 32), I_OUT = (DM / 64) * (DM / 32), I_L = I_IN + I_OUT;
    for (int it0 = it_lo + gw; it0 < it_hi; it0 += NGW) { const int l = it0 / I_L, it = it0 - l * I_L;
        bf16* WinT = (bf16*)(a.ws + WS_W + (size_t)l * W_STRIDE); bf16* WoutT = (bf16*)(a.ws + WS_W + (size_t)l * W_STRIDE + W_OUT_OFF);
        if (it < I_IN) transpose_item<true>(a.w_in + (size_t)l * DM * NIN, DM, NIN, WinT, a.norm_g + l * DM, scr, it, lane);
        else transpose_item<false>(a.w_out + (size_t)l * DM * DM, DM, DM, WoutT, nullptr, scr, it - I_IN, lane);
    }
}
__device__ __forceinline__ void sincos_acc(float angf, float& c, float& s) {
    const double ang = (double)angf; const double kq = __builtin_rint(ang * 0.63661977236758134308);
    const double r = __builtin_fma(-kq, 1.5707963267948966192, ang) - kq * 6.123233995736766036e-17; const double r2 = r * r;
    double sp = -1.0 / 1307674368000.0; sp = sp * r2 + 1.0 / 6227020800.0; sp = sp * r2 - 1.0 / 39916800.0; sp = sp * r2 + 1.0 / 362880.0; sp = sp * r2 - 1.0 / 5040.0; sp = sp * r2 + 1.0 / 120.0; sp = sp * r2 - 1.0 / 6.0; sp = sp * r2 * r + r;
    double cp = 1.0 / 87178291200.0; cp = cp * r2 - 1.0 / 479001600.0; cp = cp * r2 + 1.0 / 3628800.0; cp = cp * r2 - 1.0 / 40320.0; cp = cp * r2 + 1.0 / 720.0; cp = cp * r2 - 1.0 / 24.0; cp = cp * r2 + 0.5; cp = 1.0 - cp * r2;
    const int q = ((int)kq) & 3;
    const double sv = (q == 0) ? sp : (q == 1) ? cp : (q == 2) ? -sp : -cp, cv = (q == 0) ? cp : (q == 1) ? -sp : (q == 2) ? -cp : sp;
    c = (float)cv; s = (float)sv;
}
__device__ __forceinline__ float inv_freq(int i) {
    return i == 0 ? 1.0f : i == 1 ? 0.193922758102417f : i == 2 ? 0.03760603070259094f : i == 3 ? 0.00729266507551074f : i == 4 ? 0.001414213445968926f : i == 5 ? 0.00027424818836152554f : i == 6 ? 5.318296462064609e-05f : 1.0313385246263351e-05f;
}

#define AS1(p) ((decltype(p))(GAS void*)(p))
__global__ void __launch_bounds__(NWAVES * 64, 2) hsdg_fwd(KArgs args_in) {
    KArgs args = args_in; args.x = AS1(args_in.x); args.norm_g = AS1(args_in.norm_g); args.w_in = AS1(args_in.w_in); args.q_norm_g = AS1(args_in.q_norm_g); args.k_norm_g = AS1(args_in.k_norm_g);
    args.w_out = AS1(args_in.w_out); args.out = AS1(args_in.out); args.ws = AS1(args_in.ws);
    extern __shared__ __attribute__((aligned(16))) unsigned char lds_raw[];
    LAS unsigned char* lds = (LAS unsigned char*)lds_raw;
    volatile LAS unsigned* MISC = (volatile LAS unsigned*)(lds + MISC_OFF);
    const int wave0 = __builtin_amdgcn_readfirstlane((int)threadIdx.x >> 6); const int tid0 = lx_tid(wave0);
    const int G = gridDim.x; const int bx = blockIdx.x; const int vcu = (G % 8 == 0) ? (bx % 8) * (G / 8) + bx / 8 : bx;
    unsigned char* ws = args.ws;
    gu32* ctl = (gu32*)(ws + WS_CTL);
    for (int u = tid0; u < (LDS_BYTES - LDSCTL_OFF) / 4; u += NWAVES * 64) ((LAS unsigned*)(lds + LDSCTL_OFF))[u] = 0u;
    __syncthreads();
    XcdBarrier bar; bar.bar = (unsigned*)(ctl + CW_BAR); bar.x = 0; bar.st = nullptr;
    if (N_LAUNCHES == 1) bar = xcd_barrier_post((unsigned*)(ctl + CW_BAR), MISC + 8, tid0 == 0);
#define GRID_BAR() do { if (N_LAUNCHES == 1) xcd_barrier_flat<false>(bar, wave0); } while (0)
    const int lo = args.ph_lo, hi = args.ph_hi;
#define IN(k) (lo <= (k) && (k) < hi)
#define BOTH(k) (IN(k) && IN((k) + 1))
#define PHASE_PTRS() unsigned char* wsp; { unsigned long long w_ = (unsigned long long)ws; asm volatile("" : "+s"(w_)); wsp = (unsigned char*)(GAS unsigned char*)w_; } float* rope = (float*)(wsp + WS_ROPE); float* ssq = (float*)(wsp + WS_SSQ); float* lp = (float*)(wsp + WS_LP); \
        bf16* XB = (bf16*)(wsp + WS_XB); unsigned char* XL = wsp + WS_XL; (void)XL; bf16* MIX = (bf16*)(wsp + WS_MIX); bf16* PROJ = (bf16*)(wsp + WS_PROJ); (void)rope; (void)ssq; (void)lp; (void)XB; (void)MIX; (void)PROJ

    if (IN(0)) {
        constexpr int CW_IN0 = (DM / 64) * (NIN / 32), CW_ALL = DEPTH * ((DM / 64) * (NIN / 32) + (DM / 64) * (DM / 32));
        PHASE_PTRS(); convert_weights(args, lds, vcu, G, wave0, 0, CW_IN0);
        const int wave = wave0; const int tid = lx_tid(wave); const int lane = tid & 63; const int gw = vcu * NWAVES + wave, NGW = G * NWAVES;
        for (int m = gw; m < SEQ; m += 4 * NGW) {
            f32x4 v[4][4]; float s2[4];
#pragma unroll
            for (int q = 0; q < 4; ++q) { const int mm = m + q * NGW; const GAS f32x4* xr = (const GAS f32x4*)(args.x + (size_t)(mm < SEQ ? mm : m) * DM) + lane;
#pragma unroll
                for (int j = 0; j < 4; ++j) v[q][j] = xr[64 * j]; }
#pragma unroll
            for (int q = 0; q < 4; ++q) { float a = 0.f;
#pragma unroll
                for (int j = 0; j < 4; ++j) a += (v[q][j].x * v[q][j].x + v[q][j].y * v[q][j].y) + (v[q][j].z * v[q][j].z + v[q][j].w * v[q][j].w);
                s2[q] = wave_sum(a); }
#pragma unroll
            for (int q = 0; q < 4; ++q) { const int mm = m + q * NGW; if (mm < SEQ) {
                GAS unsigned long long* o8 = (GAS unsigned long long*)(XB + (size_t)mm * DM) + lane;
#pragma unroll
                for (int j = 0; j < 4; ++j) { const unsigned h0 = pk2(v[q][j].x, v[q][j].y), h1 = pk2(v[q][j].z, v[q][j].w); o8[64 * j] = (unsigned long long)h0 | ((unsigned long long)h1 << 32);
                    ((GAS unsigned*)(XL + (size_t)mm * DM))[lane + 64 * j] = xs_lo(v[q][j].x, h0 << 16) | (xs_lo(v[q][j].y, h0 & 0xffff0000u) << 8) | (xs_lo(v[q][j].z, h1 << 16) << 16) | (xs_lo(v[q][j].w, h1 & 0xffff0000u) << 24); }
                if (lane < 4) ssq[(size_t)lane * SEQ + mm] = (lane == 0) ? s2[q] : 0.f; } }
        }
        for (int i = bx * (NWAVES * 64) + tid; i < SEQ * 8; i += G * NWAVES * 64) { const int pos = i >> 3, k = i & 7; float c, s; sincos_acc((float)pos * inv_freq(k), c, s); rope[pos * 16 + k] = c; rope[pos * 16 + 8 + k] = s; }
        if (BOTH(0)) { if (N_LAUNCHES == 1) xcd_barrier_arrive(bar, wave0); }
        convert_weights(args, lds, vcu, G, wave0, CW_IN0, CW_ALL);
        if (BOTH(0)) { if (N_LAUNCHES == 1) xcd_barrier_wait(bar, wave0); }
    }
    for (int l = 0; l < DEPTH; ++l) {
        const int pA = 1 + 3 * l, pB = pA + 1, pC = pA + 2;
        if (IN(pA)) {
            PHASE_PTRS(); bf16* WinT = (bf16*)(wsp + WS_W + (size_t)l * W_STRIDE); const float* qg = args.q_norm_g + l * 64; const float* kg = args.k_norm_g + l * 64;
            pg8::Gemm g{XB, WinT, SEQ, NIN, DM}; pg8::StaticOrder S; S.init(SEQ, NIN, G, bx);
            if (N_LAUNCHES == 1 && l > 0) {
                pg8::Unit u0; S.next(0, u0);
                if (wave0 == 0) { unsigned sp = 0u; const unsigned* cp = (const unsigned*)(ctl + CW_ROW + ((l - 1) * 64 + u0.pm) * 16);
                    while (__hip_atomic_load(cp, __ATOMIC_RELAXED, __HIP_MEMORY_SCOPE_AGENT) < 4u) { __builtin_amdgcn_s_sleep(1); if (++sp > (1u << 22)) break; }
                    __builtin_amdgcn_fence(__ATOMIC_ACQUIRE, "agent"); asm volatile("s_waitcnt vmcnt(0)" ::: "memory"); }
                __syncthreads(); }
            { static_assert(pg8::EpiInProj::OFF_ROPE == WS_ROPE && pg8::EpiInProj::OFF_SSQ == WS_SSQ && pg8::EpiInProj::OFF_P == WS_PROJ, "workspace offsets"); pg8::EpiInProj E{wsp, qg, kg, (LAS unsigned char*)(lds + RING_OFF + RING_BYTES), -1};
            pg8::gemm_phase<pg8::EpiInProj, pg8::StaticOrder, true, true>(lds + RING_OFF, g, S, E, wave0); }
            if (BOTH(pA)) { if (l == 0) { if (N_LAUNCHES == 1) xcd_barrier_flat<true>(bar, wave0); } else GRID_BAR(); }
        }
        if (IN(pB)) {
            PHASE_PTRS(); const float* qg = args.q_norm_g + l * 64; const float* kg = args.k_norm_g + l * 64; gu32* ctlp = (gu32*)(wsp + WS_CTL);
            const att::SbArgs SA{PROJ, MIX};
            const att::DilArgs DA{PROJ, (bf16*)args.out, MIX, lp, (unsigned*)(ctlp + CW_GRP + l * 8 * 3 * 64), qg, kg};
            att::dil_phase<0>(vcu, G, DA, (att::lds_ptr)(lds + RING_OFF), wave0);
            asm volatile("s_waitcnt vmcnt(0) lgkmcnt(0)" ::: "memory"); __syncthreads();
            for (int u = vcu; u < 256; u += G) att::sb_unit<SB_EARLY_EXIT != 0>(u >> 6, u & 63, SA, (att::lds_ptr)(lds + RING_OFF), wave0);
            if (BOTH(pB)) GRID_BAR();
        }
        if (IN(pC)) {
            PHASE_PTRS(); bf16* WoutT = (bf16*)(wsp + WS_W + (size_t)l * W_STRIDE + W_OUT_OFF);
            pg8::Gemm g{MIX, WoutT, SEQ, DM, DM}; pg8::StaticOrder S; S.init(SEQ, DM, G, bx);
            const bool local_seam = (N_LAUNCHES == 1) && (l + 1 < DEPTH);
            pg8::EpiOutProj E{XB, XL, args.out, ssq, l == DEPTH - 1 ? 1 : 0, local_seam ? 1 : 0};
            pg8::gemm_phase<pg8::EpiOutProj, pg8::StaticOrder, false, true>(lds + RING_OFF, g, S, E, wave0);
            if (local_seam) {
                pg8::Unit u0; S.next(0, u0);
                asm volatile("s_waitcnt vmcnt(0)" ::: "memory"); __syncthreads();
                if (lx_tid(wave0) == 0) __hip_atomic_fetch_add((unsigned*)(ctl + CW_ROW + (l * 64 + u0.pm) * 16), 1u, __ATOMIC_RELAXED, __HIP_MEMORY_SCOPE_AGENT);
            } else if (pC + 1 < N_PHASES && BOTH(pC)) GRID_BAR();
        }
    }
#undef IN
#undef BOTH
#undef GRID_BAR
}

extern "C" void kernel_launch(void* const* d_in, const int* in_sizes, int n_in, void* d_out, int out_size, void* d_ws, size_t ws_size, hipStream_t stream) {
    static int grid = 0;
    if (grid == 0) {
        if (n_in != 6 || in_sizes[0] != SEQ * DM || out_size != SEQ * DM || ws_size < WS_END) { fprintf(stderr, "kernel_launch: unexpected shapes / workspace (n_in %d, in0 %d, out %d, ws %zu, need %zu)\n", n_in, n_in > 0 ? in_sizes[0] : -1, out_size, ws_size, (size_t)WS_END); grid = -1; return; }
        int dev = 0, cus = 0, per_cu = 0;
        if (hipGetDevice(&dev) != hipSuccess || hipDeviceGetAttribute(&cus, hipDeviceAttributeMultiprocessorCount, dev) != hipSuccess) { fprintf(stderr, "kernel_launch: device query failed\n"); grid = -1; return; }
        if (hipFuncSetAttribute((const void*)hsdg_fwd, hipFuncAttributeMaxDynamicSharedMemorySize, LDS_BYTES) != hipSuccess) { fprintf(stderr, "kernel_launch: hipFuncSetAttribute failed\n"); grid = -1; return; }
        if (hipOccupancyMaxActiveBlocksPerMultiprocessor(&per_cu, (const void*)hsdg_fwd, NWAVES * 64, LDS_BYTES) != hipSuccess || per_cu < 1) fprintf(stderr, "kernel_launch: note: occupancy query reports %d workgroups per CU\n", per_cu);
        (void)hipGetLastError();
        grid = cus;
        if (grid != 256) fprintf(stderr, "kernel_launch: %d CUs; the out-proj phase assumes 256 workgroups\n", grid);
    }
    if (grid < 0) return;
    if (hipMemsetAsync((char*)d_ws + WS_CTL, 0, CTL_ZERO_BYTES, stream) != hipSuccess) { fprintf(stderr, "kernel_launch: hipMemsetAsync failed\n"); return; }
    KArgs a{};
    a.x = (const float*)d_in[0]; a.norm_g = (const float*)d_in[1]; a.w_in = (const float*)d_in[2]; a.q_norm_g = (const float*)d_in[3]; a.k_norm_g = (const float*)d_in[4]; a.w_out = (const float*)d_in[5];
    a.out = (float*)d_out; a.ws = (unsigned char*)d_ws;
    if (N_LAUNCHES == 1) { a.ph_lo = 0; a.ph_hi = N_PHASES; hipLaunchKernelGGL(hsdg_fwd, dim3(grid), dim3(NWAVES * 64), LDS_BYTES, stream, a); }
    else for (int ph = 0; ph < N_PHASES; ++ph) { a.ph_lo = ph; a.ph_hi = ph + 1; hipLaunchKernelGGL(hsdg_fwd, dim3(grid), dim3(NWAVES * 64), LDS_BYTES, stream, a); }
    const hipError_t le = hipPeekAtLastError();
    if (le != hipSuccess) fprintf(stderr, "kernel_launch: launch failed: %s\n", hipGetErrorName(le));
}
```
